# Optimizing an MI355X kernel written in HIP

```python
import math
import jax, jax.numpy as jnp
from jax import lax
import numpy as np

D_MODEL = 1024
BATCH = 16
SEQ = 4096
DEPTH = 4

D_MIX = D_MODEL
HG_WIDTH = D_MIX // 2
HG_HEAD_DIM = 128
HG_HEADS = HG_WIDTH // HG_HEAD_DIM
HG_CHUNK = 64
NSA_WIDTH = D_MIX - HG_WIDTH
NSA_HEAD_DIM = 64
NSA_HEADS = NSA_WIDTH // NSA_HEAD_DIM
NSA_KV_GROUPS = 2
NSA_HPG = NSA_HEADS // NSA_KV_GROUPS
CMP_BLOCK = 32
CMP_STRIDE = 16
CMP_HIDDEN = 128
SLC_BLOCK = 64
SLC_TOPK = 16
SLC_LOCAL = 2
WINDOW = 512
Q_BLOCK = 64
N_BUCKETS = 32
MAX_DISTANCE = 128
D_FF = ((8 * D_MODEL // 3 + 255) // 256) * 256
ALPHA = (2.0 * DEPTH) ** 0.25
BETA = (8.0 * DEPTH) ** -0.25
KV_W = NSA_KV_GROUPS * NSA_HEAD_DIM
SPLIT_SIZES = (HG_WIDTH, HG_WIDTH, HG_WIDTH, HG_WIDTH, NSA_WIDTH, KV_W, KV_W, KV_W, KV_W, KV_W, KV_W, 3 * NSA_HEADS)
D_IN = sum(SPLIT_SIZES)
NEG = -1e30
BIG = 1e9

kernel_name = "hgrn2_nsa_parallel_heads_deepnorm"


def _split_points():
    pts, acc = [], 0
    for s in SPLIT_SIZES[:-1]:
        acc += s
        pts.append(acc)
    return pts


def layer_norm(x, g, b, eps=1e-5):
    xf = x.astype(jnp.float32)
    mu = jnp.mean(xf, -1, keepdims=True)
    var = jnp.mean(jnp.square(xf - mu), -1, keepdims=True)
    return ((xf - mu) * lax.rsqrt(var + eps) * g + b).astype(x.dtype)


def hgrn2_lower_bounds(lb_param):
    p = jax.nn.softmax(lb_param.astype(jnp.float32), axis=0)
    c = jnp.cumsum(p, axis=0)
    return c - c[0:1]


def hgrn2_mixer(q, f_logit, i, g, lb, gnorm_w):
    B, S, _ = q.shape
    H, Dk, C = HG_HEADS, HG_HEAD_DIM, HG_CHUNK
    N = S // C
    f32 = jnp.float32
    logf = jnp.logaddexp(jnp.log(lb), jnp.log1p(-lb) + jax.nn.log_sigmoid(f_logit.astype(f32)))
    k = -jnp.expm1(logf)

    def to_chunks(t):
        return t.astype(f32).reshape(B, N, C, H, -1).transpose(1, 0, 3, 2, 4)

    qc, kc, vc = to_chunks(q), to_chunks(k), to_chunks(i)
    bc = jnp.cumsum(to_chunks(logf), axis=3)
    causal = jnp.tril(jnp.ones((C, C), bool))

    def step(state, xs):
        qb, kb, vb, bb = xs
        rel = bb[:, :, :, None, :] - bb[:, :, None, :, :]
        decay = jnp.exp(jnp.where(causal[:, :, None], rel, -jnp.inf))
        scores = jnp.einsum('bhtd,bhsd,bhtsd->bhts', qb, kb, decay)
        o_intra = jnp.einsum('bhts,bhsv->bhtv', scores, vb)
        o_inter = jnp.einsum('bhtd,bhdv->bhtv', qb * jnp.exp(bb), state)
        b_last = bb[:, :, -1:, :]
        k_dec = kb * jnp.exp(b_last - bb)
        new_state = state * jnp.exp(b_last[:, :, 0, :, None]) + jnp.einsum('bhsd,bhsv->bhdv', k_dec, vb)
        return new_state, o_intra + o_inter

    s0 = jnp.zeros((B, H, Dk, Dk), f32)
    _, o = lax.scan(step, s0, (qc, kc, vc, bc))
    o = o.transpose(1, 0, 3, 2, 4).reshape(B, S, H, Dk)
    o = o * lax.rsqrt(jnp.mean(o * o, -1, keepdims=True) + 1e-6) * gnorm_w
    o = o.reshape(B, S, HG_WIDTH) * jax.nn.silu(g.astype(f32))
    return o.astype(q.dtype)


def t5_bucket(n):
    n = jnp.maximum(n, 0)
    max_exact = N_BUCKETS // 2
    nf = jnp.maximum(n, 1).astype(jnp.float32)
    large = max_exact + (jnp.log(nf / max_exact) / math.log(MAX_DISTANCE / max_exact)
                         * (N_BUCKETS - max_exact)).astype(jnp.int32)
    large = jnp.minimum(large, N_BUCKETS - 1)
    return jnp.where(n < max_exact, n, large)


def masked_softmax(s, valid):
    s = jnp.where(valid, s, NEG)
    p = jax.nn.softmax(s, axis=-1)
    return jnp.where(valid, p, 0.0)


def nsa_mixer(q, k_cmp, v_cmp, k_slc, v_slc, k_win, v_win, gates,
              cmp_pos_k, cmp_w1_k, cmp_w2_k, cmp_pos_v, cmp_w1_v, cmp_w2_v, rel_bias):
    B, S, _ = q.shape
    G, HPG, Dh = NSA_KV_GROUPS, NSA_HPG, NSA_HEAD_DIM
    f32 = jnp.float32
    scale = Dh ** -0.5
    rb = rel_bias.astype(f32)
    qh = q.astype(f32).reshape(B, S, G, HPG, Dh).transpose(0, 2, 3, 1, 4)
    gh = jax.nn.sigmoid(gates.astype(f32)).reshape(B, S, 3, G, HPG).transpose(0, 3, 4, 1, 2)

    def kv(t):
        return t.astype(f32).reshape(B, S, G, Dh).transpose(0, 2, 1, 3)

    n_cmp = (S - CMP_BLOCK) // CMP_STRIDE + 1

    def compress(t, pos, w1, w2):
        c = kv(t).reshape(B, G, S // CMP_STRIDE, CMP_STRIDE, Dh)
        blocks = jnp.concatenate([c[:, :, :-1], c[:, :, 1:]], axis=3)
        blocks = (blocks + pos).reshape(B, G, n_cmp, CMP_BLOCK * Dh)
        return jax.nn.gelu(blocks @ w1) @ w2

    kc = compress(k_cmp, cmp_pos_k, cmp_w1_k, cmp_w2_k)
    vc = compress(v_cmp, cmp_pos_v, cmp_w1_v, cmp_w2_v)
    cmp_start = jnp.arange(n_cmp) * CMP_STRIDE
    cmp_end = cmp_start + CMP_BLOCK - 1

    n_slc = S // SLC_BLOCK
    n_sel = min(SLC_TOPK, n_slc)
    ks_blocks = kv(k_slc).reshape(B, G, n_slc, SLC_BLOCK, Dh)
    vs_blocks = kv(v_slc).reshape(B, G, n_slc, SLC_BLOCK, Dh)
    slc_start = jnp.arange(n_slc) * SLC_BLOCK
    overlap = jnp.clip(jnp.minimum(cmp_start[:, None] + CMP_BLOCK, slc_start[None, :] + SLC_BLOCK)
                       - jnp.maximum(cmp_start[:, None], slc_start[None, :]), 0, None)
    agg = overlap.astype(f32) / CMP_STRIDE

    kw_pad = jnp.pad(kv(k_win), ((0, 0), (0, 0), (WINDOW, 0), (0, 0)))
    vw_pad = jnp.pad(kv(v_win), ((0, 0), (0, 0), (WINDOW, 0), (0, 0)))
    tab_g = rb.reshape(N_BUCKETS, G, HPG)
    bi = jnp.arange(B)[:, None, None, None]
    gi = jnp.arange(G)[None, :, None, None]

    def head_bias(dist):
        bsh = rb[t5_bucket(dist)]
        return bsh.reshape(dist.shape + (G, HPG)).transpose(2, 3, 0, 1)

    def block_fn(qb_idx):
        t0 = qb_idx * Q_BLOCK
        t_pos = t0 + jnp.arange(Q_BLOCK)
        qblk = lax.dynamic_slice_in_dim(qh, t0, Q_BLOCK, axis=3)
        gblk = lax.dynamic_slice_in_dim(gh, t0, Q_BLOCK, axis=3)
        s_c = jnp.einsum('bghtd,bgnd->bghtn', qblk, kc) * scale + head_bias(t_pos[:, None] - cmp_end[None, :])
        valid_c = cmp_end[None, :] <= t_pos[:, None]
        p_c = masked_softmax(s_c, valid_c)
        o_c = jnp.einsum('bghtn,bgnd->bghtd', p_c, vc)
        imp = jnp.einsum('bghtn,nj->bgtj', p_c, agg)
        cur = t_pos // SLC_BLOCK
        j = jnp.arange(n_slc)
        diff = cur[:, None] - j[None, :]
        forced = (j[None, :] == 0) | ((diff >= 0) & (diff < SLC_LOCAL))
        causal_blk = slc_start[None, :] <= t_pos[:, None]
        score = jnp.where(forced, BIG, jnp.where(causal_blk, imp, -BIG))
        _, idx = lax.top_k(score, n_sel)
        L = n_sel * SLC_BLOCK
        ks_g = ks_blocks[bi, gi, idx].reshape(B, G, Q_BLOCK, L, Dh)
        vs_g = vs_blocks[bi, gi, idx].reshape(B, G, Q_BLOCK, L, Dh)
        key_pos = (idx[..., None] * SLC_BLOCK + jnp.arange(SLC_BLOCK)).reshape(B, G, Q_BLOCK, L)
        dist_s = t_pos[None, None, :, None] - key_pos
        bias_s = jax.vmap(lambda tb, bk: tb[bk], in_axes=(1, 1), out_axes=1)(tab_g, t5_bucket(dist_s))
        bias_s = bias_s.transpose(0, 1, 4, 2, 3)
        s_s = jnp.einsum('bghtd,bgtld->bghtl', qblk, ks_g) * scale + bias_s
        p_s = masked_softmax(s_s, (dist_s >= 0)[:, :, None])
        o_s = jnp.einsum('bghtl,bgtld->bghtd', p_s, vs_g)
        kw = lax.dynamic_slice_in_dim(kw_pad, t0, WINDOW + Q_BLOCK, axis=2)
        vw = lax.dynamic_slice_in_dim(vw_pad, t0, WINDOW + Q_BLOCK, axis=2)
        kpos = t0 - WINDOW + jnp.arange(WINDOW + Q_BLOCK)
        dist_w = t_pos[:, None] - kpos[None, :]
        valid_w = (dist_w >= 0) & (dist_w < WINDOW) & (kpos[None, :] >= 0)
        s_w = jnp.einsum('bghtd,bgkd->bghtk', qblk, kw) * scale + head_bias(dist_w)
        p_w = masked_softmax(s_w, valid_w)
        o_w = jnp.einsum('bghtk,bgkd->bghtd', p_w, vw)
        return gblk[..., 0:1] * o_c + gblk[..., 1:2] * o_s + gblk[..., 2:3] * o_w

    o = lax.map(block_fn, jnp.arange(S // Q_BLOCK))
    o = o.transpose(1, 0, 4, 2, 3, 5).reshape(B, S, NSA_WIDTH)
    return o.astype(q.dtype)


def setup_inputs(seed: int = 0) -> dict:
    key = jax.random.key(seed)
    ks = jax.random.split(key, 20)
    f32 = jnp.float32

    def nrm(k, shape, fan_in, scale=1.0):
        return jax.random.normal(k, shape, f32) * (scale * fan_in ** -0.5)

    def small(k, shape, s):
        return jax.random.normal(k, shape, f32) * s

    return {
        "x": jax.random.normal(ks[0], (BATCH, SEQ, D_MODEL), f32),
        "w_in": nrm(ks[1], (DEPTH, D_MODEL, D_IN), D_MODEL),
        "hg_lb_param": small(ks[2], (DEPTH, HG_WIDTH), 0.1),
        "hg_norm_w": 1.0 + small(ks[3], (DEPTH, HG_HEAD_DIM), 0.02),
        "cmp_pos_k": small(ks[4], (DEPTH, CMP_BLOCK, NSA_HEAD_DIM), 0.02),
        "cmp_w1_k": nrm(ks[5], (DEPTH, CMP_BLOCK * NSA_HEAD_DIM, CMP_HIDDEN), CMP_BLOCK * NSA_HEAD_DIM),
        "cmp_w2_k": nrm(ks[6], (DEPTH, CMP_HIDDEN, NSA_HEAD_DIM), CMP_HIDDEN),
        "cmp_pos_v": small(ks[7], (DEPTH, CMP_BLOCK, NSA_HEAD_DIM), 0.02),
        "cmp_w1_v": nrm(ks[8], (DEPTH, CMP_BLOCK * NSA_HEAD_DIM, CMP_HIDDEN), CMP_BLOCK * NSA_HEAD_DIM),
        "cmp_w2_v": nrm(ks[9], (DEPTH, CMP_HIDDEN, NSA_HEAD_DIM), CMP_HIDDEN),
        "rel_bias": small(ks[10], (N_BUCKETS, NSA_HEADS), 0.1),
        "w_out": nrm(ks[11], (DEPTH, D_MIX, D_MODEL), D_MIX, BETA),
        "ln1_g": 1.0 + small(ks[12], (DEPTH, D_MODEL), 0.02),
        "ln1_b": small(ks[13], (DEPTH, D_MODEL), 0.02),
        "w_ffn_gate": nrm(ks[14], (DEPTH, D_MODEL, D_FF), D_MODEL),
        "w_ffn_up": nrm(ks[15], (DEPTH, D_MODEL, D_FF), D_MODEL),
        "w_ffn_down": nrm(ks[16], (DEPTH, D_FF, D_MODEL), D_FF, BETA),
        "ln2_g": 1.0 + small(ks[17], (DEPTH, D_MODEL), 0.02),
        "ln2_b": small(ks[18], (DEPTH, D_MODEL), 0.02),
    }


def reference(x, w_in, hg_lb_param, hg_norm_w, cmp_pos_k, cmp_w1_k, cmp_w2_k,
              cmp_pos_v, cmp_w1_v, cmp_w2_v, rel_bias, w_out, ln1_g, ln1_b,
              w_ffn_gate, w_ffn_up, w_ffn_down, ln2_g, ln2_b):
    lbs = hgrn2_lower_bounds(hg_lb_param)
    pts = _split_points()
    for l in range(DEPTH):
        proj = x @ w_in[l]
        hq, hf, hi, hg, nq, kc, vc, ks, vs, kw, vw, gt = jnp.split(proj, pts, axis=-1)
        o_a = hgrn2_mixer(hq, hf, hi, hg, lbs[l], hg_norm_w[l])
        o_b = nsa_mixer(nq, kc, vc, ks, vs, kw, vw, gt,
                        cmp_pos_k[l], cmp_w1_k[l], cmp_w2_k[l],
                        cmp_pos_v[l], cmp_w1_v[l], cmp_w2_v[l], rel_bias)
        mix = jnp.concatenate([o_a, o_b], axis=-1) @ w_out[l]
        x = layer_norm(ALPHA * x + mix, ln1_g[l], ln1_b[l])
        ffn = (jax.nn.silu(x @ w_ffn_gate[l]) * (x @ w_ffn_up[l])) @ w_ffn_down[l]
        x = layer_norm(ALPHA * x + ffn, ln2_g[l], ln2_b[l])
    return x
```

```cpp
#define MK_N_LAUNCHES 1
#include <hip/hip_runtime.h>
#include <cstdio>
#include <cstdint>
#include <cmath>
namespace pg8 {
#define PG8_LAS __attribute__((address_space(3)))
typedef unsigned short bf16_t;
typedef short bf16x8 __attribute__((ext_vector_type(8)));
typedef float f32x4 __attribute__((ext_vector_type(4)));
typedef unsigned u32x4 __attribute__((ext_vector_type(4)));
constexpr int BM = 256, BK = 64, HALF = 128, HTB = HALF * BK * 2  , STAGE_BYTES = 8 * HTB, NXCD = 8, WGM = 8;

__host__ __device__ __forceinline__ int lds_byte(int r, int c) { const int st = (r >> 4) * 2 + (c >> 5), rr = r & 15, cc = c & 31, ob = rr * 64 + cc * 2; return st * 1024 + (ob ^ (((ob >> 9) & 1) << 5)); }
__host__ __device__ __forceinline__ void stage_rc(int b, int& R, int& C) { const int st = b / 1024, sb = b % 1024, swz = sb ^ (((sb >> 9) & 1) << 5); R = (st >> 1) * 16 + swz / 64; C = (st & 1) * 32 + (swz % 64) / 2; }
__host__ __device__ __forceinline__ int perm32(int rho) { const int n = rho >> 4, i = rho & 15; return 8 * (i >> 2) + 4 * n + (i & 3); }

struct Unit { int pm, pn; };
struct Gemm { const bf16_t* A; const bf16_t* Bt; int M, N, K; };

struct StaticOrder {
    int nM, nN, nwg, G, c;
    __host__ __device__ void init(int M, int N, int G_, int c_) { nM = M / BM; nN = N / BM; nwg = nM * nN; G = G_; c = c_; }
    __host__ __device__ bool next(int i, Unit& u) const {
        const long L = (long)i * G + c; if (L >= nwg) return false;
        int wgid = (int)L; { const int q = nwg / NXCD, r = nwg % NXCD, xcd = wgid % NXCD, off = wgid / NXCD; wgid = (xcd < r ? xcd * (q + 1) : r * (q + 1) + (xcd - r) * q) + off; }
        const int nig = WGM * nN, gid = wgid / nig, fm = gid * WGM, gsz = (nM - fm) < WGM ? (nM - fm) : WGM;
        u.pm = fm + ((wgid % nig) % gsz); u.pn = (wgid % nig) / gsz; return true;
    }
    __device__ __forceinline__ void a_ready(const Unit&) const {}
    __device__ __forceinline__ void done(const Unit&) const {}
};

__device__ __forceinline__ unsigned cvt_pk_bf16(float lo, float hi) { unsigned r; asm volatile("v_cvt_pk_bf16_f32 %0, %1, %2" : "=v"(r) : "v"(lo), "v"(hi)); return r; }
typedef float f32x2 __attribute__((ext_vector_type(2)));
__device__ __forceinline__ f32x2 gelu_pk(f32x2 v) {
    const f32x2 av = __builtin_elementwise_abs(v), d = av * 0.2316418882f + 1.0f;
    f32x2 t; t.x = __builtin_amdgcn_rcpf(d.x); t.y = __builtin_amdgcn_rcpf(d.y);
    f32x2 q = t * 0.5307027145f + (-0.7265760135f); q = q * t + 0.7107068705f; q = q * t + (-0.142248368f); q = q * t + 0.127414796f; q = q * t;
    const f32x2 s = (v * v) * (-0.72134752044f);
    f32x2 e; e.x = __builtin_amdgcn_exp2f(s.x); e.y = __builtin_amdgcn_exp2f(s.y);
    const f32x2 m = v * (q * e), r = v - m;
    f32x2 o; o.x = v.x < 0.f ? m.x : r.x; o.y = v.y < 0.f ? m.y : r.y; return o;
}

template <int ACT  > struct EpiBf16 {
    static constexpr bool PERM = true, AFTER_DRAIN = false; static_assert(ACT == 0 || ACT == 1, "EpiBf16: ACT is 0 (none) or 1 (gelu_pk)");
    bf16_t* O; int ldc; const float* bias; int split_cols; size_t split_stride; float scale0;
    __device__ __forceinline__ void operator()(const f32x4 (&acc)[2][2][4][2], const Unit& u, int wr, int wc, int fr, int fq) const {
        const int row0 = u.pm * BM + wr * 64 + fr; int colt = u.pn * BM; bf16_t* base = O;
        float sc = 1.f; if (split_cols) { const int t = colt / split_cols; base += (size_t)t * split_stride; colt -= t * split_cols; if (t == 0) sc = scale0; }
        const int col0 = colt + wc * 32 + 8 * fq, bcol0 = u.pn * BM + wc * 32 + 8 * fq;
        f32x4 bv[2][2];
#pragma unroll
        for (int bj = 0; bj < 2; ++bj)
#pragma unroll
            for (int n = 0; n < 2; ++n) bv[bj][n] = bias ? *(const f32x4*)(bias + bcol0 + bj * HALF + 4 * n) : (f32x4){0.f, 0.f, 0.f, 0.f};
#pragma unroll
        for (int ai = 0; ai < 2; ++ai)
#pragma unroll
            for (int m = 0; m < 4; ++m) { bf16_t* rowp = base + (size_t)(row0 + ai * HALF + m * 16) * ldc + col0;
#pragma unroll
                for (int bj = 0; bj < 2; ++bj) { f32x4 v0 = acc[ai][bj][m][0] + bv[bj][0], v1 = acc[ai][bj][m][1] + bv[bj][1];
                    if (ACT == 1) { f32x2 a = gelu_pk((f32x2){v0[0], v0[1]}), b = gelu_pk((f32x2){v0[2], v0[3]}), c = gelu_pk((f32x2){v1[0], v1[1]}), d = gelu_pk((f32x2){v1[2], v1[3]});
                        v0 = (f32x4){a.x, a.y, b.x, b.y}; v1 = (f32x4){c.x, c.y, d.x, d.y}; }
                    v0 = v0 * sc; v1 = v1 * sc; u32x4 w; w.x = cvt_pk_bf16(v0[0], v0[1]); w.y = cvt_pk_bf16(v0[2], v0[3]); w.z = cvt_pk_bf16(v1[0], v1[1]); w.w = cvt_pk_bf16(v1[2], v1[3]);
                    *(u32x4*)(rowp + bj * HALF) = w; } }
    }
};

struct EpiResid {
    static constexpr bool PERM = false, AFTER_DRAIN = false;
    const float* xin; float* out; int ldc; float alpha;
    __device__ __forceinline__ void operator()(const f32x4 (&acc)[2][2][4][2], const Unit& u, int wr, int wc, int fr, int fq) const {
        const int col0 = u.pn * BM + wc * 32 + 4 * fq;
#pragma unroll
        for (int ai = 0; ai < 2; ++ai)
#pragma unroll
            for (int m = 0; m < 4; ++m) { const size_t off = (size_t)(u.pm * BM + ai * HALF + wr * 64 + m * 16 + fr) * ldc + col0;
#pragma unroll
                for (int bj = 0; bj < 2; ++bj)
#pragma unroll
                    for (int n = 0; n < 2; ++n) { const size_t p = off + bj * HALF + n * 16; const f32x4 xv = *(const f32x4*)(xin + p); *(f32x4*)(out + p) = xv * alpha + acc[ai][bj][m][n]; } }
    }
};
struct EpiSwiGLU {
    static constexpr bool PERM = true, AFTER_DRAIN = false;
    bf16_t* H; int ldh;
    __device__ __forceinline__ static float silu(float x) { return x * __builtin_amdgcn_rcpf(1.0f + __expf(-x)); }
    __device__ __forceinline__ void operator()(const f32x4 (&acc)[2][2][4][2], const Unit& u, int wr, int wc, int fr, int fq) const {
        const int row0 = u.pm * BM + wr * 64 + fr, col0 = u.pn * HALF + wc * 32 + 8 * fq;
#pragma unroll
        for (int ai = 0; ai < 2; ++ai)
#pragma unroll
            for (int m = 0; m < 4; ++m) { bf16_t* rowp = H + (size_t)(row0 + ai * HALF + m * 16) * ldh + col0;
                const f32x4 g0 = acc[ai][0][m][0], g1 = acc[ai][0][m][1], u0 = acc[ai][1][m][0], u1 = acc[ai][1][m][1];
                u32x4 w; w.x = cvt_pk_bf16(silu(g0[0]) * u0[0], silu(g0[1]) * u0[1]); w.y = cvt_pk_bf16(silu(g0[2]) * u0[2], silu(g0[3]) * u0[3]);
                w.z = cvt_pk_bf16(silu(g1[0]) * u1[0], silu(g1[1]) * u1[1]); w.w = cvt_pk_bf16(silu(g1[2]) * u1[2], silu(g1[3]) * u1[3]);
                *(u32x4*)rowp = w; }
    }
};
template <class Epi, class Sched, bool ALIGN_EPI = false, bool SP2 = false>
__device__ __forceinline__ void gemm_phase(PG8_LAS unsigned char* lds, const Gemm g, const Sched& S, const Epi& E) {
    int tid_ = threadIdx.x; asm volatile("" : "+v"(tid_));
    const int tid = tid_, wid = __builtin_amdgcn_readfirstlane(tid >> 6), lane = tid & 63, wr = wid >> 2, wc = wid & 3, fr = lane & 15, fq = lane >> 4;
    const int K = g.K, nt = K / BK;
    unsigned voffA[2], voffB[2];
#pragma unroll
    for (int i = 0; i < 2; ++i) { int R, C; stage_rc(tid * 16 + i * 8192, R, C); const int Rb = Epi::PERM ? ((R & ~31) + perm32(R & 31)) : R;
        voffA[i] = (unsigned)(R * K + C) * 2u; voffB[i] = (unsigned)(Rb * K + C) * 2u; }
    const size_t kstep = (size_t)(BK * 2);
    const size_t hstep = (size_t)HALF * K * 2;
    const size_t tstep = 2 * hstep;
    const unsigned ldsw = (unsigned)wid * 1024u;
    const int aoff = lds_byte(wr * 64 + fr, fq * 8), boff = lds_byte(wc * 32 + fr, fq * 8);
#define PG8_SA(b, h) (((b) * 2 + (h)) * HTB)
#define PG8_SB(b, h) ((4 + (b) * 2 + (h)) * HTB)
#define PG8_STAGE(bufoff, gbase, voff) do { _Pragma("unroll") for (int _i = 0; _i < 2; ++_i) \
        __builtin_amdgcn_global_load_lds((const unsigned*)((const char*)(gbase) + (voff)[_i]), (PG8_LAS unsigned*)(lds + (bufoff) + ldsw + _i * 8192), 16, 0, 0); } while (0)
#define PG8_LDA(dst, b, h) do { _Pragma("unroll") for (int m = 0; m < 4; ++m) _Pragma("unroll") for (int k = 0; k < 2; ++k) dst[m][k] = *(const PG8_LAS bf16x8*)(lds + PG8_SA(b, h) + aoff + m * 2048 + k * 1024); } while (0)
#define PG8_LDB(dst, b, h) do { _Pragma("unroll") for (int n = 0; n < 2; ++n) _Pragma("unroll") for (int k = 0; k < 2; ++k) dst[n][k] = *(const PG8_LAS bf16x8*)(lds + PG8_SB(b, h) + boff + n * 2048 + k * 1024); } while (0)
#define PG8_MMA(ai, bj, At, Bt) do { __builtin_amdgcn_s_setprio(1); _Pragma("unroll") for (int m = 0; m < 4; ++m) _Pragma("unroll") for (int n = 0; n < 2; ++n) _Pragma("unroll") for (int k = 0; k < 2; ++k) \
        acc[ai][bj][m][n] = __builtin_amdgcn_mfma_f32_16x16x32_bf16(Bt[n][k], At[m][k], acc[ai][bj][m][n], 0, 0, 0); __builtin_amdgcn_s_setprio(0); } while (0)
#define PG8_WAIT_V(n) asm volatile("s_waitcnt vmcnt(" #n ")" ::: "memory")
#define PG8_WAIT_L(n) asm volatile("s_waitcnt lgkmcnt(" #n ")" ::: "memory")
#define PG8_BAR __builtin_amdgcn_s_barrier()
#define PG8_SCHED __builtin_amdgcn_sched_barrier(0)
    Unit cur, nxt; int ui = 0;
    if (!S.next(0, cur)) return;
    f32x4 acc[2][2][4][2];
#pragma unroll
    for (int a = 0; a < 2; ++a)
#pragma unroll
        for (int b = 0; b < 2; ++b)
#pragma unroll
            for (int m = 0; m < 4; ++m)
#pragma unroll
                for (int n = 0; n < 2; ++n) acc[a][b][m][n] = (f32x4){0.f, 0.f, 0.f, 0.f};
    bf16x8 At[4][2], B0[2][2], B1[2][2];
    const char* cA = (const char*)g.A + (size_t)cur.pm * tstep; const char* cB = (const char*)g.Bt + (size_t)cur.pn * tstep;
    S.a_ready(cur);
    if constexpr (SP2) {
        PG8_STAGE(PG8_SB(0, 0), cB, voffB); PG8_STAGE(PG8_SB(0, 1), cB + hstep, voffB); PG8_STAGE(PG8_SA(0, 0), cA, voffA); PG8_STAGE(PG8_SA(0, 1), cA + hstep, voffA);
        if (wr == 1) PG8_BAR;
        PG8_WAIT_V(2); PG8_BAR;
        PG8_STAGE(PG8_SB(1, 0), cB + kstep, voffB); PG8_STAGE(PG8_SA(1, 0), cA + kstep, voffA); PG8_STAGE(PG8_SB(1, 1), cB + hstep + kstep, voffB);
        PG8_WAIT_V(6); PG8_BAR;
    } else {
        PG8_STAGE(PG8_SB(0, 0), cB, voffB); PG8_STAGE(PG8_SA(0, 0), cA, voffA); PG8_STAGE(PG8_SB(0, 1), cB + hstep, voffB); PG8_STAGE(PG8_SA(0, 1), cA + hstep, voffA);
        if (wr == 1) PG8_BAR;
        PG8_WAIT_V(4); PG8_BAR;
        PG8_STAGE(PG8_SB(1, 0), cB + kstep, voffB); PG8_STAGE(PG8_SA(1, 0), cA + kstep, voffA); PG8_STAGE(PG8_SB(1, 1), cB + hstep + kstep, voffB);
        PG8_WAIT_V(6); PG8_BAR;
    }
    for (;;) {
        const bool has_next = S.next(ui + 1, nxt);
        const char* nA = has_next ? (const char*)g.A + (size_t)nxt.pm * tstep : cA; const char* nB = has_next ? (const char*)g.Bt + (size_t)nxt.pn * tstep : cB;
        for (int t = 0; t < nt; t += 2) {
            const bool last = (t == nt - 2);
            const char* a1 = cA + (size_t)(t + 1) * kstep;
            const char* a2 = last ? nA : cA + (size_t)(t + 2) * kstep; const char* b2 = last ? nB : cB + (size_t)(t + 2) * kstep;
            const char* a3 = a2 + kstep; const char* b3 = b2 + kstep;
            if (last && has_next) S.a_ready(nxt);
            if constexpr (SP2) {
            PG8_LDB(B0, 0, 0); PG8_LDB(B1, 0, 1); PG8_SCHED; PG8_LDA(At, 0, 0); PG8_STAGE(PG8_SA(1, 1), a1 + hstep, voffA);
            PG8_WAIT_V(8); PG8_WAIT_L(0); PG8_BAR; PG8_MMA(0, 0, At, B0); PG8_MMA(0, 1, At, B1); PG8_BAR; PG8_SCHED;
            PG8_LDA(At, 0, 1); PG8_STAGE(PG8_SB(0, 0), b2, voffB); PG8_STAGE(PG8_SB(0, 1), b2 + hstep, voffB); PG8_STAGE(PG8_SA(0, 0), a2, voffA);
            PG8_WAIT_V(8); PG8_WAIT_L(0); PG8_BAR; PG8_MMA(1, 0, At, B0); PG8_MMA(1, 1, At, B1); PG8_BAR; PG8_SCHED;
            PG8_LDB(B0, 1, 0); PG8_LDB(B1, 1, 1); PG8_SCHED; PG8_LDA(At, 1, 0); PG8_STAGE(PG8_SA(0, 1), a2 + hstep, voffA);
            PG8_WAIT_V(8); PG8_WAIT_L(0); PG8_BAR; PG8_MMA(0, 0, At, B0); PG8_MMA(0, 1, At, B1); PG8_BAR; PG8_SCHED;
            PG8_LDA(At, 1, 1); PG8_STAGE(PG8_SB(1, 0), b3, voffB); PG8_STAGE(PG8_SB(1, 1), b3 + hstep, voffB); PG8_STAGE(PG8_SA(1, 0), a3, voffA);
            PG8_WAIT_V(8); PG8_WAIT_L(0); PG8_BAR; PG8_MMA(1, 0, At, B0); PG8_MMA(1, 1, At, B1); PG8_BAR; PG8_SCHED;
            } else {
            PG8_LDB(B0, 0, 0); PG8_SCHED; PG8_LDA(At, 0, 0); PG8_STAGE(PG8_SA(1, 1), a1 + hstep, voffA);
            PG8_WAIT_L(8); PG8_BAR; PG8_WAIT_L(0); PG8_MMA(0, 0, At, B0); PG8_BAR; PG8_SCHED;
            PG8_LDB(B1, 0, 1); PG8_STAGE(PG8_SB(0, 0), b2, voffB);
            PG8_BAR; PG8_WAIT_L(0); PG8_MMA(0, 1, At, B1); PG8_BAR;
            PG8_LDA(At, 0, 1); PG8_STAGE(PG8_SA(0, 0), a2, voffA);
            PG8_BAR; PG8_WAIT_L(0); PG8_MMA(1, 0, At, B0); PG8_BAR; PG8_SCHED;
            PG8_STAGE(PG8_SB(0, 1), b2 + hstep, voffB);
            PG8_WAIT_V(6); PG8_BAR; PG8_MMA(1, 1, At, B1); PG8_BAR;
            PG8_LDB(B0, 1, 0); PG8_SCHED; PG8_LDA(At, 1, 0); PG8_STAGE(PG8_SA(0, 1), a2 + hstep, voffA);
            PG8_WAIT_L(8); PG8_BAR; PG8_WAIT_L(0); PG8_MMA(0, 0, At, B0); PG8_BAR; PG8_SCHED;
            PG8_LDB(B1, 1, 1); PG8_STAGE(PG8_SB(1, 0), b3, voffB);
            PG8_BAR; PG8_WAIT_L(0); PG8_MMA(0, 1, At, B1); PG8_BAR;
            PG8_LDA(At, 1, 1); PG8_STAGE(PG8_SA(1, 0), a3, voffA);
            PG8_BAR; PG8_WAIT_L(0); PG8_MMA(1, 0, At, B0); PG8_BAR; PG8_SCHED;
            PG8_STAGE(PG8_SB(1, 1), b3 + hstep, voffB);
            PG8_WAIT_V(6); PG8_BAR; PG8_MMA(1, 1, At, B1); PG8_BAR;
            }
        }
        if constexpr (ALIGN_EPI) { if (wr == 0) PG8_BAR; }
        if constexpr (!Epi::AFTER_DRAIN) { E(acc, cur, wr, wc, fr, fq); S.done(cur); }
        if (!has_next) break;
#pragma unroll
        for (int a = 0; a < 2; ++a)
#pragma unroll
            for (int b = 0; b < 2; ++b)
#pragma unroll
                for (int m = 0; m < 4; ++m)
#pragma unroll
                    for (int n = 0; n < 2; ++n) acc[a][b][m][n] = (f32x4){0.f, 0.f, 0.f, 0.f};
        cur = nxt; cA = nA; cB = nB; ++ui;
        if constexpr (ALIGN_EPI) { if (wr == 1) PG8_BAR; }
    }
    PG8_WAIT_V(0);
    if constexpr (!ALIGN_EPI) { if (wr == 0) PG8_BAR; }
    PG8_BAR;
    if constexpr (Epi::AFTER_DRAIN) { E.fused(acc, cur, wr, wc, fr, fq, lds, wid, lane); S.done(cur); }
#undef PG8_SA
#undef PG8_SB
#undef PG8_STAGE
#undef PG8_LDA
#undef PG8_LDB
#undef PG8_MMA
#undef PG8_WAIT_V
#undef PG8_WAIT_L
#undef PG8_BAR
#undef PG8_SCHED
}
}
constexpr int NWAVES = 8;
constexpr int BATCH = 16, SEQ = 4096, D = 1024, DEPTH = 4;
constexpr int M = BATCH * SEQ;
constexpr int DIN = 3352, PS = 3584;
constexpr int DFF = 2816, NGU = 2 * DFF;
constexpr int C_HQ = 0, C_HF = 512, C_HI = 1024, C_HG = 1536, C_NQ = 2048, C_KC = 2560, C_VC = 2688, C_KS = 2816, C_VS = 2944, C_KW = 3072, C_VW = 3200, C_GT = 3328;
constexpr float LN_EPS = 1e-5f;
constexpr float ALPHA = 1.681792830507429f;
constexpr int NCMP = 255;

#ifndef MK_N_LAUNCHES
#define MK_N_LAUNCHES 1
#endif
constexpr int N_PHASES = 1 + 8 * DEPTH;
constexpr bool ONE_LAUNCH = (MK_N_LAUNCHES == 1);

constexpr size_t MiB = 1u << 20;
constexpr size_t WS_CTL = 0, CTL_ZERO_BYTES = 1 * MiB;
constexpr size_t WS_WIN = 2 * MiB, WS_WOUT = 30 * MiB, WS_WGU = 38 * MiB, WS_WDN = 82 * MiB;
constexpr size_t WS_KCMP = 104 * MiB, WS_VCMP = 105 * MiB;
constexpr size_t WS_XB = 112 * MiB, WS_MIX = 240 * MiB, WS_OPRE = 368 * MiB, WS_PROJ = 496 * MiB, WS_END = 944 * MiB;
constexpr int CW_TMO = 0, CW_CODE = 1, CW_BAR = 4096;

constexpr int RING_OFF = 0, RING_BYTES = 131072;
constexpr int LDSCTL_OFF = RING_BYTES, MISC_OFF = LDSCTL_OFF + 320;
constexpr int LDS_BYTES = 147456;

#define GAS __attribute__((address_space(1)))
#define LAS __attribute__((address_space(3)))
typedef unsigned short bf16;
typedef unsigned v4u __attribute__((ext_vector_type(4)));
typedef unsigned v2u __attribute__((ext_vector_type(2)));
typedef float f32x4 __attribute__((ext_vector_type(4)));
typedef GAS unsigned gu32;
#define RLX_AGENT __ATOMIC_RELAXED, __HIP_MEMORY_SCOPE_AGENT
#define LDS_WAIT() asm volatile("s_waitcnt lgkmcnt(0)" ::: "memory")
__device__ __forceinline__ unsigned f2bf(float f) { unsigned u = __builtin_bit_cast(unsigned, f); return (u + 0x7fffu + ((u >> 16) & 1u)) >> 16; }
__device__ __forceinline__ unsigned pk2(float lo, float hi) { return f2bf(lo) | (f2bf(hi) << 16); }
__device__ __forceinline__ float bf2f(unsigned h) { return __uint_as_float(h << 16); }
__device__ __forceinline__ float bflo(unsigned w) { return __uint_as_float(w << 16); }
__device__ __forceinline__ float bfhi(unsigned w) { return __uint_as_float(w & 0xffff0000u); }
__device__ __forceinline__ float wave_sum(float v) {
#pragma unroll
    for (int o = 1; o < 64; o <<= 1) v += __shfl_xor(v, o);
    return v;
}
__device__ __forceinline__ float wave_max(float v) {
#pragma unroll
    for (int o = 1; o < 64; o <<= 1) v = fmaxf(v, __shfl_xor(v, o));
    return v;
}
__device__ __forceinline__ float sigmoidf_(float x) { return 1.0f / (1.0f + __expf(-x)); }
__device__ __forceinline__ float gelu_tanh(float x) { const float u = 0.7978845608028654f * (x + 0.044715f * x * x * x); return 0.5f * x * (1.0f + tanhf(u)); }

#define XB_TMO      128
#define XB_XCNT(j)  (256  + 64 * (j))
#define XB_XSUB(j)  (1280 + 64 * (j))
#define XB_XGEN(j)  (2304 + 64 * (j))
#define XB_TOP      3328
#define XB_TOPGEN   3392
#define XCD_BAR_WORDS 3456
#define XB_SPIN_CAP (1u << 18)

__device__ __forceinline__ unsigned xb_ld(unsigned* p)              { return __hip_atomic_load(p, __ATOMIC_RELAXED, __HIP_MEMORY_SCOPE_AGENT); }
__device__ __forceinline__ unsigned xb_add(unsigned* p, unsigned v) { return __hip_atomic_fetch_add(p, v, __ATOMIC_RELAXED, __HIP_MEMORY_SCOPE_AGENT); }
__device__ __forceinline__ unsigned xb_xcc_id() { return (unsigned)__builtin_amdgcn_s_getreg((3 << 11) | 20) & 0xFu; }
#define XB_SPIN(cond, bar) do { unsigned _sp = 0; while (cond) { __builtin_amdgcn_s_sleep(1); \
    if ((++_sp & 255u) == 0u) { if (xb_ld(&(bar)[XB_TMO])) break; if (_sp > XB_SPIN_CAP) { atomicAdd(&(bar)[XB_TMO], 1u); break; } } } } while (0)

struct XcdBarrier {
    unsigned* bar; unsigned x;
    volatile LAS unsigned* st;
};

__device__ __forceinline__ XcdBarrier xcd_barrier_post(unsigned* bar, volatile LAS unsigned* st) {
    XcdBarrier b; b.bar = bar; b.x = xb_xcc_id(); b.st = st;
    if (threadIdx.x == 0) (void)xb_add(&bar[XB_XCNT(b.x)], 1u);
    return b;
}
__device__ __forceinline__ void xcd_barrier_complete(unsigned* bar, unsigned x, unsigned& nloc, unsigned& nx) {
    const unsigned G = gridDim.x * gridDim.y * gridDim.z;
    unsigned sum, cnt, mine, sp = 0u;
    for (;;) {
        sum = 0u; cnt = 0u; mine = 0u;
#pragma unroll
        for (unsigned j = 0; j < 16; ++j) { const unsigned c = xb_ld(&bar[XB_XCNT(j)]); sum += c; cnt += (c > 0u) ? 1u : 0u; mine = (j == x) ? c : mine; }
        if (sum == G) break;
        __builtin_amdgcn_s_sleep(1);
        if ((++sp & 255u) == 0u) { if (xb_ld(&bar[XB_TMO])) break; if (sp > XB_SPIN_CAP) { atomicAdd(&bar[XB_TMO], 1u); break; } }
    }
    nloc = mine > 0u ? mine : 1u; nx = cnt > 0u ? cnt : 1u;
}

__device__ __forceinline__ void xcd_barrier(const XcdBarrier& b) {
    asm volatile("s_waitcnt vmcnt(0)" ::: "memory");
    __syncthreads();
    if (threadIdx.x == 0) {
        unsigned* bar = b.bar;
        __builtin_amdgcn_s_waitcnt(0);
        unsigned nloc = b.st[0], nx = b.st[1];
        if (nloc == 0u) { xcd_barrier_complete(bar, b.x, nloc, nx); b.st[0] = nloc; b.st[1] = nx; }
        const unsigned old = xb_add(&bar[XB_XSUB(b.x)], 1u);
        const unsigned gen = old / nloc;
        if (old + 1u == (gen + 1u) * nloc) {
            __builtin_amdgcn_fence(__ATOMIC_RELEASE, "agent");
            asm volatile("s_waitcnt vmcnt(0)" ::: "memory");
            const unsigned og = xb_add(&bar[XB_TOP], 1u);
            const unsigned tg = og / nx;
            if (og + 1u == (tg + 1u) * nx) xb_add(&bar[XB_TOPGEN], 1u);
            else XB_SPIN(xb_ld(&bar[XB_TOPGEN]) == tg, bar);
            __builtin_amdgcn_fence(__ATOMIC_ACQUIRE, "agent");
            xb_add(&bar[XB_XGEN(b.x)], 1u);
            asm volatile("s_waitcnt vmcnt(0)" ::: "memory");
        } else {
            XB_SPIN(xb_ld(&bar[XB_XGEN(b.x)]) == gen, bar);
            __builtin_amdgcn_fence(__ATOMIC_ACQUIRE, "agent");
            asm volatile("s_waitcnt vmcnt(0)" ::: "memory");
        }
    }
    __syncthreads();
}

struct Ctx {
    LAS unsigned char* lds;
    int tid, lane, wave, vcu, G;
    const float *x, *w_in, *lb_param, *norm_w, *pos_k, *w1_k, *w2_k, *pos_v, *w1_v, *w2_v, *rel_bias, *w_out, *ln1_g, *ln1_b, *w_gate, *w_up, *w_down, *ln2_g, *ln2_b;
    float* out;
    bf16 *win_t, *wout_t, *wgu_t, *wdn_t, *kcmp, *vcmp, *xb, *mix, *proj;
    float* opre;
};

__device__ __forceinline__ void transpose_item(const float* W, int K, int N, bf16* WT, int dst_row0, LAS float* scr, int k0, int n0, int lane) {
#pragma unroll 8
    for (int i = 0; i < 32; ++i) { const int kk = 2 * i + (lane >> 5); const int n = n0 + (lane & 31); scr[kk * 33 + (lane & 31)] = (n < N) ? W[(size_t)(k0 + kk) * N + n] : 0.f; }
    LDS_WAIT(); asm volatile("" ::: "memory");
    const int c = lane & 7;
#pragma unroll
    for (int j = 0; j < 4; ++j) { const int n = (lane >> 3) + 8 * j; const LAS float* s = scr + (8 * c) * 33 + n;
        v4u o; o.x = pk2(s[0 * 33], s[1 * 33]); o.y = pk2(s[2 * 33], s[3 * 33]); o.z = pk2(s[4 * 33], s[5 * 33]); o.w = pk2(s[6 * 33], s[7 * 33]);
        *(v4u*)(WT + (size_t)(dst_row0 + n) * K + k0 + 8 * c) = o; }
    LDS_WAIT(); asm volatile("" ::: "memory");
}
__device__ __forceinline__ void p_prologue(const Ctx& F) {
    LAS float* scr = (LAS float*)(F.lds + RING_OFF + F.wave * 16384);
    const int gw = F.vcu * NWAVES + F.wave, NGW = F.G * NWAVES;
    constexpr int I_IN = (D / 64) * (PS / 32), I_OUT = (D / 64) * (D / 32), I_G = (D / 64) * (DFF / 32), I_DN = (DFF / 64) * (D / 32);
    constexpr int PER_L = I_IN + I_OUT + 2 * I_G + I_DN;
    for (int it = gw; it < PER_L * DEPTH; it += NGW) {
        const int l = it / PER_L; int r = it % PER_L;
        if (r < I_IN) { const int nb = r % (PS / 32), kb = r / (PS / 32); transpose_item(F.w_in + (size_t)l * D * DIN, D, DIN, F.win_t + (size_t)l * PS * D, 32 * nb, scr, 64 * kb, 32 * nb, F.lane); continue; } r -= I_IN;
        if (r < I_OUT) { const int nb = r % (D / 32), kb = r / (D / 32); transpose_item(F.w_out + (size_t)l * D * D, D, D, F.wout_t + (size_t)l * D * D, 32 * nb, scr, 64 * kb, 32 * nb, F.lane); continue; } r -= I_OUT;
        if (r < 2 * I_G) { const int up = r >= I_G; if (up) r -= I_G; const int nb = r % (DFF / 32), kb = r / (DFF / 32); const int n0 = 32 * nb;
            transpose_item((up ? F.w_up : F.w_gate) + (size_t)l * D * DFF, D, DFF, F.wgu_t + (size_t)l * NGU * D, (n0 / 128) * 256 + (up ? 128 : 0) + (n0 % 128), scr, 64 * kb, n0, F.lane); continue; } r -= 2 * I_G;
        { const int nb = r % (D / 32), kb = r / (D / 32); transpose_item(F.w_down + (size_t)l * DFF * D, DFF, D, F.wdn_t + (size_t)l * D * DFF, 32 * nb, scr, 64 * kb, 32 * nb, F.lane); }
    }
    for (int m = gw; m < M; m += NGW) {
        const f32x4* xr = (const f32x4*)(F.x + (size_t)m * D) + F.lane; v2u* o8 = (v2u*)(F.xb + (size_t)m * D) + F.lane;
#pragma unroll
        for (int j = 0; j < 4; ++j) { const f32x4 v = xr[64 * j]; v2u w; w.x = pk2(v.x, v.y); w.y = pk2(v.z, v.w); o8[64 * j] = w; }
    }
}

__device__ __forceinline__ void p_layernorm(const Ctx& F, const float* gam, const float* bet) {
    const int gw = F.vcu * NWAVES + F.wave, NGW = F.G * NWAVES;
    f32x4 gv[4], bv[4];
#pragma unroll
    for (int j = 0; j < 4; ++j) { gv[j] = ((const f32x4*)gam)[F.lane + 64 * j]; bv[j] = ((const f32x4*)bet)[F.lane + 64 * j]; }
    for (int m = gw; m < M; m += NGW) {
        f32x4* xr = (f32x4*)(F.out + (size_t)m * D) + F.lane; v2u* o8 = (v2u*)(F.xb + (size_t)m * D) + F.lane;
        f32x4 v[4]; float s = 0.f;
#pragma unroll
        for (int j = 0; j < 4; ++j) { v[j] = xr[64 * j]; s += (v[j].x + v[j].y) + (v[j].z + v[j].w); }
        const float mean = wave_sum(s) * (1.f / D); float s2 = 0.f;
#pragma unroll
        for (int j = 0; j < 4; ++j) { v[j] = v[j] - mean; s2 += (v[j].x * v[j].x + v[j].y * v[j].y) + (v[j].z * v[j].z + v[j].w * v[j].w); }
        const float rstd = 1.f / sqrtf(wave_sum(s2) * (1.f / D) + LN_EPS);
#pragma unroll
        for (int j = 0; j < 4; ++j) { const f32x4 o = v[j] * rstd * gv[j] + bv[j]; xr[64 * j] = o; v2u w; w.x = pk2(o.x, o.y); w.y = pk2(o.z, o.w); o8[64 * j] = w; }
    }
}

__device__ __forceinline__ void hgrn_scan_unit(const Ctx& F, int l, int u) {
    constexpr int TT = 16;
    const int b = u >> 4, h = (u >> 2) & 3, dvs = u & 3;
    LAS float* qs = (LAS float*)(F.lds + RING_OFF);
    LAS float* fs = qs + TT * 128;
    LAS float* vs = fs + TT * 128;
    LAS float* part = vs + TT * 32;
    LAS float* lbs = part + TT * 16 * 32;
    const int tid = F.tid, dv = tid & 31, kg = tid >> 5;
    if (tid < 128) {
        const int c = h * 128 + tid; float p[DEPTH], mx = -1e30f;
#pragma unroll
        for (int i = 0; i < DEPTH; ++i) { p[i] = F.lb_param[i * 512 + c]; mx = fmaxf(mx, p[i]); }
        float sum = 0.f, acc = 0.f;
#pragma unroll
        for (int i = 0; i < DEPTH; ++i) { p[i] = expf(p[i] - mx); sum += p[i]; }
#pragma unroll
        for (int i = 1; i < DEPTH; ++i) { if (i <= l) acc += p[i]; }
        lbs[tid] = acc / sum;
    }
    __syncthreads();
    float S[8];
#pragma unroll
    for (int j = 0; j < 8; ++j) S[j] = 0.f;
    const bf16* P = F.proj + (size_t)b * SEQ * PS;
    const int lr = tid >> 5, lc = tid & 31;
    for (int t0 = 0; t0 < SEQ; t0 += TT) {
        {   const bf16* row = P + (size_t)(t0 + lr) * PS;
            const v2u qw = *(const v2u*)(row + C_HQ + h * 128 + lc * 4), fw = *(const v2u*)(row + C_HF + h * 128 + lc * 4);
            f32x4 qv = {bflo(qw.x), bfhi(qw.x), bflo(qw.y), bfhi(qw.y)}, zv = {bflo(fw.x), bfhi(fw.x), bflo(fw.y), bfhi(fw.y)};
            const f32x4 lbv = *(LAS f32x4*)(lbs + lc * 4); f32x4 fv;
            fv.x = lbv.x + (1.f - lbv.x) * sigmoidf_(zv.x); fv.y = lbv.y + (1.f - lbv.y) * sigmoidf_(zv.y); fv.z = lbv.z + (1.f - lbv.z) * sigmoidf_(zv.z); fv.w = lbv.w + (1.f - lbv.w) * sigmoidf_(zv.w);
            *(LAS f32x4*)(qs + lr * 128 + lc * 4) = qv; *(LAS f32x4*)(fs + lr * 128 + lc * 4) = fv;
            vs[lr * 32 + lc] = bf2f(row[C_HI + h * 128 + dvs * 32 + lc]);
        }
        __syncthreads();
#pragma unroll 4
        for (int tt = 0; tt < TT; ++tt) {
            const float v = vs[tt * 32 + dv];
            const f32x4 f0 = *(LAS f32x4*)(fs + tt * 128 + kg * 8), f1 = *(LAS f32x4*)(fs + tt * 128 + kg * 8 + 4);
            const f32x4 q0 = *(LAS f32x4*)(qs + tt * 128 + kg * 8), q1 = *(LAS f32x4*)(qs + tt * 128 + kg * 8 + 4);
            float o = 0.f;
            S[0] = f0.x * S[0] + (1.f - f0.x) * v; o += q0.x * S[0];
            S[1] = f0.y * S[1] + (1.f - f0.y) * v; o += q0.y * S[1];
            S[2] = f0.z * S[2] + (1.f - f0.z) * v; o += q0.z * S[2];
            S[3] = f0.w * S[3] + (1.f - f0.w) * v; o += q0.w * S[3];
            S[4] = f1.x * S[4] + (1.f - f1.x) * v; o += q1.x * S[4];
            S[5] = f1.y * S[5] + (1.f - f1.y) * v; o += q1.y * S[5];
            S[6] = f1.z * S[6] + (1.f - f1.z) * v; o += q1.z * S[6];
            S[7] = f1.w * S[7] + (1.f - f1.w) * v; o += q1.w * S[7];
            part[(tt * 16 + kg) * 32 + dv] = o;
        }
        __syncthreads();
        {   const int tt = tid >> 5; float o = 0.f;
#pragma unroll
            for (int k = 0; k < 16; ++k) o += part[(tt * 16 + k) * 32 + dv];
            F.opre[(size_t)(b * SEQ + t0 + tt) * 512 + h * 128 + dvs * 32 + dv] = o;
        }
    }
    __syncthreads();
}
__device__ __forceinline__ void hgrn_finalize(const Ctx& F, int l) {
    const int gw = F.vcu * NWAVES + F.wave, NGW = F.G * NWAVES;
    const float* nw = F.norm_w + l * 128 + (F.lane & 15) * 8;
    float w[8];
#pragma unroll
    for (int i = 0; i < 8; ++i) w[i] = nw[i];
    for (int m = gw; m < M; m += NGW) {
        const f32x4* op = (const f32x4*)(F.opre + (size_t)m * 512 + F.lane * 8);
        const f32x4 a = op[0], c = op[1];
        float o[8] = {a.x, a.y, a.z, a.w, c.x, c.y, c.z, c.w};
        float ss = 0.f;
#pragma unroll
        for (int i = 0; i < 8; ++i) ss += o[i] * o[i];
        ss += __shfl_xor(ss, 1); ss += __shfl_xor(ss, 2); ss += __shfl_xor(ss, 4); ss += __shfl_xor(ss, 8);
        const float r = 1.0f / sqrtf(ss * (1.f / 128.f) + 1e-6f);
        const v4u gw4 = *(const v4u*)(F.proj + (size_t)m * PS + C_HG + F.lane * 8);
        const float g[8] = {bflo(gw4.x), bfhi(gw4.x), bflo(gw4.y), bfhi(gw4.y), bflo(gw4.z), bfhi(gw4.z), bflo(gw4.w), bfhi(gw4.w)};
        float y[8];
#pragma unroll
        for (int i = 0; i < 8; ++i) y[i] = o[i] * r * w[i] * (g[i] * sigmoidf_(g[i]));
        v4u ov; ov.x = pk2(y[0], y[1]); ov.y = pk2(y[2], y[3]); ov.z = pk2(y[4], y[5]); ov.w = pk2(y[6], y[7]);
        *(v4u*)(F.mix + (size_t)m * D + F.lane * 8) = ov;
    }
}

__device__ __forceinline__ void cmp_unit(const Ctx& F, int l, int cu) {
    const int b = cu >> 6, g = (cu >> 5) & 1, kv = (cu >> 4) & 1, nb = cu & 15, n0 = nb * 16;
    LAS float* X = (LAS float*)(F.lds + RING_OFF);
    LAS float* posl = X + 272 * 64;
    LAS float* hid = posl + 32 * 64;
    const int tid = F.tid;
    const bf16* P = F.proj + (size_t)b * SEQ * PS + (kv ? C_VC : C_KC) + g * 64;
    const float* pos = (kv ? F.pos_v : F.pos_k) + (size_t)l * 32 * 64;
    const float* W1 = (kv ? F.w1_v : F.w1_k) + (size_t)l * 2048 * 128;
    const float* W2 = (kv ? F.w2_v : F.w2_k) + (size_t)l * 128 * 64;
    for (int i = tid; i < 272 * 16; i += 512) { const int r = i >> 4, c4 = (i & 15) * 4, t = n0 * 16 + r;
        f32x4 v = {0.f, 0.f, 0.f, 0.f};
        if (t < SEQ) { const v2u w = *(const v2u*)(P + (size_t)t * PS + c4); v = (f32x4){bflo(w.x), bfhi(w.x), bflo(w.y), bfhi(w.y)}; }
        *(LAS f32x4*)(X + r * 64 + c4) = v; }
    for (int i = tid; i < 32 * 64; i += 512) posl[i] = pos[i];
    __syncthreads();
    const int j = tid & 127, nq = tid >> 7;
    float acc[4] = {0.f, 0.f, 0.f, 0.f}, pacc = 0.f;
    for (int p = 0; p < 32; ++p) {
#pragma unroll 2
        for (int d = 0; d < 64; d += 4) {
            const float* wp = W1 + (size_t)(p * 64 + d) * 128 + j;
            const float w0 = wp[0], w1 = wp[128], w2 = wp[256], w3 = wp[384];
            const f32x4 pv = *(LAS f32x4*)(posl + p * 64 + d);
            pacc += pv.x * w0 + pv.y * w1 + pv.z * w2 + pv.w * w3;
#pragma unroll
            for (int i = 0; i < 4; ++i) { const f32x4 xv = *(LAS f32x4*)(X + ((nq * 4 + i) * 16 + p) * 64 + d); acc[i] += xv.x * w0 + xv.y * w1 + xv.z * w2 + xv.w * w3; }
        }
    }
#pragma unroll
    for (int i = 0; i < 4; ++i) hid[(nq * 4 + i) * 128 + j] = gelu_tanh(acc[i] + pacc);
    __syncthreads();
    bf16* O = (kv ? F.vcmp : F.kcmp) + (size_t)(b * 2 + g) * 256 * 64;
    const int c = tid & 63;
#pragma unroll
    for (int r = 0; r < 2; ++r) { const int nl = (tid >> 6) + 8 * r; float o = 0.f;
        for (int jj = 0; jj < 128; ++jj) o += hid[nl * 128 + jj] * W2[jj * 64 + c];
        const int n = n0 + nl; O[(size_t)n * 64 + c] = (bf16)((n < NCMP) ? f2bf(o) : 0u); }
    __syncthreads();
}

__device__ __forceinline__ int t5_bucket(int n) {
    if (n < 16) return n;
    int b = 16;
    b += (n >= 19); b += (n >= 21); b += (n >= 24); b += (n >= 27); b += (n >= 31); b += (n >= 35); b += (n >= 40); b += (n >= 46);
    b += (n >= 52); b += (n >= 59); b += (n >= 67); b += (n >= 77); b += (n >= 87); b += (n >= 99); b += (n >= 113);
    return b;
}
__device__ __forceinline__ void build_bias_table(const Ctx& F, LAS float* tab) {
    for (int i = F.tid; i < 8 * 129; i += NWAVES * 64) { const int h = i / 129, n = i % 129; tab[h * 132 + n] = F.rel_bias[t5_bucket(n) * 8 + h]; }
}
__device__ __forceinline__ void dot4(const bf16* krow, const LAS float* qf, float (&s)[4]) {
    s[0] = s[1] = s[2] = s[3] = 0.f;
#pragma unroll 2
    for (int i = 0; i < 8; ++i) {
        asm volatile("" ::: "memory");
        const v4u kv = *(const v4u*)(krow + 8 * i);
        const float k0 = bflo(kv.x), k1 = bfhi(kv.x), k2 = bflo(kv.y), k3 = bfhi(kv.y), k4 = bflo(kv.z), k5 = bfhi(kv.z), k6 = bflo(kv.w), k7 = bfhi(kv.w);
#pragma unroll
        for (int h = 0; h < 4; ++h) { const f32x4 qa = *(const LAS f32x4*)(qf + h * 64 + 8 * i), qb = *(const LAS f32x4*)(qf + h * 64 + 8 * i + 4);
            s[h] += k0 * qa.x + k1 * qa.y + k2 * qa.z + k3 * qa.w + k4 * qb.x + k5 * qb.y + k6 * qb.z + k7 * qb.w; }
    }
}
template <int MODE>
__device__ __forceinline__ void nsa_branch(const bf16* Kb, const bf16* Vb, int pitch, int nblk, unsigned long long sel, int t, int lim,
                                           const LAS float* qf, const LAS float* tab, LAS float* pe, int lane, float (&o)[4]) {
    float mx[4], lp[4];
#pragma unroll
    for (int h = 0; h < 4; ++h) { mx[h] = -INFINITY; lp[h] = 0.f; o[h] = 0.f; }
#pragma unroll 1
    for (int c = (MODE == 2 && t < 511) ? ((511 - t) >> 6) : 0; c < nblk; ++c) {
        int row0;
        if (MODE == 0) row0 = 64 * c; else if (MODE == 1) { row0 = 64 * (int)__builtin_ctzll(sel); sel &= sel - 1; } else row0 = t - 511 + 64 * c;
        const int key = row0 + lane; bool valid; int dist;
        if (MODE == 0) { valid = key < lim; dist = t - (16 * key + 31); } else { valid = (key >= 0) && (key <= t); dist = t - key; }
        const int krow = key < 0 ? 0 : key;
        float d4[4]; dot4(Kb + (size_t)krow * pitch, qf, d4);
        const int di = dist < 0 ? 0 : (dist > 128 ? 128 : dist);
        float e[4];
#pragma unroll
        for (int h = 0; h < 4; ++h) {
            const float sv = valid ? d4[h] + tab[h * 132 + di] : -INFINITY;
            if (MODE == 0) pe[h * 256 + key] = sv;
            const float mn = fmaxf(mx[h], wave_max(sv));
            const float scl = (mx[h] == mn) ? 1.f : __expf(mx[h] - mn);
            e[h] = valid ? __expf(sv - mn) : 0.f; lp[h] = lp[h] * scl + e[h]; o[h] *= scl; mx[h] = mn;
        }
#pragma unroll 2
        for (int kk = 0; kk < 64; ++kk) {
            int row = row0 + kk; row = row < 0 ? 0 : row;
            const float v = bf2f(Vb[(size_t)row * pitch + lane]);
#pragma unroll
            for (int h = 0; h < 4; ++h) o[h] += __int_as_float(__builtin_amdgcn_readlane(__float_as_int(e[h]), kk)) * v;
        }
    }
#pragma unroll
    for (int h = 0; h < 4; ++h) { lp[h] = 1.0f / wave_sum(lp[h]); o[h] *= lp[h]; }
    if (MODE == 0) {
        LDS_WAIT(); asm volatile("" ::: "memory");
#pragma unroll
        for (int c = 0; c < 4; ++c)
#pragma unroll
            for (int h = 0; h < 4; ++h) { const int n = 64 * c + lane; const float sv = (c < nblk) ? pe[h * 256 + n] : -INFINITY; pe[h * 256 + n] = __expf(sv - mx[h]) * lp[h]; }
    }
}
__device__ __forceinline__ void nsa_attn_phase(const Ctx& F, int l) {
    LAS float* tab = (LAS float*)(F.lds + RING_OFF);
    LAS float* qf = tab + 8 * 132 + F.wave * 64 * 4;
    LAS float* pe = tab + 8 * 132 + NWAVES * 256 + F.wave * 1024;
    build_bias_table(F, tab);
    __syncthreads();
    const int gw = F.vcu * NWAVES + F.wave, NGW = F.G * NWAVES, lane = F.lane;
    for (int idx = gw; idx < M * 2; idx += NGW) {
        const int g = idx & 1, m = idx >> 1, b = m >> 12, t = m & (SEQ - 1);
        const bf16* prow = F.proj + (size_t)m * PS;
        const LAS float* tg = tab + g * 4 * 132;
#pragma unroll
        for (int h = 0; h < 4; ++h) qf[h * 64 + lane] = 0.125f * bf2f(prow[C_NQ + (g * 4 + h) * 64 + lane]);
        LDS_WAIT(); asm volatile("" ::: "memory");
        const bf16* P0 = F.proj + (size_t)b * SEQ * PS;
        float oc[4] = {0.f, 0.f, 0.f, 0.f};
        const int nv = (t >= 31) ? ((t - 31) >> 4) + 1 : 0;
        if (nv > 0) {
            nsa_branch<0>(F.kcmp + (size_t)(b * 2 + g) * 256 * 64, F.vcmp + (size_t)(b * 2 + g) * 256 * 64, 64, (nv + 63) >> 6, 0ull, t, nv, qf, tg, pe, lane, oc);
            LDS_WAIT(); asm volatile("" ::: "memory");
        }
        const int cur = t >> 6;
        float imp = 0.f;
        if (nv > 0) {
#pragma unroll
            for (int k = -1; k <= 3; ++k) { const int n = 4 * lane + k; if (n >= 0 && n < NCMP) { const float p = pe[n] + pe[256 + n] + pe[512 + n] + pe[768 + n]; imp += (k >= 0 && k <= 2) ? 2.f * p : p; } }
        }
        const bool causal = lane <= cur, forced = (lane == 0) || (lane == cur) || (lane + 1 == cur);
        const float sc = forced ? 1e9f : (causal ? imp : -1e9f);
        int cnt = 0;
        for (int i = 0; i < 64; ++i) { const float o = __int_as_float(__builtin_amdgcn_readlane(__float_as_int(sc), i)); cnt += ((o > sc) || (o == sc && i < lane)) ? 1 : 0; }
        unsigned long long sel = __ballot((cnt < 16) && causal);
        float os[4];
        nsa_branch<1>(P0 + C_KS + g * 64, P0 + C_VS + g * 64, PS, __builtin_popcountll(sel), sel, t, 0, qf, tg, nullptr, lane, os);
        float ow[4];
        nsa_branch<2>(P0 + C_KW + g * 64, P0 + C_VW + g * 64, PS, 8, 0ull, t, 0, qf, tg, nullptr, lane, ow);
#pragma unroll
        for (int h = 0; h < 4; ++h) {
            const float gc = sigmoidf_(bf2f(prow[C_GT + 0 + g * 4 + h])), gs = sigmoidf_(bf2f(prow[C_GT + 8 + g * 4 + h])), gwn = sigmoidf_(bf2f(prow[C_GT + 16 + g * 4 + h]));
            F.mix[(size_t)m * D + 512 + (g * 4 + h) * 64 + lane] = (bf16)f2bf(gc * oc[h] + gs * os[h] + gwn * ow[h]);
        }
    }
    __syncthreads();
}

struct Args { const float* in[19]; float* out; unsigned char* ws; int ph_lo, ph_hi; };
__global__ void __launch_bounds__(NWAVES * 64, 2) fwd(Args args) {
    extern __shared__ __attribute__((aligned(16))) unsigned char lds[];
    Ctx F;
    F.lds = (LAS unsigned char*)lds;
    volatile LAS unsigned* MISC = (volatile LAS unsigned*)(F.lds + MISC_OFF);
    F.tid = threadIdx.x; F.lane = F.tid & 63; F.wave = __builtin_amdgcn_readfirstlane(F.tid >> 6);
    F.G = gridDim.x; { const int bx = blockIdx.x; F.vcu = (F.G % 8 == 0) ? (bx % 8) * (F.G / 8) + bx / 8 : bx; }
    unsigned char* ws = args.ws;
    gu32* ctl = (gu32*)(ws + WS_CTL);
    F.x = args.in[0]; F.w_in = args.in[1]; F.lb_param = args.in[2]; F.norm_w = args.in[3]; F.pos_k = args.in[4]; F.w1_k = args.in[5]; F.w2_k = args.in[6];
    F.pos_v = args.in[7]; F.w1_v = args.in[8]; F.w2_v = args.in[9]; F.rel_bias = args.in[10]; F.w_out = args.in[11]; F.ln1_g = args.in[12]; F.ln1_b = args.in[13];
    F.w_gate = args.in[14]; F.w_up = args.in[15]; F.w_down = args.in[16]; F.ln2_g = args.in[17]; F.ln2_b = args.in[18]; F.out = args.out;
    F.win_t = (bf16*)(ws + WS_WIN); F.wout_t = (bf16*)(ws + WS_WOUT); F.wgu_t = (bf16*)(ws + WS_WGU); F.wdn_t = (bf16*)(ws + WS_WDN);
    F.kcmp = (bf16*)(ws + WS_KCMP); F.vcmp = (bf16*)(ws + WS_VCMP); F.xb = (bf16*)(ws + WS_XB); F.mix = (bf16*)(ws + WS_MIX); F.proj = (bf16*)(ws + WS_PROJ);
    F.opre = (float*)(ws + WS_OPRE);
    for (int u = F.tid; u < (LDS_BYTES - LDSCTL_OFF) / 4; u += NWAVES * 64) ((LAS unsigned*)(F.lds + LDSCTL_OFF))[u] = 0u;
    __syncthreads();
    XcdBarrier bar; bar.bar = (unsigned*)(ctl + CW_BAR); bar.x = 0; bar.st = nullptr;
    if (ONE_LAUNCH) bar = xcd_barrier_post((unsigned*)(ctl + CW_BAR), MISC + 8);
    const int lo = args.ph_lo, hi = args.ph_hi;
#define IN(k) (lo <= (k) && (k) < hi)
#define FRESH() do { int t_ = threadIdx.x; asm volatile("" : "+v"(t_)); F.tid = t_; F.lane = t_ & 63; } while (0)
#define SEAM(k) do { if (IN(k) && IN((k) + 1)) { if (ONE_LAUNCH) xcd_barrier(bar); } } while (0)

    if (IN(0)) { p_prologue(F); } SEAM(0);
    for (int l = 0; l < DEPTH; ++l) {
        const int p0 = 1 + 8 * l;
        const float* xin = (l == 0) ? F.x : F.out;
        if (IN(p0 + 0)) {
            pg8::Gemm g{F.xb, F.win_t + (size_t)l * PS * D, M, PS, D}; pg8::StaticOrder S; S.init(M, PS, F.G, (int)blockIdx.x);
            pg8::EpiBf16<0> E{F.proj, PS, nullptr, 0, 0, 1.f};
            pg8::gemm_phase<pg8::EpiBf16<0>, pg8::StaticOrder, true, true>(F.lds + RING_OFF, g, S, E);
        } SEAM(p0 + 0);
        if (IN(p0 + 1)) { FRESH();
            for (int u = F.vcu; u < 256; u += F.G) hgrn_scan_unit(F, l, u);
            for (int cu = F.vcu; cu < 1024; cu += F.G) cmp_unit(F, l, cu);
        } SEAM(p0 + 1);
        if (IN(p0 + 2)) { FRESH();
            hgrn_finalize(F, l);
            FRESH(); nsa_attn_phase(F, l);
        } SEAM(p0 + 2);
        if (IN(p0 + 3)) {
            pg8::Gemm g{F.mix, F.wout_t + (size_t)l * D * D, M, D, D}; pg8::StaticOrder S; S.init(M, D, F.G, (int)blockIdx.x);
            pg8::EpiResid E{xin, F.out, D, ALPHA};
            pg8::gemm_phase<pg8::EpiResid, pg8::StaticOrder, true, true>(F.lds + RING_OFF, g, S, E);
        } SEAM(p0 + 3);
        if (IN(p0 + 4)) { FRESH(); p_layernorm(F, F.ln1_g + l * D, F.ln1_b + l * D); } SEAM(p0 + 4);
        if (IN(p0 + 5)) {
            pg8::Gemm g{F.xb, F.wgu_t + (size_t)l * NGU * D, M, NGU, D}; pg8::StaticOrder S; S.init(M, NGU, F.G, (int)blockIdx.x);
            pg8::EpiSwiGLU E{F.proj, DFF};
            pg8::gemm_phase<pg8::EpiSwiGLU, pg8::StaticOrder, true, true>(F.lds + RING_OFF, g, S, E);
        } SEAM(p0 + 5);
        if (IN(p0 + 6)) {
            pg8::Gemm g{F.proj, F.wdn_t + (size_t)l * D * DFF, M, D, DFF}; pg8::StaticOrder S; S.init(M, D, F.G, (int)blockIdx.x);
            pg8::EpiResid E{F.out, F.out, D, ALPHA};
            pg8::gemm_phase<pg8::EpiResid, pg8::StaticOrder, true, true>(F.lds + RING_OFF, g, S, E);
        } SEAM(p0 + 6);
        if (IN(p0 + 7)) { FRESH(); p_layernorm(F, F.ln2_g + l * D, F.ln2_b + l * D); } SEAM(p0 + 7);
    }
#undef IN
#undef SEAM
}

extern "C" void kernel_launch(void* const* d_in, const int* in_sizes, int n_in, void* d_out, int out_size, void* d_ws, size_t ws_size, hipStream_t stream) {
    static int grid = 0;
    if (grid == 0) {
        if (n_in != 19 || in_sizes[0] != M * D || out_size != M * D || ws_size < WS_END) { fprintf(stderr, "kernel_launch: unexpected shapes (n_in %d, in0 %d, out %d, ws %zu); nothing launched\n", n_in, n_in > 0 ? in_sizes[0] : -1, out_size, ws_size); grid = -1; return; }
        int dev = 0, cus = 0, per_cu = 0;
        if (hipGetDevice(&dev) != hipSuccess || hipDeviceGetAttribute(&cus, hipDeviceAttributeMultiprocessorCount, dev) != hipSuccess) { grid = -1; return; }
        if (hipFuncSetAttribute((const void*)fwd, hipFuncAttributeMaxDynamicSharedMemorySize, LDS_BYTES) != hipSuccess) { fprintf(stderr, "kernel_launch: hipFuncSetAttribute failed\n"); grid = -1; return; }
        if (hipOccupancyMaxActiveBlocksPerMultiprocessor(&per_cu, (const void*)fwd, NWAVES * 64, LDS_BYTES) != hipSuccess || per_cu < 1) fprintf(stderr, "kernel_launch: note: occupancy query reports %d\n", per_cu);
        (void)hipGetLastError();
        grid = cus;
    }
    if (grid < 0) return;
    if (hipMemsetAsync((char*)d_ws + WS_CTL, 0, CTL_ZERO_BYTES, stream) != hipSuccess) return;
    Args a{};
    for (int i = 0; i < 19; ++i) a.in[i] = (const float*)d_in[i];
    a.out = (float*)d_out; a.ws = (unsigned char*)d_ws;
    if (ONE_LAUNCH) { a.ph_lo = 0; a.ph_hi = N_PHASES; hipLaunchKernelGGL(fwd, dim3(grid), dim3(NWAVES * 64), LDS_BYTES, stream, a); }
    else { for (int p = 0; p < N_PHASES; ++p) { a.ph_lo = p; a.ph_hi = p + 1; hipLaunchKernelGGL(fwd, dim3(grid), dim3(NWAVES * 64), LDS_BYTES, stream, a); } }
}
```

```cpp
#define MK_N_LAUNCHES 1
#include <hip/hip_runtime.h>
#include <cstdio>
#include <cstdint>
#include <cmath>
namespace pg8 {
#define PG8_LAS __attribute__((address_space(3)))
typedef unsigned short bf16_t;
typedef short bf16x8 __attribute__((ext_vector_type(8)));
typedef float f32x4 __attribute__((ext_vector_type(4)));
typedef unsigned u32x4 __attribute__((ext_vector_type(4)));
constexpr int BM = 256, BK = 64, HALF = 128, HTB = HALF * BK * 2  , STAGE_BYTES = 8 * HTB, NXCD = 8, WGM = 8;

__host__ __device__ __forceinline__ int lds_byte(int r, int c) { const int st = (r >> 4) * 2 + (c >> 5), rr = r & 15, cc = c & 31, ob = rr * 64 + cc * 2; return st * 1024 + (ob ^ (((ob >> 9) & 1) << 5)); }
__host__ __device__ __forceinline__ void stage_rc(int b, int& R, int& C) { const int st = b / 1024, sb = b % 1024, swz = sb ^ (((sb >> 9) & 1) << 5); R = (st >> 1) * 16 + swz / 64; C = (st & 1) * 32 + (swz % 64) / 2; }
__host__ __device__ __forceinline__ int perm32(int rho) { const int n = rho >> 4, i = rho & 15; return 8 * (i >> 2) + 4 * n + (i & 3); }

struct Unit { int pm, pn; };
struct Gemm { const bf16_t* A; const bf16_t* Bt; int M, N, K; };

struct StaticOrder {
    int nM, nN, nwg, G, c;
    __host__ __device__ void init(int M, int N, int G_, int c_) { nM = M / BM; nN = N / BM; nwg = nM * nN; G = G_; c = c_; }
    __host__ __device__ bool next(int i, Unit& u) const {
        const long L = (long)i * G + c; if (L >= nwg) return false;
        int wgid = (int)L; { const int q = nwg / NXCD, r = nwg % NXCD, xcd = wgid % NXCD, off = wgid / NXCD; wgid = (xcd < r ? xcd * (q + 1) : r * (q + 1) + (xcd - r) * q) + off; }
        const int nig = WGM * nN, gid = wgid / nig, fm = gid * WGM, gsz = (nM - fm) < WGM ? (nM - fm) : WGM;
        u.pm = fm + ((wgid % nig) % gsz); u.pn = (wgid % nig) / gsz; return true;
    }
    __device__ __forceinline__ void a_ready(const Unit&) const {}
    __device__ __forceinline__ void done(const Unit&) const {}
};

__device__ __forceinline__ unsigned cvt_pk_bf16(float lo, float hi) { unsigned r; asm volatile("v_cvt_pk_bf16_f32 %0, %1, %2" : "=v"(r) : "v"(lo), "v"(hi)); return r; }
typedef float f32x2 __attribute__((ext_vector_type(2)));
__device__ __forceinline__ f32x2 gelu_pk(f32x2 v) {
    const f32x2 av = __builtin_elementwise_abs(v), d = av * 0.2316418882f + 1.0f;
    f32x2 t; t.x = __builtin_amdgcn_rcpf(d.x); t.y = __builtin_amdgcn_rcpf(d.y);
    f32x2 q = t * 0.5307027145f + (-0.7265760135f); q = q * t + 0.7107068705f; q = q * t + (-0.142248368f); q = q * t + 0.127414796f; q = q * t;
    const f32x2 s = (v * v) * (-0.72134752044f);
    f32x2 e; e.x = __builtin_amdgcn_exp2f(s.x); e.y = __builtin_amdgcn_exp2f(s.y);
    const f32x2 m = v * (q * e), r = v - m;
    f32x2 o; o.x = v.x < 0.f ? m.x : r.x; o.y = v.y < 0.f ? m.y : r.y; return o;
}

template <int ACT  > struct EpiBf16 {
    static constexpr bool PERM = true, AFTER_DRAIN = false; static_assert(ACT == 0 || ACT == 1, "EpiBf16: ACT is 0 (none) or 1 (gelu_pk)");
    bf16_t* O; int ldc; const float* bias; int split_cols; size_t split_stride; float scale0;
    __device__ __forceinline__ void operator()(const f32x4 (&acc)[2][2][4][2], const Unit& u, int wr, int wc, int fr, int fq) const {
        const int row0 = u.pm * BM + wr * 64 + fr; int colt = u.pn * BM; bf16_t* base = O;
        float sc = 1.f; if (split_cols) { const int t = colt / split_cols; base += (size_t)t * split_stride; colt -= t * split_cols; if (t == 0) sc = scale0; }
        const int col0 = colt + wc * 32 + 8 * fq, bcol0 = u.pn * BM + wc * 32 + 8 * fq;
        f32x4 bv[2][2];
#pragma unroll
        for (int bj = 0; bj < 2; ++bj)
#pragma unroll
            for (int n = 0; n < 2; ++n) bv[bj][n] = bias ? *(const f32x4*)(bias + bcol0 + bj * HALF + 4 * n) : (f32x4){0.f, 0.f, 0.f, 0.f};
#pragma unroll
        for (int ai = 0; ai < 2; ++ai)
#pragma unroll
            for (int m = 0; m < 4; ++m) { bf16_t* rowp = base + (size_t)(row0 + ai * HALF + m * 16) * ldc + col0;
#pragma unroll
                for (int bj = 0; bj < 2; ++bj) { f32x4 v0 = acc[ai][bj][m][0] + bv[bj][0], v1 = acc[ai][bj][m][1] + bv[bj][1];
                    if (ACT == 1) { f32x2 a = gelu_pk((f32x2){v0[0], v0[1]}), b = gelu_pk((f32x2){v0[2], v0[3]}), c = gelu_pk((f32x2){v1[0], v1[1]}), d = gelu_pk((f32x2){v1[2], v1[3]});
                        v0 = (f32x4){a.x, a.y, b.x, b.y}; v1 = (f32x4){c.x, c.y, d.x, d.y}; }
                    v0 = v0 * sc; v1 = v1 * sc; u32x4 w; w.x = cvt_pk_bf16(v0[0], v0[1]); w.y = cvt_pk_bf16(v0[2], v0[3]); w.z = cvt_pk_bf16(v1[0], v1[1]); w.w = cvt_pk_bf16(v1[2], v1[3]);
                    *(u32x4*)(rowp + bj * HALF) = w; } }
    }
};

struct EpiResid {
    static constexpr bool PERM = false, AFTER_DRAIN = false;
    const float* xin; float* out; int ldc; float alpha;
    __device__ __forceinline__ void operator()(const f32x4 (&acc)[2][2][4][2], const Unit& u, int wr, int wc, int fr, int fq) const {
        const int col0 = u.pn * BM + wc * 32 + 4 * fq;
#pragma unroll
        for (int ai = 0; ai < 2; ++ai)
#pragma unroll
            for (int m = 0; m < 4; ++m) { const size_t off = (size_t)(u.pm * BM + ai * HALF + wr * 64 + m * 16 + fr) * ldc + col0;
#pragma unroll
                for (int bj = 0; bj < 2; ++bj)
#pragma unroll
                    for (int n = 0; n < 2; ++n) { const size_t p = off + bj * HALF + n * 16; const f32x4 xv = *(const f32x4*)(xin + p); *(f32x4*)(out + p) = xv * alpha + acc[ai][bj][m][n]; } }
    }
};
struct EpiSwiGLU {
    static constexpr bool PERM = true, AFTER_DRAIN = false;
    bf16_t* H; int ldh;
    __device__ __forceinline__ static float silu(float x) { return x * __builtin_amdgcn_rcpf(1.0f + __expf(-x)); }
    __device__ __forceinline__ void operator()(const f32x4 (&acc)[2][2][4][2], const Unit& u, int wr, int wc, int fr, int fq) const {
        const int row0 = u.pm * BM + wr * 64 + fr, col0 = u.pn * HALF + wc * 32 + 8 * fq;
#pragma unroll
        for (int ai = 0; ai < 2; ++ai)
#pragma unroll
            for (int m = 0; m < 4; ++m) { bf16_t* rowp = H + (size_t)(row0 + ai * HALF + m * 16) * ldh + col0;
                const f32x4 g0 = acc[ai][0][m][0], g1 = acc[ai][0][m][1], u0 = acc[ai][1][m][0], u1 = acc[ai][1][m][1];
                u32x4 w; w.x = cvt_pk_bf16(silu(g0[0]) * u0[0], silu(g0[1]) * u0[1]); w.y = cvt_pk_bf16(silu(g0[2]) * u0[2], silu(g0[3]) * u0[3]);
                w.z = cvt_pk_bf16(silu(g1[0]) * u1[0], silu(g1[1]) * u1[1]); w.w = cvt_pk_bf16(silu(g1[2]) * u1[2], silu(g1[3]) * u1[3]);
                *(u32x4*)rowp = w; }
    }
};
template <class Epi, class Sched, bool ALIGN_EPI = false, bool SP2 = false>
__device__ __forceinline__ void gemm_phase(PG8_LAS unsigned char* lds, const Gemm g, const Sched& S, const Epi& E) {
    int tid_ = threadIdx.x; asm volatile("" : "+v"(tid_));
    const int tid = tid_, wid = __builtin_amdgcn_readfirstlane(tid >> 6), lane = tid & 63, wr = wid >> 2, wc = wid & 3, fr = lane & 15, fq = lane >> 4;
    const int K = g.K, nt = K / BK;
    unsigned voffA[2], voffB[2];
#pragma unroll
    for (int i = 0; i < 2; ++i) { int R, C; stage_rc(tid * 16 + i * 8192, R, C); const int Rb = Epi::PERM ? ((R & ~31) + perm32(R & 31)) : R;
        voffA[i] = (unsigned)(R * K + C) * 2u; voffB[i] = (unsigned)(Rb * K + C) * 2u; }
    const size_t kstep = (size_t)(BK * 2);
    const size_t hstep = (size_t)HALF * K * 2;
    const size_t tstep = 2 * hstep;
    const unsigned ldsw = (unsigned)wid * 1024u;
    const int aoff = lds_byte(wr * 64 + fr, fq * 8), boff = lds_byte(wc * 32 + fr, fq * 8);
#define PG8_SA(b, h) (((b) * 2 + (h)) * HTB)
#define PG8_SB(b, h) ((4 + (b) * 2 + (h)) * HTB)
#define PG8_STAGE(bufoff, gbase, voff) do { _Pragma("unroll") for (int _i = 0; _i < 2; ++_i) \
        __builtin_amdgcn_global_load_lds((const unsigned*)((const char*)(gbase) + (voff)[_i]), (PG8_LAS unsigned*)(lds + (bufoff) + ldsw + _i * 8192), 16, 0, 0); } while (0)
#define PG8_LDA(dst, b, h) do { _Pragma("unroll") for (int m = 0; m < 4; ++m) _Pragma("unroll") for (int k = 0; k < 2; ++k) dst[m][k] = *(const PG8_LAS bf16x8*)(lds + PG8_SA(b, h) + aoff + m * 2048 + k * 1024); } while (0)
#define PG8_LDB(dst, b, h) do { _Pragma("unroll") for (int n = 0; n < 2; ++n) _Pragma("unroll") for (int k = 0; k < 2; ++k) dst[n][k] = *(const PG8_LAS bf16x8*)(lds + PG8_SB(b, h) + boff + n * 2048 + k * 1024); } while (0)
#define PG8_MMA(ai, bj, At, Bt) do { __builtin_amdgcn_s_setprio(1); _Pragma("unroll") for (int m = 0; m < 4; ++m) _Pragma("unroll") for (int n = 0; n < 2; ++n) _Pragma("unroll") for (int k = 0; k < 2; ++k) \
        acc[ai][bj][m][n] = __builtin_amdgcn_mfma_f32_16x16x32_bf16(Bt[n][k], At[m][k], acc[ai][bj][m][n], 0, 0, 0); __builtin_amdgcn_s_setprio(0); } while (0)
#define PG8_WAIT_V(n) asm volatile("s_waitcnt vmcnt(" #n ")" ::: "memory")
#define PG8_WAIT_L(n) asm volatile("s_waitcnt lgkmcnt(" #n ")" ::: "memory")
#define PG8_BAR __builtin_amdgcn_s_barrier()
#define PG8_SCHED __builtin_amdgcn_sched_barrier(0)
    Unit cur, nxt; int ui = 0;
    if (!S.next(0, cur)) return;
    f32x4 acc[2][2][4][2];
#pragma unroll
    for (int a = 0; a < 2; ++a)
#pragma unroll
        for (int b = 0; b < 2; ++b)
#pragma unroll
            for (int m = 0; m < 4; ++m)
#pragma unroll
                for (int n = 0; n < 2; ++n) acc[a][b][m][n] = (f32x4){0.f, 0.f, 0.f, 0.f};
    bf16x8 At[4][2], B0[2][2], B1[2][2];
    const char* cA = (const char*)g.A + (size_t)cur.pm * tstep; const char* cB = (const char*)g.Bt + (size_t)cur.pn * tstep;
    S.a_ready(cur);
    if constexpr (SP2) {
        PG8_STAGE(PG8_SB(0, 0), cB, voffB); PG8_STAGE(PG8_SB(0, 1), cB + hstep, voffB); PG8_STAGE(PG8_SA(0, 0), cA, voffA); PG8_STAGE(PG8_SA(0, 1), cA + hstep, voffA);
        if (wr == 1) PG8_BAR;
        PG8_WAIT_V(2); PG8_BAR;
        PG8_STAGE(PG8_SB(1, 0), cB + kstep, voffB); PG8_STAGE(PG8_SA(1, 0), cA + kstep, voffA); PG8_STAGE(PG8_SB(1, 1), cB + hstep + kstep, voffB);
        PG8_WAIT_V(6); PG8_BAR;
    } else {
        PG8_STAGE(PG8_SB(0, 0), cB, voffB); PG8_STAGE(PG8_SA(0, 0), cA, voffA); PG8_STAGE(PG8_SB(0, 1), cB + hstep, voffB); PG8_STAGE(PG8_SA(0, 1), cA + hstep, voffA);
        if (wr == 1) PG8_BAR;
        PG8_WAIT_V(4); PG8_BAR;
        PG8_STAGE(PG8_SB(1, 0), cB + kstep, voffB); PG8_STAGE(PG8_SA(1, 0), cA + kstep, voffA); PG8_STAGE(PG8_SB(1, 1), cB + hstep + kstep, voffB);
        PG8_WAIT_V(6); PG8_BAR;
    }
    for (;;) {
        const bool has_next = S.next(ui + 1, nxt);
        const char* nA = has_next ? (const char*)g.A + (size_t)nxt.pm * tstep : cA; const char* nB = has_next ? (const char*)g.Bt + (size_t)nxt.pn * tstep : cB;
        for (int t = 0; t < nt; t += 2) {
            const bool last = (t == nt - 2);
            const char* a1 = cA + (size_t)(t + 1) * kstep;
            const char* a2 = last ? nA : cA + (size_t)(t + 2) * kstep; const char* b2 = last ? nB : cB + (size_t)(t + 2) * kstep;
            const char* a3 = a2 + kstep; const char* b3 = b2 + kstep;
            if (last && has_next) S.a_ready(nxt);
            if constexpr (SP2) {
            PG8_LDB(B0, 0, 0); PG8_LDB(B1, 0, 1); PG8_SCHED; PG8_LDA(At, 0, 0); PG8_STAGE(PG8_SA(1, 1), a1 + hstep, voffA);
            PG8_WAIT_V(8); PG8_WAIT_L(0); PG8_BAR; PG8_MMA(0, 0, At, B0); PG8_MMA(0, 1, At, B1); PG8_BAR; PG8_SCHED;
            PG8_LDA(At, 0, 1); PG8_STAGE(PG8_SB(0, 0), b2, voffB); PG8_STAGE(PG8_SB(0, 1), b2 + hstep, voffB); PG8_STAGE(PG8_SA(0, 0), a2, voffA);
            PG8_WAIT_V(8); PG8_WAIT_L(0); PG8_BAR; PG8_MMA(1, 0, At, B0); PG8_MMA(1, 1, At, B1); PG8_BAR; PG8_SCHED;
            PG8_LDB(B0, 1, 0); PG8_LDB(B1, 1, 1); PG8_SCHED; PG8_LDA(At, 1, 0); PG8_STAGE(PG8_SA(0, 1), a2 + hstep, voffA);
            PG8_WAIT_V(8); PG8_WAIT_L(0); PG8_BAR; PG8_MMA(0, 0, At, B0); PG8_MMA(0, 1, At, B1); PG8_BAR; PG8_SCHED;
            PG8_LDA(At, 1, 1); PG8_STAGE(PG8_SB(1, 0), b3, voffB); PG8_STAGE(PG8_SB(1, 1), b3 + hstep, voffB); PG8_STAGE(PG8_SA(1, 0), a3, voffA);
            PG8_WAIT_V(8); PG8_WAIT_L(0); PG8_BAR; PG8_MMA(1, 0, At, B0); PG8_MMA(1, 1, At, B1); PG8_BAR; PG8_SCHED;
            } else {
            PG8_LDB(B0, 0, 0); PG8_SCHED; PG8_LDA(At, 0, 0); PG8_STAGE(PG8_SA(1, 1), a1 + hstep, voffA);
            PG8_WAIT_L(8); PG8_BAR; PG8_WAIT_L(0); PG8_MMA(0, 0, At, B0); PG8_BAR; PG8_SCHED;
            PG8_LDB(B1, 0, 1); PG8_STAGE(PG8_SB(0, 0), b2, voffB);
            PG8_BAR; PG8_WAIT_L(0); PG8_MMA(0, 1, At, B1); PG8_BAR;
            PG8_LDA(At, 0, 1); PG8_STAGE(PG8_SA(0, 0), a2, voffA);
            PG8_BAR; PG8_WAIT_L(0); PG8_MMA(1, 0, At, B0); PG8_BAR; PG8_SCHED;
            PG8_STAGE(PG8_SB(0, 1), b2 + hstep, voffB);
            PG8_WAIT_V(6); PG8_BAR; PG8_MMA(1, 1, At, B1); PG8_BAR;
            PG8_LDB(B0, 1, 0); PG8_SCHED; PG8_LDA(At, 1, 0); PG8_STAGE(PG8_SA(0, 1), a2 + hstep, voffA);
            PG8_WAIT_L(8); PG8_BAR; PG8_WAIT_L(0); PG8_MMA(0, 0, At, B0); PG8_BAR; PG8_SCHED;
            PG8_LDB(B1, 1, 1); PG8_STAGE(PG8_SB(1, 0), b3, voffB);
            PG8_BAR; PG8_WAIT_L(0); PG8_MMA(0, 1, At, B1); PG8_BAR;
            PG8_LDA(At, 1, 1); PG8_STAGE(PG8_SA(1, 0), a3, voffA);
            PG8_BAR; PG8_WAIT_L(0); PG8_MMA(1, 0, At, B0); PG8_BAR; PG8_SCHED;
            PG8_STAGE(PG8_SB(1, 1), b3 + hstep, voffB);
            PG8_WAIT_V(6); PG8_BAR; PG8_MMA(1, 1, At, B1); PG8_BAR;
            }
        }
        if constexpr (ALIGN_EPI) { if (wr == 0) PG8_BAR; }
        if constexpr (!Epi::AFTER_DRAIN) { E(acc, cur, wr, wc, fr, fq); S.done(cur); }
        if (!has_next) break;
#pragma unroll
        for (int a = 0; a < 2; ++a)
#pragma unroll
            for (int b = 0; b < 2; ++b)
#pragma unroll
                for (int m = 0; m < 4; ++m)
#pragma unroll
                    for (int n = 0; n < 2; ++n) acc[a][b][m][n] = (f32x4){0.f, 0.f, 0.f, 0.f};
        cur = nxt; cA = nA; cB = nB; ++ui;
        if constexpr (ALIGN_EPI) { if (wr == 1) PG8_BAR; }
    }
    PG8_WAIT_V(0);
    if constexpr (!ALIGN_EPI) { if (wr == 0) PG8_BAR; }
    PG8_BAR;
    if constexpr (Epi::AFTER_DRAIN) { E.fused(acc, cur, wr, wc, fr, fq, lds, wid, lane); S.done(cur); }
#undef PG8_SA
#undef PG8_SB
#undef PG8_STAGE
#undef PG8_LDA
#undef PG8_LDB
#undef PG8_MMA
#undef PG8_WAIT_V
#undef PG8_WAIT_L
#undef PG8_BAR
#undef PG8_SCHED
}
}
constexpr int NWAVES = 8;
constexpr int BATCH = 16, SEQ = 4096, D = 1024, DEPTH = 4;
constexpr int M = BATCH * SEQ;
constexpr int DIN = 3352, PS = 3584;
constexpr int DFF = 2816, NGU = 2 * DFF;
constexpr int C_HQ = 0, C_HF = 512, C_HI = 1024, C_HG = 1536, C_NQ = 2048, C_KC = 2560, C_VC = 2688, C_KS = 2816, C_VS = 2944, C_KW = 3072, C_VW = 3200, C_GT = 3328;
constexpr float LN_EPS = 1e-5f;
constexpr float ALPHA = 1.681792830507429f;
constexpr int NCMP = 255;

#ifndef MK_N_LAUNCHES
#define MK_N_LAUNCHES 1
#endif
constexpr int N_PHASES = 1 + 8 * DEPTH;
constexpr bool ONE_LAUNCH = (MK_N_LAUNCHES == 1);

constexpr size_t MiB = 1u << 20;
constexpr size_t WS_CTL = 0, CTL_ZERO_BYTES = 1 * MiB;
constexpr size_t WS_WIN = 2 * MiB, WS_WOUT = 30 * MiB, WS_WGU = 38 * MiB, WS_WDN = 82 * MiB;
constexpr size_t WS_KCMP = 104 * MiB, WS_VCMP = 105 * MiB;
constexpr size_t WS_XB = 112 * MiB, WS_MIX = 240 * MiB, WS_OPRE = 368 * MiB, WS_PROJ = 496 * MiB, WS_END = 944 * MiB;
constexpr int CW_TMO = 0, CW_CODE = 1, CW_BAR = 4096;

constexpr int RING_OFF = 0, RING_BYTES = 131072;
constexpr int LDSCTL_OFF = RING_BYTES, MISC_OFF = LDSCTL_OFF + 320;
constexpr int LDS_BYTES = 147456;

#define GAS __attribute__((address_space(1)))
#define LAS __attribute__((address_space(3)))
typedef unsigned short bf16;
typedef unsigned v4u __attribute__((ext_vector_type(4)));
typedef unsigned v2u __attribute__((ext_vector_type(2)));
typedef float f32x4 __attribute__((ext_vector_type(4)));
typedef GAS unsigned gu32;
#define RLX_AGENT __ATOMIC_RELAXED, __HIP_MEMORY_SCOPE_AGENT
#define LDS_WAIT() asm volatile("s_waitcnt lgkmcnt(0)" ::: "memory")
__device__ __forceinline__ unsigned f2bf(float f) { unsigned u = __builtin_bit_cast(unsigned, f); return (u + 0x7fffu + ((u >> 16) & 1u)) >> 16; }
__device__ __forceinline__ unsigned pk2(float lo, float hi) { return f2bf(lo) | (f2bf(hi) << 16); }
__device__ __forceinline__ float bf2f(unsigned h) { return __uint_as_float(h << 16); }
__device__ __forceinline__ float bflo(unsigned w) { return __uint_as_float(w << 16); }
__device__ __forceinline__ float bfhi(unsigned w) { return __uint_as_float(w & 0xffff0000u); }
__device__ __forceinline__ float wave_sum(float v) {
#pragma unroll
    for (int o = 1; o < 64; o <<= 1) v += __shfl_xor(v, o);
    return v;
}
__device__ __forceinline__ float wave_max(float v) {
#pragma unroll
    for (int o = 1; o < 64; o <<= 1) v = fmaxf(v, __shfl_xor(v, o));
    return v;
}
__device__ __forceinline__ float sigmoidf_(float x) { return 1.0f / (1.0f + __expf(-x)); }
__device__ __forceinline__ float gelu_tanh(float x) { const float u = 0.7978845608028654f * (x + 0.044715f * x * x * x); return 0.5f * x * (1.0f + tanhf(u)); }

#define XB_TMO      128
#define XB_XCNT(j)  (256  + 64 * (j))
#define XB_XSUB(j)  (1280 + 64 * (j))
#define XB_XGEN(j)  (2304 + 64 * (j))
#define XB_TOP      3328
#define XB_TOPGEN   3392
#define XCD_BAR_WORDS 3456
#define XB_SPIN_CAP (1u << 18)

__device__ __forceinline__ unsigned xb_ld(unsigned* p)              { return __hip_atomic_load(p, __ATOMIC_RELAXED, __HIP_MEMORY_SCOPE_AGENT); }
__device__ __forceinline__ unsigned xb_add(unsigned* p, unsigned v) { return __hip_atomic_fetch_add(p, v, __ATOMIC_RELAXED, __HIP_MEMORY_SCOPE_AGENT); }
__device__ __forceinline__ unsigned xb_xcc_id() { return (unsigned)__builtin_amdgcn_s_getreg((3 << 11) | 20) & 0xFu; }
#define XB_SPIN(cond, bar) do { unsigned _sp = 0; while (cond) { __builtin_amdgcn_s_sleep(1); \
    if ((++_sp & 255u) == 0u) { if (xb_ld(&(bar)[XB_TMO])) break; if (_sp > XB_SPIN_CAP) { atomicAdd(&(bar)[XB_TMO], 1u); break; } } } } while (0)

struct XcdBarrier {
    unsigned* bar; unsigned x;
    volatile LAS unsigned* st;
};

__device__ __forceinline__ XcdBarrier xcd_barrier_post(unsigned* bar, volatile LAS unsigned* st) {
    XcdBarrier b; b.bar = bar; b.x = xb_xcc_id(); b.st = st;
    if (threadIdx.x == 0) (void)xb_add(&bar[XB_XCNT(b.x)], 1u);
    return b;
}
__device__ __forceinline__ void xcd_barrier_complete(unsigned* bar, unsigned x, unsigned& nloc, unsigned& nx) {
    const unsigned G = gridDim.x * gridDim.y * gridDim.z;
    unsigned sum, cnt, mine, sp = 0u;
    for (;;) {
        sum = 0u; cnt = 0u; mine = 0u;
#pragma unroll
        for (unsigned j = 0; j < 16; ++j) { const unsigned c = xb_ld(&bar[XB_XCNT(j)]); sum += c; cnt += (c > 0u) ? 1u : 0u; mine = (j == x) ? c : mine; }
        if (sum == G) break;
        __builtin_amdgcn_s_sleep(1);
        if ((++sp & 255u) == 0u) { if (xb_ld(&bar[XB_TMO])) break; if (sp > XB_SPIN_CAP) { atomicAdd(&bar[XB_TMO], 1u); break; } }
    }
    nloc = mine > 0u ? mine : 1u; nx = cnt > 0u ? cnt : 1u;
}

__device__ __forceinline__ void xcd_barrier(const XcdBarrier& b) {
    asm volatile("s_waitcnt vmcnt(0)" ::: "memory");
    __syncthreads();
    if (threadIdx.x == 0) {
        unsigned* bar = b.bar;
        __builtin_amdgcn_s_waitcnt(0);
        unsigned nloc = b.st[0], nx = b.st[1];
        if (nloc == 0u) { xcd_barrier_complete(bar, b.x, nloc, nx); b.st[0] = nloc; b.st[1] = nx; }
        const unsigned old = xb_add(&bar[XB_XSUB(b.x)], 1u);
        const unsigned gen = old / nloc;
        if (old + 1u == (gen + 1u) * nloc) {
            __builtin_amdgcn_fence(__ATOMIC_RELEASE, "agent");
            asm volatile("s_waitcnt vmcnt(0)" ::: "memory");
            const unsigned og = xb_add(&bar[XB_TOP], 1u);
            const unsigned tg = og / nx;
            if (og + 1u == (tg + 1u) * nx) xb_add(&bar[XB_TOPGEN], 1u);
            else XB_SPIN(xb_ld(&bar[XB_TOPGEN]) == tg, bar);
            __builtin_amdgcn_fence(__ATOMIC_ACQUIRE, "agent");
            xb_add(&bar[XB_XGEN(b.x)], 1u);
            asm volatile("s_waitcnt vmcnt(0)" ::: "memory");
        } else {
            XB_SPIN(xb_ld(&bar[XB_XGEN(b.x)]) == gen, bar);
            __builtin_amdgcn_fence(__ATOMIC_ACQUIRE, "agent");
            asm volatile("s_waitcnt vmcnt(0)" ::: "memory");
        }
    }
    __syncthreads();
}

struct Ctx {
    LAS unsigned char* lds;
    int tid, lane, wave, vcu, G;
    const float *x, *w_in, *lb_param, *norm_w, *pos_k, *w1_k, *w2_k, *pos_v, *w1_v, *w2_v, *rel_bias, *w_out, *ln1_g, *ln1_b, *w_gate, *w_up, *w_down, *ln2_g, *ln2_b;
    float* out;
    bf16 *win_t, *wout_t, *wgu_t, *wdn_t, *kcmp, *vcmp, *xb, *mix, *proj;
    float* opre;
};

__device__ __forceinline__ void transpose_item(const float* W, int K, int N, bf16* WT, int dst_row0, LAS float* scr, int k0, int n0, int lane) {
#pragma unroll 8
    for (int i = 0; i < 32; ++i) { const int kk = 2 * i + (lane >> 5); const int n = n0 + (lane & 31); scr[kk * 33 + (lane & 31)] = (n < N) ? W[(size_t)(k0 + kk) * N + n] : 0.f; }
    LDS_WAIT(); asm volatile("" ::: "memory");
    const int c = lane & 7;
#pragma unroll
    for (int j = 0; j < 4; ++j) { const int n = (lane >> 3) + 8 * j; const LAS float* s = scr + (8 * c) * 33 + n;
        v4u o; o.x = pk2(s[0 * 33], s[1 * 33]); o.y = pk2(s[2 * 33], s[3 * 33]); o.z = pk2(s[4 * 33], s[5 * 33]); o.w = pk2(s[6 * 33], s[7 * 33]);
        *(v4u*)(WT + (size_t)(dst_row0 + n) * K + k0 + 8 * c) = o; }
    LDS_WAIT(); asm volatile("" ::: "memory");
}
__device__ __forceinline__ void p_prologue(const Ctx& F) {
    LAS float* scr = (LAS float*)(F.lds + RING_OFF + F.wave * 16384);
    const int gw = F.vcu * NWAVES + F.wave, NGW = F.G * NWAVES;
    constexpr int I_IN = (D / 64) * (PS / 32), I_OUT = (D / 64) * (D / 32), I_G = (D / 64) * (DFF / 32), I_DN = (DFF / 64) * (D / 32);
    constexpr int PER_L = I_IN + I_OUT + 2 * I_G + I_DN;
    for (int it = gw; it < PER_L * DEPTH; it += NGW) {
        const int l = it / PER_L; int r = it % PER_L;
        if (r < I_IN) { const int nb = r % (PS / 32), kb = r / (PS / 32); transpose_item(F.w_in + (size_t)l * D * DIN, D, DIN, F.win_t + (size_t)l * PS * D, 32 * nb, scr, 64 * kb, 32 * nb, F.lane); continue; } r -= I_IN;
        if (r < I_OUT) { const int nb = r % (D / 32), kb = r / (D / 32); transpose_item(F.w_out + (size_t)l * D * D, D, D, F.wout_t + (size_t)l * D * D, 32 * nb, scr, 64 * kb, 32 * nb, F.lane); continue; } r -= I_OUT;
        if (r < 2 * I_G) { const int up = r >= I_G; if (up) r -= I_G; const int nb = r % (DFF / 32), kb = r / (DFF / 32); const int n0 = 32 * nb;
            transpose_item((up ? F.w_up : F.w_gate) + (size_t)l * D * DFF, D, DFF, F.wgu_t + (size_t)l * NGU * D, (n0 / 128) * 256 + (up ? 128 : 0) + (n0 % 128), scr, 64 * kb, n0, F.lane); continue; } r -= 2 * I_G;
        { const int nb = r % (D / 32), kb = r / (D / 32); transpose_item(F.w_down + (size_t)l * DFF * D, DFF, D, F.wdn_t + (size_t)l * D * DFF, 32 * nb, scr, 64 * kb, 32 * nb, F.lane); }
    }
    for (int m = gw; m < M; m += NGW) {
        const f32x4* xr = (const f32x4*)(F.x + (size_t)m * D) + F.lane; v2u* o8 = (v2u*)(F.xb + (size_t)m * D) + F.lane;
#pragma unroll
        for (int j = 0; j < 4; ++j) { const f32x4 v = xr[64 * j]; v2u w; w.x = pk2(v.x, v.y); w.y = pk2(v.z, v.w); o8[64 * j] = w; }
    }
}

__device__ __forceinline__ void p_layernorm(const Ctx& F, const float* gam, const float* bet) {
    const int gw = F.vcu * NWAVES + F.wave, NGW = F.G * NWAVES;
    f32x4 gv[4], bv[4];
#pragma unroll
    for (int j = 0; j < 4; ++j) { gv[j] = ((const f32x4*)gam)[F.lane + 64 * j]; bv[j] = ((const f32x4*)bet)[F.lane + 64 * j]; }
    for (int m = gw; m < M; m += NGW) {
        f32x4* xr = (f32x4*)(F.out + (size_t)m * D) + F.lane; v2u* o8 = (v2u*)(F.xb + (size_t)m * D) + F.lane;
        f32x4 v[4]; float s = 0.f;
#pragma unroll
        for (int j = 0; j < 4; ++j) { v[j] = xr[64 * j]; s += (v[j].x + v[j].y) + (v[j].z + v[j].w); }
        const float mean = wave_sum(s) * (1.f / D); float s2 = 0.f;
#pragma unroll
        for (int j = 0; j < 4; ++j) { v[j] = v[j] - mean; s2 += (v[j].x * v[j].x + v[j].y * v[j].y) + (v[j].z * v[j].z + v[j].w * v[j].w); }
        const float rstd = 1.f / sqrtf(wave_sum(s2) * (1.f / D) + LN_EPS);
#pragma unroll
        for (int j = 0; j < 4; ++j) { const f32x4 o = v[j] * rstd * gv[j] + bv[j]; xr[64 * j] = o; v2u w; w.x = pk2(o.x, o.y); w.y = pk2(o.z, o.w); o8[64 * j] = w; }
    }
}

__device__ __forceinline__ void hgrn_scan_unit(const Ctx& F, int l, int u) {
    constexpr int TT = 16;
    const int b = u >> 4, h = (u >> 2) & 3, dvs = u & 3;
    LAS float* qs = (LAS float*)(F.lds + RING_OFF);
    LAS float* fs = qs + TT * 128;
    LAS float* vs = fs + TT * 128;
    LAS float* part = vs + TT * 32;
    LAS float* lbs = part + TT * 16 * 32;
    const int tid = F.tid, dv = tid & 31, kg = tid >> 5;
    if (tid < 128) {
        const int c = h * 128 + tid; float p[DEPTH], mx = -1e30f;
#pragma unroll
        for (int i = 0; i < DEPTH; ++i) { p[i] = F.lb_param[i * 512 + c]; mx = fmaxf(mx, p[i]); }
        float sum = 0.f, acc = 0.f;
#pragma unroll
        for (int i = 0; i < DEPTH; ++i) { p[i] = expf(p[i] - mx); sum += p[i]; }
#pragma unroll
        for (int i = 1; i < DEPTH; ++i) { if (i <= l) acc += p[i]; }
        lbs[tid] = acc / sum;
    }
    __syncthreads();
    float S[8];
#pragma unroll
    for (int j = 0; j < 8; ++j) S[j] = 0.f;
    const bf16* P = F.proj + (size_t)b * SEQ * PS;
    const int lr = tid >> 5, lc = tid & 31;
    for (int t0 = 0; t0 < SEQ; t0 += TT) {
        {   const bf16* row = P + (size_t)(t0 + lr) * PS;
            const v2u qw = *(const v2u*)(row + C_HQ + h * 128 + lc * 4), fw = *(const v2u*)(row + C_HF + h * 128 + lc * 4);
            f32x4 qv = {bflo(qw.x), bfhi(qw.x), bflo(qw.y), bfhi(qw.y)}, zv = {bflo(fw.x), bfhi(fw.x), bflo(fw.y), bfhi(fw.y)};
            const f32x4 lbv = *(LAS f32x4*)(lbs + lc * 4); f32x4 fv;
            fv.x = lbv.x + (1.f - lbv.x) * sigmoidf_(zv.x); fv.y = lbv.y + (1.f - lbv.y) * sigmoidf_(zv.y); fv.z = lbv.z + (1.f - lbv.z) * sigmoidf_(zv.z); fv.w = lbv.w + (1.f - lbv.w) * sigmoidf_(zv.w);
            *(LAS f32x4*)(qs + lr * 128 + lc * 4) = qv; *(LAS f32x4*)(fs + lr * 128 + lc * 4) = fv;
            vs[lr * 32 + lc] = bf2f(row[C_HI + h * 128 + dvs * 32 + lc]);
        }
        __syncthreads();
#pragma unroll 4
        for (int tt = 0; tt < TT; ++tt) {
            const float v = vs[tt * 32 + dv];
            const f32x4 f0 = *(LAS f32x4*)(fs + tt * 128 + kg * 8), f1 = *(LAS f32x4*)(fs + tt * 128 + kg * 8 + 4);
            const f32x4 q0 = *(LAS f32x4*)(qs + tt * 128 + kg * 8), q1 = *(LAS f32x4*)(qs + tt * 128 + kg * 8 + 4);
            float o = 0.f;
            S[0] = f0.x * S[0] + (1.f - f0.x) * v; o += q0.x * S[0];
            S[1] = f0.y * S[1] + (1.f - f0.y) * v; o += q0.y * S[1];
            S[2] = f0.z * S[2] + (1.f - f0.z) * v; o += q0.z * S[2];
            S[3] = f0.w * S[3] + (1.f - f0.w) * v; o += q0.w * S[3];
            S[4] = f1.x * S[4] + (1.f - f1.x) * v; o += q1.x * S[4];
            S[5] = f1.y * S[5] + (1.f - f1.y) * v; o += q1.y * S[5];
            S[6] = f1.z * S[6] + (1.f - f1.z) * v; o += q1.z * S[6];
            S[7] = f1.w * S[7] + (1.f - f1.w) * v; o += q1.w * S[7];
            part[(tt * 16 + kg) * 32 + dv] = o;
        }
        __syncthreads();
        {   const int tt = tid >> 5; float o = 0.f;
#pragma unroll
            for (int k = 0; k < 16; ++k) o += part[(tt * 16 + k) * 32 + dv];
            F.opre[(size_t)(b * SEQ + t0 + tt) * 512 + h * 128 + dvs * 32 + dv] = o;
        }
    }
    __syncthreads();
}
__device__ __forceinline__ void hgrn_finalize(const Ctx& F, int l) {
    const int gw = F.vcu * NWAVES + F.wave, NGW = F.G * NWAVES;
    const float* nw = F.norm_w + l * 128 + (F.lane & 15) * 8;
    float w[8];
#pragma unroll
    for (int i = 0; i < 8; ++i) w[i] = nw[i];
    for (int m = gw; m < M; m += NGW) {
        const f32x4* op = (const f32x4*)(F.opre + (size_t)m * 512 + F.lane * 8);
        const f32x4 a = op[0], c = op[1];
        float o[8] = {a.x, a.y, a.z, a.w, c.x, c.y, c.z, c.w};
        float ss = 0.f;
#pragma unroll
        for (int i = 0; i < 8; ++i) ss += o[i] * o[i];
        ss += __shfl_xor(ss, 1); ss += __shfl_xor(ss, 2); ss += __shfl_xor(ss, 4); ss += __shfl_xor(ss, 8);
        const float r = 1.0f / sqrtf(ss * (1.f / 128.f) + 1e-6f);
        const v4u gw4 = *(const v4u*)(F.proj + (size_t)m * PS + C_HG + F.lane * 8);
        const float g[8] = {bflo(gw4.x), bfhi(gw4.x), bflo(gw4.y), bfhi(gw4.y), bflo(gw4.z), bfhi(gw4.z), bflo(gw4.w), bfhi(gw4.w)};
        float y[8];
#pragma unroll
        for (int i = 0; i < 8; ++i) y[i] = o[i] * r * w[i] * (g[i] * sigmoidf_(g[i]));
        v4u ov; ov.x = pk2(y[0], y[1]); ov.y = pk2(y[2], y[3]); ov.z = pk2(y[4], y[5]); ov.w = pk2(y[6], y[7]);
        *(v4u*)(F.mix + (size_t)m * D + F.lane * 8) = ov;
    }
}

__device__ __forceinline__ void cmp_unit(const Ctx& F, int l, int cu) {
    const int b = cu >> 6, g = (cu >> 5) & 1, kv = (cu >> 4) & 1, nb = cu & 15, n0 = nb * 16;
    LAS float* X = (LAS float*)(F.lds + RING_OFF);
    LAS float* posl = X + 272 * 64;
    LAS float* hid = posl + 32 * 64;
    const int tid = F.tid;
    const bf16* P = F.proj + (size_t)b * SEQ * PS + (kv ? C_VC : C_KC) + g * 64;
    const float* pos = (kv ? F.pos_v : F.pos_k) + (size_t)l * 32 * 64;
    const float* W1 = (kv ? F.w1_v : F.w1_k) + (size_t)l * 2048 * 128;
    const float* W2 = (kv ? F.w2_v : F.w2_k) + (size_t)l * 128 * 64;
    for (int i = tid; i < 272 * 16; i += 512) { const int r = i >> 4, c4 = (i & 15) * 4, t = n0 * 16 + r;
        f32x4 v = {0.f, 0.f, 0.f, 0.f};
        if (t < SEQ) { const v2u w = *(const v2u*)(P + (size_t)t * PS + c4); v = (f32x4){bflo(w.x), bfhi(w.x), bflo(w.y), bfhi(w.y)}; }
        *(LAS f32x4*)(X + r * 64 + c4) = v; }
    for (int i = tid; i < 32 * 64; i += 512) posl[i] = pos[i];
    __syncthreads();
    const int j = tid & 127, nq = tid >> 7;
    float acc[4] = {0.f, 0.f, 0.f, 0.f}, pacc = 0.f;
    for (int p = 0; p < 32; ++p) {
#pragma unroll 2
        for (int d = 0; d < 64; d += 4) {
            const float* wp = W1 + (size_t)(p * 64 + d) * 128 + j;
            const float w0 = wp[0], w1 = wp[128], w2 = wp[256], w3 = wp[384];
            const f32x4 pv = *(LAS f32x4*)(posl + p * 64 + d);
            pacc += pv.x * w0 + pv.y * w1 + pv.z * w2 + pv.w * w3;
#pragma unroll
            for (int i = 0; i < 4; ++i) { const f32x4 xv = *(LAS f32x4*)(X + ((nq * 4 + i) * 16 + p) * 64 + d); acc[i] += xv.x * w0 + xv.y * w1 + xv.z * w2 + xv.w * w3; }
        }
    }
#pragma unroll
    for (int i = 0; i < 4; ++i) hid[(nq * 4 + i) * 128 + j] = gelu_tanh(acc[i] + pacc);
    __syncthreads();
    bf16* O = (kv ? F.vcmp : F.kcmp) + (size_t)(b * 2 + g) * 256 * 64;
    const int c = tid & 63;
#pragma unroll
    for (int r = 0; r < 2; ++r) { const int nl = (tid >> 6) + 8 * r; float o = 0.f;
        for (int jj = 0; jj < 128; ++jj) o += hid[nl * 128 + jj] * W2[jj * 64 + c];
        const int n = n0 + nl; O[(size_t)n * 64 + c] = (bf16)((n < NCMP) ? f2bf(o) : 0u); }
    __syncthreads();
}

__device__ __forceinline__ int t5_bucket(int n) {
    if (n < 16) return n;
    int b = 16;
    b += (n >= 19); b += (n >= 21); b += (n >= 24); b += (n >= 27); b += (n >= 31); b += (n >= 35); b += (n >= 40); b += (n >= 46);
    b += (n >= 52); b += (n >= 59); b += (n >= 67); b += (n >= 77); b += (n >= 87); b += (n >= 99); b += (n >= 113);
    return b;
}
__device__ __forceinline__ void build_bias_table(const Ctx& F, LAS float* tab) {
    for (int i = F.tid; i < 8 * 129; i += NWAVES * 64) { const int h = i / 129, n = i % 129; tab[h * 132 + n] = F.rel_bias[t5_bucket(n) * 8 + h]; }
}
__device__ __forceinline__ void dot4(const bf16* krow, const LAS float* qf, float (&s)[4]) {
    s[0] = s[1] = s[2] = s[3] = 0.f;
#pragma unroll 2
    for (int i = 0; i < 8; ++i) {
        asm volatile("" ::: "memory");
        const v4u kv = *(const v4u*)(krow + 8 * i);
        const float k0 = bflo(kv.x), k1 = bfhi(kv.x), k2 = bflo(kv.y), k3 = bfhi(kv.y), k4 = bflo(kv.z), k5 = bfhi(kv.z), k6 = bflo(kv.w), k7 = bfhi(kv.w);
#pragma unroll
        for (int h = 0; h < 4; ++h) { const f32x4 qa = *(const LAS f32x4*)(qf + h * 64 + 8 * i), qb = *(const LAS f32x4*)(qf + h * 64 + 8 * i + 4);
            s[h] += k0 * qa.x + k1 * qa.y + k2 * qa.z + k3 * qa.w + k4 * qb.x + k5 * qb.y + k6 * qb.z + k7 * qb.w; }
    }
}
template <int MODE>
__device__ __forceinline__ void nsa_branch(const bf16* Kb, const bf16* Vb, int pitch, int nblk, unsigned long long sel, int t, int lim,
                                           const LAS float* qf, const LAS float* tab, LAS float* pe, int lane, float (&o)[4]) {
    float mx[4], lp[4];
#pragma unroll
    for (int h = 0; h < 4; ++h) { mx[h] = -INFINITY; lp[h] = 0.f; o[h] = 0.f; }
#pragma unroll 1
    for (int c = (MODE == 2 && t < 511) ? ((511 - t) >> 6) : 0; c < nblk; ++c) {
        int row0;
        if (MODE == 0) row0 = 64 * c; else if (MODE == 1) { row0 = 64 * (int)__builtin_ctzll(sel); sel &= sel - 1; } else row0 = t - 511 + 64 * c;
        const int key = row0 + lane; bool valid; int dist;
        if (MODE == 0) { valid = key < lim; dist = t - (16 * key + 31); } else { valid = (key >= 0) && (key <= t); dist = t - key; }
        const int krow = key < 0 ? 0 : key;
        float d4[4]; dot4(Kb + (size_t)krow * pitch, qf, d4);
        const int di = dist < 0 ? 0 : (dist > 128 ? 128 : dist);
        float e[4];
#pragma unroll
        for (int h = 0; h < 4; ++h) {
            const float sv = valid ? d4[h] + tab[h * 132 + di] : -INFINITY;
            if (MODE == 0) pe[h * 256 + key] = sv;
            const float mn = fmaxf(mx[h], wave_max(sv));
            const float scl = (mx[h] == mn) ? 1.f : __expf(mx[h] - mn);
            e[h] = valid ? __expf(sv - mn) : 0.f; lp[h] = lp[h] * scl + e[h]; o[h] *= scl; mx[h] = mn;
        }
#pragma unroll 2
        for (int kk = 0; kk < 64; ++kk) {
            int row = row0 + kk; row = row < 0 ? 0 : row;
            const float v = bf2f(Vb[(size_t)row * pitch + lane]);
#pragma unroll
            for (int h = 0; h < 4; ++h) o[h] += __int_as_float(__builtin_amdgcn_readlane(__float_as_int(e[h]), kk)) * v;
        }
    }
#pragma unroll
    for (int h = 0; h < 4; ++h) { lp[h] = 1.0f / wave_sum(lp[h]); o[h] *= lp[h]; }
    if (MODE == 0) {
        LDS_WAIT(); asm volatile("" ::: "memory");
#pragma unroll
        for (int c = 0; c < 4; ++c)
#pragma unroll
            for (int h = 0; h < 4; ++h) { const int n = 64 * c + lane; const float sv = (c < nblk) ? pe[h * 256 + n] : -INFINITY; pe[h * 256 + n] = __expf(sv - mx[h]) * lp[h]; }
    }
}
__device__ __forceinline__ void nsa_attn_phase(const Ctx& F, int l) {
    LAS float* tab = (LAS float*)(F.lds + RING_OFF);
    LAS float* qf = tab + 8 * 132 + F.wave * 64 * 4;
    LAS float* pe = tab + 8 * 132 + NWAVES * 256 + F.wave * 1024;
    build_bias_table(F, tab);
    __syncthreads();
    const int gw = F.vcu * NWAVES + F.wave, NGW = F.G * NWAVES, lane = F.lane;
    for (int idx = gw; idx < M * 2; idx += NGW) {
        const int g = idx & 1, m = idx >> 1, b = m >> 12, t = m & (SEQ - 1);
        const bf16* prow = F.proj + (size_t)m * PS;
        const LAS float* tg = tab + g * 4 * 132;
#pragma unroll
        for (int h = 0; h < 4; ++h) qf[h * 64 + lane] = 0.125f * bf2f(prow[C_NQ + (g * 4 + h) * 64 + lane]);
        LDS_WAIT(); asm volatile("" ::: "memory");
        const bf16* P0 = F.proj + (size_t)b * SEQ * PS;
        float oc[4] = {0.f, 0.f, 0.f, 0.f};
        const int nv = (t >= 31) ? ((t - 31) >> 4) + 1 : 0;
        if (nv > 0) {
            nsa_branch<0>(F.kcmp + (size_t)(b * 2 + g) * 256 * 64, F.vcmp + (size_t)(b * 2 + g) * 256 * 64, 64, (nv + 63) >> 6, 0ull, t, nv, qf, tg, pe, lane, oc);
            LDS_WAIT(); asm volatile("" ::: "memory");
        }
        const int cur = t >> 6;
        float imp = 0.f;
        if (nv > 0) {
#pragma unroll
            for (int k = -1; k <= 3; ++k) { const int n = 4 * lane + k; if (n >= 0 && n < NCMP) { const float p = pe[n] + pe[256 + n] + pe[512 + n] + pe[768 + n]; imp += (k >= 0 && k <= 2) ? 2.f * p : p; } }
        }
        const bool causal = lane <= cur, forced = (lane == 0) || (lane == cur) || (lane + 1 == cur);
        const float sc = forced ? 1e9f : (causal ? imp : -1e9f);
        int cnt = 0;
        for (int i = 0; i < 64; ++i) { const float o = __int_as_float(__builtin_amdgcn_readlane(__float_as_int(sc), i)); cnt += ((o > sc) || (o == sc && i < lane)) ? 1 : 0; }
        unsigned long long sel = __ballot((cnt < 16) && causal);
        float os[4];
        nsa_branch<1>(P0 + C_KS + g * 64, P0 + C_VS + g * 64, PS, __builtin_popcountll(sel), sel, t, 0, qf, tg, nullptr, lane, os);
        float ow[4];
        nsa_branch<2>(P0 + C_KW + g * 64, P0 + C_VW + g * 64, PS, 8, 0ull, t, 0, qf, tg, nullptr, lane, ow);
#pragma unroll
        for (int h = 0; h < 4; ++h) {
            const float gc = sigmoidf_(bf2f(prow[C_GT + 0 + g * 4 + h])), gs = sigmoidf_(bf2f(prow[C_GT + 8 + g * 4 + h])), gwn = sigmoidf_(bf2f(prow[C_GT + 16 + g * 4 + h]));
            F.mix[(size_t)m * D + 512 + (g * 4 + h) * 64 + lane] = (bf16)f2bf(gc * oc[h] + gs * os[h] + gwn * ow[h]);
        }
    }
    __syncthreads();
}

namespace nsa {
typedef short bf16x8 __attribute__((ext_vector_type(8)));
typedef float f32x16 __attribute__((ext_vector_type(16)));
typedef float f32x2_t __attribute__((ext_vector_type(2)));
typedef __bf16 bf16x2_t __attribute__((ext_vector_type(2)));
__device__ __forceinline__ unsigned cvtpk(float lo, float hi) { f32x2_t v = {lo, hi}; bf16x2_t b = __builtin_convertvector(v, bf16x2_t); return __builtin_bit_cast(unsigned, b); }
#define NSA_MFMA(a, b, c) __builtin_amdgcn_mfma_f32_32x32x16_bf16((a), (b), (c), 0, 0, 0)
constexpr int KP = 144, VP = 136;
constexpr int KT_BYTES = 64 * KP, VT_BYTES = 64 * VP;
constexpr int L_K = 0, L_V = 2 * KT_BYTES, L_TAB = L_V + 2 * VT_BYTES, L_IMPM = L_TAB + 8 * 132 * 4, L_IMPC = L_IMPM + 16384, L_STASH = L_IMPM  , L_SEL = L_STASH + 65536, L_END = L_SEL + 512;
static_assert(L_END <= RING_BYTES, "NSA LDS map");
constexpr float LOG2E = 1.4426950408889634f, C1 = 0.125f * LOG2E;
__device__ __forceinline__ int crow(int reg, int h) { return (reg & 3) + 8 * (reg >> 2) + 4 * h; }

struct Stage { v4u k, v; };
__device__ __forceinline__ void st_load(Stage& s, const bf16* kb, const bf16* vb, int pitch, int row0, int tid) {
    const size_t off = (size_t)(row0 + (tid >> 3)) * pitch + (tid & 7) * 8;
    s.k = *(const v4u*)(kb + off); s.v = *(const v4u*)(vb + off);
}
__device__ __forceinline__ void st_store(const Stage& s, LAS unsigned char* kl, LAS unsigned char* vl, int tid) {
    const int key = tid >> 3, ch = tid & 7;
    *(LAS v4u*)(kl + key * KP + ch * 16) = s.k;
    LAS unsigned short* vp = (LAS unsigned short*)(vl + (ch * 8) * VP + key * 2);
    vp[0 * (VP / 2)] = (unsigned short)(s.v.x & 0xffffu); vp[1 * (VP / 2)] = (unsigned short)(s.v.x >> 16);
    vp[2 * (VP / 2)] = (unsigned short)(s.v.y & 0xffffu); vp[3 * (VP / 2)] = (unsigned short)(s.v.y >> 16);
    vp[4 * (VP / 2)] = (unsigned short)(s.v.z & 0xffffu); vp[5 * (VP / 2)] = (unsigned short)(s.v.z >> 16);
    vp[6 * (VP / 2)] = (unsigned short)(s.v.w & 0xffffu); vp[7 * (VP / 2)] = (unsigned short)(s.v.w >> 16);
}
__device__ __forceinline__ void qk(f32x16& p0, f32x16& p1, const LAS unsigned char* kl, const bf16x8 (&qf)[4], int r, int h) {
    const LAS unsigned char* a = kl + r * KP + h * 16;
    f32x16 z;
#pragma unroll
    for (int i = 0; i < 16; ++i) z[i] = 0.f;
#pragma unroll
    for (int s = 0; s < 4; ++s) {
        const bf16x8 a0 = *(const LAS bf16x8*)(a + 32 * s), a1 = *(const LAS bf16x8*)(a + 32 * KP + 32 * s);
        p0 = NSA_MFMA(a0, qf[s], s ? p0 : z); p1 = NSA_MFMA(a1, qf[s], s ? p1 : z);
    }
}
__device__ __forceinline__ void pv(f32x16 (&o)[2], const LAS unsigned char* vl, const f32x16& p0, const f32x16& p1, int r, int h) {
#pragma unroll
    for (int kt = 0; kt < 2; ++kt)
#pragma unroll
        for (int s = 0; s < 2; ++s) {
            const f32x16& p = kt ? p1 : p0;
            v4u w; w.x = cvtpk(p[8 * s], p[8 * s + 1]); w.y = cvtpk(p[8 * s + 2], p[8 * s + 3]); w.z = cvtpk(p[8 * s + 4], p[8 * s + 5]); w.w = cvtpk(p[8 * s + 6], p[8 * s + 7]);
            const bf16x8 pb = __builtin_bit_cast(bf16x8, w);
#pragma unroll
            for (int dt = 0; dt < 2; ++dt) {
                const LAS unsigned char* va = vl + (32 * dt + r) * VP + (32 * kt + 16 * s + 4 * h) * 2;
                const v2u lo = *(const LAS v2u*)va, hi = *(const LAS v2u*)(va + 16);
                v4u vv; vv.x = lo.x; vv.y = lo.y; vv.z = hi.x; vv.w = hi.y;
                o[dt] = NSA_MFMA(__builtin_bit_cast(bf16x8, vv), pb, o[dt]);
            }
            __builtin_amdgcn_sched_barrier(0);
        }
}
template <int BR, bool NEAR>
__device__ __forceinline__ void to_scores_(f32x16& p0, f32x16& p1, int tile, int t, int lim, bool lsel, const LAS float* tabh, float bfar, int h) {
#pragma unroll
    for (int kt = 0; kt < 2; ++kt)
#pragma unroll
        for (int reg = 0; reg < 16; ++reg) {
            const int kk = 64 * tile + 32 * kt + crow(reg, h);
            int dist; bool valid;
            if (BR == 0) { valid = kk < lim; dist = t - 16 * kk - 31; }
            else { dist = t - kk; valid = (BR == 1) ? (lsel && dist >= 0) : (dist >= 0 && dist < 512); }
            float bb = bfar;
            if (NEAR) { const int di = dist < 0 ? 0 : (dist > 128 ? 128 : dist); bb = tabh[di]; }
            if (kt) p1[reg] = valid ? __builtin_fmaf(p1[reg], C1, bb) : -INFINITY; else p0[reg] = valid ? __builtin_fmaf(p0[reg], C1, bb) : -INFINITY;
        }
}
template <int BR>
__device__ __forceinline__ void to_scores(f32x16& p0, f32x16& p1, int tile, int t, int lim, bool lsel, bool near, const LAS float* tabh, float bfar, int h) {
    if (near) to_scores_<BR, true>(p0, p1, tile, t, lim, lsel, tabh, bfar, h); else to_scores_<BR, false>(p0, p1, tile, t, lim, lsel, tabh, bfar, h);
}
__device__ __forceinline__ float max32(const f32x16& p0, const f32x16& p1) {
    float a = fmaxf(p0[0], p1[0]);
#pragma unroll
    for (int i = 1; i < 16; ++i) a = fmaxf(a, fmaxf(p0[i], p1[i]));
    return fmaxf(a, __shfl_xor(a, 32));
}
__device__ __forceinline__ void online(f32x16& p0, f32x16& p1, float& m, float& l, f32x16 (&o)[2], bool with_o) {
    const float tm = max32(p0, p1), mn = fmaxf(m, tm), mu = (mn == -INFINITY) ? 0.f : mn;
    const float alpha = __builtin_amdgcn_exp2f(m - mu); m = mn;
    float sum = 0.f;
#pragma unroll
    for (int i = 0; i < 16; ++i) { p0[i] = __builtin_amdgcn_exp2f(p0[i] - mu); p1[i] = __builtin_amdgcn_exp2f(p1[i] - mu); sum += p0[i] + p1[i]; }
    l = l * alpha + sum;
    if (with_o) {
#pragma unroll
        for (int i = 0; i < 16; ++i) { o[0][i] *= alpha; o[1][i] *= alpha; }
    }
}

__device__ __forceinline__ size_t row_of(int b, int qb, int w, int lane_opaque) { return (size_t)b * SEQ + 64 * qb + 8 * w + ((lane_opaque & 31) >> 2); }
#define NSA_OPAQUE_LANE(v) int v = lane; asm volatile("" : "+v"(v))
__device__ __forceinline__ void unit(const Ctx& F, int b, int g, int qb) {
    LAS unsigned char* L = F.lds + RING_OFF;
    const LAS float* tab2 = (const LAS float*)(L + L_TAB);
    LAS float* impM = (LAS float*)(L + L_IMPM); LAS float* impC = (LAS float*)(L + L_IMPC);
    LAS unsigned* selw = (LAS unsigned*)(L + L_SEL);
    const int tid = F.tid, lane = F.lane, w = F.wave, r = lane & 31, h = lane >> 5;
    const int t0 = 64 * qb, cur = qb, ql = 8 * w + (r >> 2), hp = r & 3, t = t0 + ql;
    const LAS float* tabh = tab2 + (g * 4 + hp) * 132; const float bfar = tabh[128];
    bf16x8 qf[4];
#pragma unroll
    for (int s = 0; s < 4; ++s) qf[s] = *(const bf16x8*)(F.proj + ((size_t)b * SEQ + t) * PS + C_NQ + (g * 4 + hp) * 64 + 16 * s + 8 * h);
    __syncthreads();
    for (int i = tid; i < 8192; i += NWAVES * 64) impM[i] = 0.f;
    f32x16 out[2], o[2];
#pragma unroll
    for (int i = 0; i < 16; ++i) { out[0][i] = 0.f; out[1][i] = 0.f; }
    Stage st;
    const bf16* P0 = F.proj + (size_t)b * SEQ * PS;
    {
        const bf16* kb = F.kcmp + (size_t)(b * 2 + g) * 256 * 64; const bf16* vb = F.vcmp + (size_t)(b * 2 + g) * 256 * 64;
        const int ntc = (4 * qb + 3 + 63) >> 6, nv = (t >= 31) ? ((t - 31) >> 4) + 1 : 0;
        float m = -INFINITY, l = 0.f;
#pragma unroll 1
        for (int pass = 0; pass < 2; ++pass) {
            float mu = 0.f, linv = 0.f;
            if (pass == 1) { l += __shfl_xor(l, 32); mu = (m == -INFINITY) ? 0.f : m; linv = (l > 0.f) ? 1.0f / l : 0.f;
#pragma unroll
                for (int i = 0; i < 16; ++i) { o[0][i] = 0.f; o[1][i] = 0.f; } }
            st_load(st, kb, vb, 64, 0, tid); st_store(st, L + L_K, L + L_V, tid); __syncthreads();
#pragma unroll 1
            for (int c = 0; c < ntc; ++c) {
                const int bi = c & 1;
                if (c + 1 < ntc) st_load(st, kb, vb, 64, 64 * (c + 1), tid);
                f32x16 p0, p1; qk(p0, p1, L + L_K + bi * KT_BYTES, qf, r, h);
                const bool near = (t0 - 16 * (64 * c + 63) - 31) < 128;
                __builtin_amdgcn_sched_barrier(0);
                to_scores<0>(p0, p1, c, t, nv, true, near, tabh, bfar, h);
                __builtin_amdgcn_sched_barrier(0);
                if (pass == 0) { online(p0, p1, m, l, o, false); }
                else {
#pragma unroll
                    for (int i = 0; i < 16; ++i) { p0[i] = __builtin_amdgcn_exp2f(p0[i] - mu) * linv; p1[i] = __builtin_amdgcn_exp2f(p1[i] - mu) * linv; }
#pragma unroll
                    for (int kt = 0; kt < 2; ++kt)
#pragma unroll
                        for (int q4 = 0; q4 < 4; ++q4) {
                            const f32x16& p = kt ? p1 : p0;
                            float carry = p[4 * q4 + 3], mainv = 2.f * (p[4 * q4] + p[4 * q4 + 1] + p[4 * q4 + 2]) + carry;
                            mainv += __shfl_xor(mainv, 1); mainv += __shfl_xor(mainv, 2); carry += __shfl_xor(carry, 1); carry += __shfl_xor(carry, 2);
                            const int j = 16 * c + 8 * kt + 2 * q4 + h;
                            if (hp == 0) { impM[ql * 64 + j] = mainv; if (j + 1 < 64) impC[ql * 64 + j + 1] = carry; }
                        }
                    __builtin_amdgcn_sched_barrier(0);
                    pv(o, L + L_V + bi * VT_BYTES, p0, p1, r, h);
                }
                if (c + 1 < ntc) st_store(st, L + L_K + (bi ^ 1) * KT_BYTES, L + L_V + (bi ^ 1) * VT_BYTES, tid);
                __syncthreads();
            }
        }
        NSA_OPAQUE_LANE(lo_); const float gc = sigmoidf_(bf2f(F.proj[row_of(b, qb, w, lo_) * PS + C_GT + 0 + g * 4 + (lo_ & 3)]));
#pragma unroll
        for (int i = 0; i < 16; ++i) { out[0][i] += gc * o[0][i]; out[1][i] += gc * o[1][i]; }
    }
    if (cur >= 16) {
        int tq_ = tid; asm volatile("" : "+v"(tq_));
        const int q = tq_ >> 3, part = tq_ & 7;
        const LAS float* im = impM + q * 64; const LAS float* ic = impC + q * 64;
        float sc[8]; int cnt[8];
#pragma unroll
        for (int i = 0; i < 8; ++i) { const int j = part * 8 + i; const float v = im[j] + ic[j]; sc[i] = (j == 0 || j == cur || j + 1 == cur) ? 1e9f : (j <= cur ? v : -1e9f); cnt[i] = 0; }
#pragma unroll 4
        for (int jj = 0; jj < 64; ++jj) {
            const float v = im[jj] + ic[jj]; const float sv = (jj == 0 || jj == cur || jj + 1 == cur) ? 1e9f : (jj <= cur ? v : -1e9f);
#pragma unroll
            for (int i = 0; i < 8; ++i) cnt[i] += ((sv > sc[i]) || (sv == sc[i] && jj < part * 8 + i)) ? 1 : 0;
        }
        unsigned bits = 0;
#pragma unroll
        for (int i = 0; i < 8; ++i) bits |= ((cnt[i] < 16) && (part * 8 + i <= cur)) ? (1u << i) : 0u;
        unsigned lo = (part < 4) ? (bits << (8 * part)) : 0u, hi = (part >= 4) ? (bits << (8 * (part - 4))) : 0u;
        lo |= __shfl_xor(lo, 1); lo |= __shfl_xor(lo, 2); lo |= __shfl_xor(lo, 4); hi |= __shfl_xor(hi, 1); hi |= __shfl_xor(hi, 2); hi |= __shfl_xor(hi, 4);
        if (part == 0) { selw[2 * q] = lo; selw[2 * q + 1] = hi; }
    } else {
        if (tid < 64) { selw[2 * tid] = (1u << (cur + 1)) - 1u; selw[2 * tid + 1] = 0u; }
    }
    __syncthreads();
    const unsigned selLo = selw[2 * ql], selHi = selw[2 * ql + 1];
    LAS float* stash = (LAS float*)(L + L_STASH) + tid;
#pragma unroll
    for (int i = 0; i < 16; ++i) { stash[i * 512] = out[0][i]; stash[(16 + i) * 512] = out[1][i]; }
    unsigned long long U;
    { unsigned ulo = selw[2 * lane], uhi = selw[2 * lane + 1];
#pragma unroll
      for (int s = 1; s < 64; s <<= 1) { ulo |= __shfl_xor(ulo, s); uhi |= __shfl_xor(uhi, s); }
      U = ((unsigned long long)(unsigned)__builtin_amdgcn_readfirstlane(uhi) << 32) | (unsigned)__builtin_amdgcn_readfirstlane(ulo); }
    {
        const bf16* kb = P0 + C_KS + g * 64; const bf16* vb = P0 + C_VS + g * 64;
        float m = -INFINITY, l = 0.f;
#pragma unroll
        for (int i = 0; i < 16; ++i) { o[0][i] = 0.f; o[1][i] = 0.f; }
        unsigned long long rem = U; int j = (int)__builtin_ctzll(rem); rem &= rem - 1;
        st_load(st, kb, vb, PS, 64 * j, tid); st_store(st, L + L_K, L + L_V, tid); __syncthreads();
        int bi = 0;
#pragma unroll 1
        for (;;) {
            const bool more = rem != 0ull; int jn = 0;
            if (more) { jn = (int)__builtin_ctzll(rem); rem &= rem - 1; st_load(st, kb, vb, PS, 64 * jn, tid); }
            f32x16 p0, p1; qk(p0, p1, L + L_K + bi * KT_BYTES, qf, r, h);
            const bool lsel = ((j < 32 ? (selLo >> j) : (selHi >> (j - 32))) & 1u) != 0u;
            __builtin_amdgcn_sched_barrier(0);
            to_scores<1>(p0, p1, j, t, 0, lsel, (cur - j) <= 2, tabh, bfar, h);
            __builtin_amdgcn_sched_barrier(0);
            online(p0, p1, m, l, o, true);
            __builtin_amdgcn_sched_barrier(0);
            pv(o, L + L_V + bi * VT_BYTES, p0, p1, r, h);
            if (more) st_store(st, L + L_K + (bi ^ 1) * KT_BYTES, L + L_V + (bi ^ 1) * VT_BYTES, tid);
            __syncthreads();
            if (!more) break;
            j = jn; bi ^= 1;
        }
        l += __shfl_xor(l, 32);
        NSA_OPAQUE_LANE(lo_); const float gs = sigmoidf_(bf2f(F.proj[row_of(b, qb, w, lo_) * PS + C_GT + 8 + g * 4 + (lo_ & 3)])) / l;
#pragma unroll
        for (int i = 0; i < 16; ++i) { stash[i * 512] += gs * o[0][i]; stash[(16 + i) * 512] += gs * o[1][i]; }
    }
    {
        const bf16* kb = P0 + C_KW + g * 64; const bf16* vb = P0 + C_VW + g * 64;
        float m = -INFINITY, l = 0.f;
#pragma unroll
        for (int i = 0; i < 16; ++i) { o[0][i] = 0.f; o[1][i] = 0.f; }
        const int j0 = cur >= 8 ? cur - 8 : 0;
        st_load(st, kb, vb, PS, 64 * j0, tid); st_store(st, L + L_K, L + L_V, tid); __syncthreads();
#pragma unroll 1
        for (int j = j0; j <= cur; ++j) {
            const int bi = (j - j0) & 1;
            if (j < cur) st_load(st, kb, vb, PS, 64 * (j + 1), tid);
            f32x16 p0, p1; qk(p0, p1, L + L_K + bi * KT_BYTES, qf, r, h);
            __builtin_amdgcn_sched_barrier(0);
            to_scores<2>(p0, p1, j, t, 0, true, (cur - j) <= 2, tabh, bfar, h);
            __builtin_amdgcn_sched_barrier(0);
            online(p0, p1, m, l, o, true);
            __builtin_amdgcn_sched_barrier(0);
            pv(o, L + L_V + bi * VT_BYTES, p0, p1, r, h);
            if (j < cur) st_store(st, L + L_K + (bi ^ 1) * KT_BYTES, L + L_V + (bi ^ 1) * VT_BYTES, tid);
            __syncthreads();
        }
        l += __shfl_xor(l, 32);
        NSA_OPAQUE_LANE(lo_); const float gw = sigmoidf_(bf2f(F.proj[row_of(b, qb, w, lo_) * PS + C_GT + 16 + g * 4 + (lo_ & 3)])) / l;
#pragma unroll
        for (int i = 0; i < 16; ++i) { out[0][i] = stash[i * 512] + gw * o[0][i]; out[1][i] = stash[(16 + i) * 512] + gw * o[1][i]; }
    }
    NSA_OPAQUE_LANE(lo2_);
    bf16* orow = F.mix + row_of(b, qb, w, lo2_) * D + 512 + (g * 4 + (lo2_ & 3)) * 64 + 4 * (lo2_ >> 5);
#pragma unroll
    for (int dt = 0; dt < 2; ++dt)
#pragma unroll
        for (int q4 = 0; q4 < 4; ++q4) { v2u wv; wv.x = cvtpk(out[dt][4 * q4], out[dt][4 * q4 + 1]); wv.y = cvtpk(out[dt][4 * q4 + 2], out[dt][4 * q4 + 3]); *(v2u*)(orow + 32 * dt + 8 * q4) = wv; }
}
__device__ __forceinline__ void phase(const Ctx& F) {
    LAS float* tab2 = (LAS float*)(F.lds + RING_OFF + L_TAB);
    for (int i = F.tid; i < 8 * 129; i += NWAVES * 64) { const int hh = i / 129, n = i % 129; tab2[hh * 132 + n] = F.rel_bias[t5_bucket(n) * 8 + hh] * LOG2E; }
    __syncthreads();
    const int nper = (2048 + F.G - 1) / F.G;
#pragma unroll 1
    for (int k = 0; k < nper; ++k) {
        int b, g, qb;
        if (F.G == 256) { const int a = F.vcu & 7, bg = F.vcu >> 3; qb = 63 - 8 * k - ((k & 1) ? (7 - a) : a); b = bg >> 1; g = bg & 1; }
        else { const int u = F.vcu + k * F.G; if (u >= 2048) break; b = (u & 31) >> 1; g = u & 1; qb = 63 - (u >> 5); }
        unit(F, b, g, qb);
    }
    __syncthreads();
}
#undef NSA_MFMA
#undef NSA_OPAQUE_LANE
}

struct Args { const float* in[19]; float* out; unsigned char* ws; int ph_lo, ph_hi; };
__global__ void __launch_bounds__(NWAVES * 64, 2) fwd(Args args) {
    extern __shared__ __attribute__((aligned(16))) unsigned char lds[];
    Ctx F;
    F.lds = (LAS unsigned char*)lds;
    volatile LAS unsigned* MISC = (volatile LAS unsigned*)(F.lds + MISC_OFF);
    F.tid = threadIdx.x; F.lane = F.tid & 63; F.wave = __builtin_amdgcn_readfirstlane(F.tid >> 6);
    F.G = gridDim.x; { const int bx = blockIdx.x; F.vcu = (F.G % 8 == 0) ? (bx % 8) * (F.G / 8) + bx / 8 : bx; }
    unsigned char* ws = args.ws;
    gu32* ctl = (gu32*)(ws + WS_CTL);
    F.x = args.in[0]; F.w_in = args.in[1]; F.lb_param = args.in[2]; F.norm_w = args.in[3]; F.pos_k = args.in[4]; F.w1_k = args.in[5]; F.w2_k = args.in[6];
    F.pos_v = args.in[7]; F.w1_v = args.in[8]; F.w2_v = args.in[9]; F.rel_bias = args.in[10]; F.w_out = args.in[11]; F.ln1_g = args.in[12]; F.ln1_b = args.in[13];
    F.w_gate = args.in[14]; F.w_up = args.in[15]; F.w_down = args.in[16]; F.ln2_g = args.in[17]; F.ln2_b = args.in[18]; F.out = args.out;
    F.win_t = (bf16*)(ws + WS_WIN); F.wout_t = (bf16*)(ws + WS_WOUT); F.wgu_t = (bf16*)(ws + WS_WGU); F.wdn_t = (bf16*)(ws + WS_WDN);
    F.kcmp = (bf16*)(ws + WS_KCMP); F.vcmp = (bf16*)(ws + WS_VCMP); F.xb = (bf16*)(ws + WS_XB); F.mix = (bf16*)(ws + WS_MIX); F.proj = (bf16*)(ws + WS_PROJ);
    F.opre = (float*)(ws + WS_OPRE);
    for (int u = F.tid; u < (LDS_BYTES - LDSCTL_OFF) / 4; u += NWAVES * 64) ((LAS unsigned*)(F.lds + LDSCTL_OFF))[u] = 0u;
    __syncthreads();
    XcdBarrier bar; bar.bar = (unsigned*)(ctl + CW_BAR); bar.x = 0; bar.st = nullptr;
    if (ONE_LAUNCH) bar = xcd_barrier_post((unsigned*)(ctl + CW_BAR), MISC + 8);
    const int lo = args.ph_lo, hi = args.ph_hi;
#define IN(k) (lo <= (k) && (k) < hi)
#define FRESH() do { int t_ = threadIdx.x; asm volatile("" : "+v"(t_)); F.tid = t_; F.lane = t_ & 63; } while (0)
#define SEAM(k) do { if (IN(k) && IN((k) + 1)) { if (ONE_LAUNCH) xcd_barrier(bar); } } while (0)

    if (IN(0)) { p_prologue(F); } SEAM(0);
    for (int l = 0; l < DEPTH; ++l) {
        const int p0 = 1 + 8 * l;
        const float* xin = (l == 0) ? F.x : F.out;
        if (IN(p0 + 0)) {
            pg8::Gemm g{F.xb, F.win_t + (size_t)l * PS * D, M, PS, D}; pg8::StaticOrder S; S.init(M, PS, F.G, (int)blockIdx.x);
            pg8::EpiBf16<0> E{F.proj, PS, nullptr, 0, 0, 1.f};
            pg8::gemm_phase<pg8::EpiBf16<0>, pg8::StaticOrder, true, true>(F.lds + RING_OFF, g, S, E);
        } SEAM(p0 + 0);
        if (IN(p0 + 1)) { FRESH();
            for (int u = F.vcu; u < 256; u += F.G) hgrn_scan_unit(F, l, u);
            for (int cu = F.vcu; cu < 1024; cu += F.G) cmp_unit(F, l, cu);
        } SEAM(p0 + 1);
        if (IN(p0 + 2)) { FRESH();
            hgrn_finalize(F, l);
#if defined(NSA_SCALAR)
            FRESH(); nsa_attn_phase(F, l);
#else
            FRESH(); nsa::phase(F);
#endif
        } SEAM(p0 + 2);
        if (IN(p0 + 3)) {
            pg8::Gemm g{F.mix, F.wout_t + (size_t)l * D * D, M, D, D}; pg8::StaticOrder S; S.init(M, D, F.G, (int)blockIdx.x);
            pg8::EpiResid E{xin, F.out, D, ALPHA};
            pg8::gemm_phase<pg8::EpiResid, pg8::StaticOrder, true, true>(F.lds + RING_OFF, g, S, E);
        } SEAM(p0 + 3);
        if (IN(p0 + 4)) { FRESH(); p_layernorm(F, F.ln1_g + l * D, F.ln1_b + l * D); } SEAM(p0 + 4);
        if (IN(p0 + 5)) {
            pg8::Gemm g{F.xb, F.wgu_t + (size_t)l * NGU * D, M, NGU, D}; pg8::StaticOrder S; S.init(M, NGU, F.G, (int)blockIdx.x);
            pg8::EpiSwiGLU E{F.proj, DFF};
            pg8::gemm_phase<pg8::EpiSwiGLU, pg8::StaticOrder, true, true>(F.lds + RING_OFF, g, S, E);
        } SEAM(p0 + 5);
        if (IN(p0 + 6)) {
            pg8::Gemm g{F.proj, F.wdn_t + (size_t)l * D * DFF, M, D, DFF}; pg8::StaticOrder S; S.init(M, D, F.G, (int)blockIdx.x);
            pg8::EpiResid E{F.out, F.out, D, ALPHA};
            pg8::gemm_phase<pg8::EpiResid, pg8::StaticOrder, true, true>(F.lds + RING_OFF, g, S, E);
        } SEAM(p0 + 6);
        if (IN(p0 + 7)) { FRESH(); p_layernorm(F, F.ln2_g + l * D, F.ln2_b + l * D); } SEAM(p0 + 7);
    }
#undef IN
#undef SEAM
}

extern "C" void kernel_launch(void* const* d_in, const int* in_sizes, int n_in, void* d_out, int out_size, void* d_ws, size_t ws_size, hipStream_t stream) {
    static int grid = 0;
    if (grid == 0) {
        if (n_in != 19 || in_sizes[0] != M * D || out_size != M * D || ws_size < WS_END) { fprintf(stderr, "kernel_launch: unexpected shapes (n_in %d, in0 %d, out %d, ws %zu); nothing launched\n", n_in, n_in > 0 ? in_sizes[0] : -1, out_size, ws_size); grid = -1; return; }
        int dev = 0, cus = 0, per_cu = 0;
        if (hipGetDevice(&dev) != hipSuccess || hipDeviceGetAttribute(&cus, hipDeviceAttributeMultiprocessorCount, dev) != hipSuccess) { grid = -1; return; }
        if (hipFuncSetAttribute((const void*)fwd, hipFuncAttributeMaxDynamicSharedMemorySize, LDS_BYTES) != hipSuccess) { fprintf(stderr, "kernel_launch: hipFuncSetAttribute failed\n"); grid = -1; return; }
        if (hipOccupancyMaxActiveBlocksPerMultiprocessor(&per_cu, (const void*)fwd, NWAVES * 64, LDS_BYTES) != hipSuccess || per_cu < 1) fprintf(stderr, "kernel_launch: note: occupancy query reports %d\n", per_cu);
        (void)hipGetLastError();
        grid = cus;
    }
    if (grid < 0) return;
    if (hipMemsetAsync((char*)d_ws + WS_CTL, 0, CTL_ZERO_BYTES, stream) != hipSuccess) return;
    Args a{};
    for (int i = 0; i < 19; ++i) a.in[i] = (const float*)d_in[i];
    a.out = (float*)d_out; a.ws = (unsigned char*)d_ws;
    if (ONE_LAUNCH) { a.ph_lo = 0; a.ph_hi = N_PHASES; hipLaunchKernelGGL(fwd, dim3(grid), dim3(NWAVES * 64), LDS_BYTES, stream, a); }
    else { for (int p = 0; p < N_PHASES; ++p) { a.ph_lo = p; a.ph_hi = p + 1; hipLaunchKernelGGL(fwd, dim3(grid), dim3(NWAVES * 64), LDS_BYTES, stream, a); } }
}
```

```cpp
#define MK_N_LAUNCHES 1
#include <hip/hip_runtime.h>
#include <cstdio>
#include <cstdint>
#include <cmath>
namespace pg8 {
#define PG8_LAS __attribute__((address_space(3)))
typedef unsigned short bf16_t;
typedef short bf16x8 __attribute__((ext_vector_type(8)));
typedef float f32x4 __attribute__((ext_vector_type(4)));
typedef unsigned u32x4 __attribute__((ext_vector_type(4)));
constexpr int BM = 256, BK = 64, HALF = 128, HTB = HALF * BK * 2  , STAGE_BYTES = 8 * HTB, NXCD = 8, WGM = 8;

__host__ __device__ __forceinline__ int lds_byte(int r, int c) { const int st = (r >> 4) * 2 + (c >> 5), rr = r & 15, cc = c & 31, ob = rr * 64 + cc * 2; return st * 1024 + (ob ^ (((ob >> 9) & 1) << 5)); }
__host__ __device__ __forceinline__ void stage_rc(int b, int& R, int& C) { const int st = b / 1024, sb = b % 1024, swz = sb ^ (((sb >> 9) & 1) << 5); R = (st >> 1) * 16 + swz / 64; C = (st & 1) * 32 + (swz % 64) / 2; }
__host__ __device__ __forceinline__ int perm32(int rho) { const int n = rho >> 4, i = rho & 15; return 8 * (i >> 2) + 4 * n + (i & 3); }

struct Unit { int pm, pn; };
struct Gemm { const bf16_t* A; const bf16_t* Bt; int M, N, K; };

struct StaticOrder {
    int nM, nN, nwg, G, c;
    __host__ __device__ void init(int M, int N, int G_, int c_) { nM = M / BM; nN = N / BM; nwg = nM * nN; G = G_; c = c_; }
    __host__ __device__ bool next(int i, Unit& u) const {
        const long L = (long)i * G + c; if (L >= nwg) return false;
        int wgid = (int)L; { const int q = nwg / NXCD, r = nwg % NXCD, xcd = wgid % NXCD, off = wgid / NXCD; wgid = (xcd < r ? xcd * (q + 1) : r * (q + 1) + (xcd - r) * q) + off; }
        const int nig = WGM * nN, gid = wgid / nig, fm = gid * WGM, gsz = (nM - fm) < WGM ? (nM - fm) : WGM;
        u.pm = fm + ((wgid % nig) % gsz); u.pn = (wgid % nig) / gsz; return true;
    }
    __device__ __forceinline__ void a_ready(const Unit&) const {}
    __device__ __forceinline__ void done(const Unit&) const {}
};

__device__ __forceinline__ unsigned cvt_pk_bf16(float lo, float hi) { unsigned r; asm volatile("v_cvt_pk_bf16_f32 %0, %1, %2" : "=v"(r) : "v"(lo), "v"(hi)); return r; }
typedef float f32x2 __attribute__((ext_vector_type(2)));
__device__ __forceinline__ f32x2 gelu_pk(f32x2 v) {
    const f32x2 av = __builtin_elementwise_abs(v), d = av * 0.2316418882f + 1.0f;
    f32x2 t; t.x = __builtin_amdgcn_rcpf(d.x); t.y = __builtin_amdgcn_rcpf(d.y);
    f32x2 q = t * 0.5307027145f + (-0.7265760135f); q = q * t + 0.7107068705f; q = q * t + (-0.142248368f); q = q * t + 0.127414796f; q = q * t;
    const f32x2 s = (v * v) * (-0.72134752044f);
    f32x2 e; e.x = __builtin_amdgcn_exp2f(s.x); e.y = __builtin_amdgcn_exp2f(s.y);
    const f32x2 m = v * (q * e), r = v - m;
    f32x2 o; o.x = v.x < 0.f ? m.x : r.x; o.y = v.y < 0.f ? m.y : r.y; return o;
}

template <int ACT  > struct EpiBf16 {
    static constexpr bool PERM = true, AFTER_DRAIN = false; static_assert(ACT == 0 || ACT == 1, "EpiBf16: ACT is 0 (none) or 1 (gelu_pk)");
    bf16_t* O; int ldc; const float* bias; int split_cols; size_t split_stride; float scale0;
    __device__ __forceinline__ void operator()(const f32x4 (&acc)[2][2][4][2], const Unit& u, int wr, int wc, int fr, int fq) const {
        const int row0 = u.pm * BM + wr * 64 + fr; int colt = u.pn * BM; bf16_t* base = O;
        float sc = 1.f; if (split_cols) { const int t = colt / split_cols; base += (size_t)t * split_stride; colt -= t * split_cols; if (t == 0) sc = scale0; }
        const int col0 = colt + wc * 32 + 8 * fq, bcol0 = u.pn * BM + wc * 32 + 8 * fq;
        f32x4 bv[2][2];
#pragma unroll
        for (int bj = 0; bj < 2; ++bj)
#pragma unroll
            for (int n = 0; n < 2; ++n) bv[bj][n] = bias ? *(const f32x4*)(bias + bcol0 + bj * HALF + 4 * n) : (f32x4){0.f, 0.f, 0.f, 0.f};
#pragma unroll
        for (int ai = 0; ai < 2; ++ai)
#pragma unroll
            for (int m = 0; m < 4; ++m) { bf16_t* rowp = base + (size_t)(row0 + ai * HALF + m * 16) * ldc + col0;
#pragma unroll
                for (int bj = 0; bj < 2; ++bj) { f32x4 v0 = acc[ai][bj][m][0] + bv[bj][0], v1 = acc[ai][bj][m][1] + bv[bj][1];
                    if (ACT == 1) { f32x2 a = gelu_pk((f32x2){v0[0], v0[1]}), b = gelu_pk((f32x2){v0[2], v0[3]}), c = gelu_pk((f32x2){v1[0], v1[1]}), d = gelu_pk((f32x2){v1[2], v1[3]});
                        v0 = (f32x4){a.x, a.y, b.x, b.y}; v1 = (f32x4){c.x, c.y, d.x, d.y}; }
                    v0 = v0 * sc; v1 = v1 * sc; u32x4 w; w.x = cvt_pk_bf16(v0[0], v0[1]); w.y = cvt_pk_bf16(v0[2], v0[3]); w.z = cvt_pk_bf16(v1[0], v1[1]); w.w = cvt_pk_bf16(v1[2], v1[3]);
                    *(u32x4*)(rowp + bj * HALF) = w; } }
    }
};

struct EpiResid {
    static constexpr bool PERM = false, AFTER_DRAIN = false;
    const float* xin; float* out; int ldc; float alpha;
    __device__ __forceinline__ void operator()(const f32x4 (&acc)[2][2][4][2], const Unit& u, int wr, int wc, int fr, int fq) const {
        const int col0 = u.pn * BM + wc * 32 + 4 * fq;
#pragma unroll
        for (int ai = 0; ai < 2; ++ai)
#pragma unroll
            for (int m = 0; m < 4; ++m) { const size_t off = (size_t)(u.pm * BM + ai * HALF + wr * 64 + m * 16 + fr) * ldc + col0;
#pragma unroll
                for (int bj = 0; bj < 2; ++bj)
#pragma unroll
                    for (int n = 0; n < 2; ++n) { const size_t p = off + bj * HALF + n * 16; const f32x4 xv = *(const f32x4*)(xin + p); *(f32x4*)(out + p) = xv * alpha + acc[ai][bj][m][n]; } }
    }
};
struct EpiSwiGLU {
    static constexpr bool PERM = true, AFTER_DRAIN = false;
    bf16_t* H; int ldh;
    __device__ __forceinline__ static float silu(float x) { return x * __builtin_amdgcn_rcpf(1.0f + __expf(-x)); }
    __device__ __forceinline__ void operator()(const f32x4 (&acc)[2][2][4][2], const Unit& u, int wr, int wc, int fr, int fq) const {
        const int row0 = u.pm * BM + wr * 64 + fr, col0 = u.pn * HALF + wc * 32 + 8 * fq;
#pragma unroll
        for (int ai = 0; ai < 2; ++ai)
#pragma unroll
            for (int m = 0; m < 4; ++m) { bf16_t* rowp = H + (size_t)(row0 + ai * HALF + m * 16) * ldh + col0;
                const f32x4 g0 = acc[ai][0][m][0], g1 = acc[ai][0][m][1], u0 = acc[ai][1][m][0], u1 = acc[ai][1][m][1];
                u32x4 w; w.x = cvt_pk_bf16(silu(g0[0]) * u0[0], silu(g0[1]) * u0[1]); w.y = cvt_pk_bf16(silu(g0[2]) * u0[2], silu(g0[3]) * u0[3]);
                w.z = cvt_pk_bf16(silu(g1[0]) * u1[0], silu(g1[1]) * u1[1]); w.w = cvt_pk_bf16(silu(g1[2]) * u1[2], silu(g1[3]) * u1[3]);
                *(u32x4*)rowp = w; }
    }
};
template <class Epi, class Sched, bool ALIGN_EPI = false, bool SP2 = false>
__device__ __forceinline__ void gemm_phase(PG8_LAS unsigned char* lds, const Gemm g, const Sched& S, const Epi& E) {
    int tid_ = threadIdx.x; asm volatile("" : "+v"(tid_));
    const int tid = tid_, wid = __builtin_amdgcn_readfirstlane(tid >> 6), lane = tid & 63, wr = wid >> 2, wc = wid & 3, fr = lane & 15, fq = lane >> 4;
    const int K = g.K, nt = K / BK;
    unsigned voffA[2], voffB[2];
#pragma unroll
    for (int i = 0; i < 2; ++i) { int R, C; stage_rc(tid * 16 + i * 8192, R, C); const int Rb = Epi::PERM ? ((R & ~31) + perm32(R & 31)) : R;
        voffA[i] = (unsigned)(R * K + C) * 2u; voffB[i] = (unsigned)(Rb * K + C) * 2u; }
    const size_t kstep = (size_t)(BK * 2);
    const size_t hstep = (size_t)HALF * K * 2;
    const size_t tstep = 2 * hstep;
    const unsigned ldsw = (unsigned)wid * 1024u;
    const int aoff = lds_byte(wr * 64 + fr, fq * 8), boff = lds_byte(wc * 32 + fr, fq * 8);
#define PG8_SA(b, h) (((b) * 2 + (h)) * HTB)
#define PG8_SB(b, h) ((4 + (b) * 2 + (h)) * HTB)
#define PG8_STAGE(bufoff, gbase, voff) do { _Pragma("unroll") for (int _i = 0; _i < 2; ++_i) \
        __builtin_amdgcn_global_load_lds((const unsigned*)((const char*)(gbase) + (voff)[_i]), (PG8_LAS unsigned*)(lds + (bufoff) + ldsw + _i * 8192), 16, 0, 0); } while (0)
#define PG8_LDA(dst, b, h) do { _Pragma("unroll") for (int m = 0; m < 4; ++m) _Pragma("unroll") for (int k = 0; k < 2; ++k) dst[m][k] = *(const PG8_LAS bf16x8*)(lds + PG8_SA(b, h) + aoff + m * 2048 + k * 1024); } while (0)
#define PG8_LDB(dst, b, h) do { _Pragma("unroll") for (int n = 0; n < 2; ++n) _Pragma("unroll") for (int k = 0; k < 2; ++k) dst[n][k] = *(const PG8_LAS bf16x8*)(lds + PG8_SB(b, h) + boff + n * 2048 + k * 1024); } while (0)
#define PG8_MMA(ai, bj, At, Bt) do { __builtin_amdgcn_s_setprio(1); _Pragma("unroll") for (int m = 0; m < 4; ++m) _Pragma("unroll") for (int n = 0; n < 2; ++n) _Pragma("unroll") for (int k = 0; k < 2; ++k) \
        acc[ai][bj][m][n] = __builtin_amdgcn_mfma_f32_16x16x32_bf16(Bt[n][k], At[m][k], acc[ai][bj][m][n], 0, 0, 0); __builtin_amdgcn_s_setprio(0); } while (0)
#define PG8_WAIT_V(n) asm volatile("s_waitcnt vmcnt(" #n ")" ::: "memory")
#define PG8_WAIT_L(n) asm volatile("s_waitcnt lgkmcnt(" #n ")" ::: "memory")
#define PG8_BAR __builtin_amdgcn_s_barrier()
#define PG8_SCHED __builtin_amdgcn_sched_barrier(0)
    Unit cur, nxt; int ui = 0;
    if (!S.next(0, cur)) return;
    f32x4 acc[2][2][4][2];
#pragma unroll
    for (int a = 0; a < 2; ++a)
#pragma unroll
        for (int b = 0; b < 2; ++b)
#pragma unroll
            for (int m = 0; m < 4; ++m)
#pragma unroll
                for (int n = 0; n < 2; ++n) acc[a][b][m][n] = (f32x4){0.f, 0.f, 0.f, 0.f};
    bf16x8 At[4][2], B0[2][2], B1[2][2];
    const char* cA = (const char*)g.A + (size_t)cur.pm * tstep; const char* cB = (const char*)g.Bt + (size_t)cur.pn * tstep;
    S.a_ready(cur);
    if constexpr (SP2) {
        PG8_STAGE(PG8_SB(0, 0), cB, voffB); PG8_STAGE(PG8_SB(0, 1), cB + hstep, voffB); PG8_STAGE(PG8_SA(0, 0), cA, voffA); PG8_STAGE(PG8_SA(0, 1), cA + hstep, voffA);
        if (wr == 1) PG8_BAR;
        PG8_WAIT_V(2); PG8_BAR;
        PG8_STAGE(PG8_SB(1, 0), cB + kstep, voffB); PG8_STAGE(PG8_SA(1, 0), cA + kstep, voffA); PG8_STAGE(PG8_SB(1, 1), cB + hstep + kstep, voffB);
        PG8_WAIT_V(6); PG8_BAR;
    } else {
        PG8_STAGE(PG8_SB(0, 0), cB, voffB); PG8_STAGE(PG8_SA(0, 0), cA, voffA); PG8_STAGE(PG8_SB(0, 1), cB + hstep, voffB); PG8_STAGE(PG8_SA(0, 1), cA + hstep, voffA);
        if (wr == 1) PG8_BAR;
        PG8_WAIT_V(4); PG8_BAR;
        PG8_STAGE(PG8_SB(1, 0), cB + kstep, voffB); PG8_STAGE(PG8_SA(1, 0), cA + kstep, voffA); PG8_STAGE(PG8_SB(1, 1), cB + hstep + kstep, voffB);
        PG8_WAIT_V(6); PG8_BAR;
    }
    for (;;) {
        const bool has_next = S.next(ui + 1, nxt);
        const char* nA = has_next ? (const char*)g.A + (size_t)nxt.pm * tstep : cA; const char* nB = has_next ? (const char*)g.Bt + (size_t)nxt.pn * tstep : cB;
        for (int t = 0; t < nt; t += 2) {
            const bool last = (t == nt - 2);
            const char* a1 = cA + (size_t)(t + 1) * kstep;
            const char* a2 = last ? nA : cA + (size_t)(t + 2) * kstep; const char* b2 = last ? nB : cB + (size_t)(t + 2) * kstep;
            const char* a3 = a2 + kstep; const char* b3 = b2 + kstep;
            if (last && has_next) S.a_ready(nxt);
            if constexpr (SP2) {
            PG8_LDB(B0, 0, 0); PG8_LDB(B1, 0, 1); PG8_SCHED; PG8_LDA(At, 0, 0); PG8_STAGE(PG8_SA(1, 1), a1 + hstep, voffA);
            PG8_WAIT_V(8); PG8_WAIT_L(0); PG8_BAR; PG8_MMA(0, 0, At, B0); PG8_MMA(0, 1, At, B1); PG8_BAR; PG8_SCHED;
            PG8_LDA(At, 0, 1); PG8_STAGE(PG8_SB(0, 0), b2, voffB); PG8_STAGE(PG8_SB(0, 1), b2 + hstep, voffB); PG8_STAGE(PG8_SA(0, 0), a2, voffA);
            PG8_WAIT_V(8); PG8_WAIT_L(0); PG8_BAR; PG8_MMA(1, 0, At, B0); PG8_MMA(1, 1, At, B1); PG8_BAR; PG8_SCHED;
            PG8_LDB(B0, 1, 0); PG8_LDB(B1, 1, 1); PG8_SCHED; PG8_LDA(At, 1, 0); PG8_STAGE(PG8_SA(0, 1), a2 + hstep, voffA);
            PG8_WAIT_V(8); PG8_WAIT_L(0); PG8_BAR; PG8_MMA(0, 0, At, B0); PG8_MMA(0, 1, At, B1); PG8_BAR; PG8_SCHED;
            PG8_LDA(At, 1, 1); PG8_STAGE(PG8_SB(1, 0), b3, voffB); PG8_STAGE(PG8_SB(1, 1), b3 + hstep, voffB); PG8_STAGE(PG8_SA(1, 0), a3, voffA);
            PG8_WAIT_V(8); PG8_WAIT_L(0); PG8_BAR; PG8_MMA(1, 0, At, B0); PG8_MMA(1, 1, At, B1); PG8_BAR; PG8_SCHED;
            } else {
            PG8_LDB(B0, 0, 0); PG8_SCHED; PG8_LDA(At, 0, 0); PG8_STAGE(PG8_SA(1, 1), a1 + hstep, voffA);
            PG8_WAIT_L(8); PG8_BAR; PG8_WAIT_L(0); PG8_MMA(0, 0, At, B0); PG8_BAR; PG8_SCHED;
            PG8_LDB(B1, 0, 1); PG8_STAGE(PG8_SB(0, 0), b2, voffB);
            PG8_BAR; PG8_WAIT_L(0); PG8_MMA(0, 1, At, B1); PG8_BAR;
            PG8_LDA(At, 0, 1); PG8_STAGE(PG8_SA(0, 0), a2, voffA);
            PG8_BAR; PG8_WAIT_L(0); PG8_MMA(1, 0, At, B0); PG8_BAR; PG8_SCHED;
            PG8_STAGE(PG8_SB(0, 1), b2 + hstep, voffB);
            PG8_WAIT_V(6); PG8_BAR; PG8_MMA(1, 1, At, B1); PG8_BAR;
            PG8_LDB(B0, 1, 0); PG8_SCHED; PG8_LDA(At, 1, 0); PG8_STAGE(PG8_SA(0, 1), a2 + hstep, voffA);
            PG8_WAIT_L(8); PG8_BAR; PG8_WAIT_L(0); PG8_MMA(0, 0, At, B0); PG8_BAR; PG8_SCHED;
            PG8_LDB(B1, 1, 1); PG8_STAGE(PG8_SB(1, 0), b3, voffB);
            PG8_BAR; PG8_WAIT_L(0); PG8_MMA(0, 1, At, B1); PG8_BAR;
            PG8_LDA(At, 1, 1); PG8_STAGE(PG8_SA(1, 0), a3, voffA);
            PG8_BAR; PG8_WAIT_L(0); PG8_MMA(1, 0, At, B0); PG8_BAR; PG8_SCHED;
            PG8_STAGE(PG8_SB(1, 1), b3 + hstep, voffB);
            PG8_WAIT_V(6); PG8_BAR; PG8_MMA(1, 1, At, B1); PG8_BAR;
            }
        }
        if constexpr (ALIGN_EPI) { if (wr == 0) PG8_BAR; }
        if constexpr (!Epi::AFTER_DRAIN) { E(acc, cur, wr, wc, fr, fq); S.done(cur); }
        if (!has_next) break;
#pragma unroll
        for (int a = 0; a < 2; ++a)
#pragma unroll
            for (int b = 0; b < 2; ++b)
#pragma unroll
                for (int m = 0; m < 4; ++m)
#pragma unroll
                    for (int n = 0; n < 2; ++n) acc[a][b][m][n] = (f32x4){0.f, 0.f, 0.f, 0.f};
        cur = nxt; cA = nA; cB = nB; ++ui;
        if constexpr (ALIGN_EPI) { if (wr == 1) PG8_BAR; }
    }
    PG8_WAIT_V(0);
    if constexpr (!ALIGN_EPI) { if (wr == 0) PG8_BAR; }
    PG8_BAR;
    if constexpr (Epi::AFTER_DRAIN) { E.fused(acc, cur, wr, wc, fr, fq, lds, wid, lane); S.done(cur); }
#undef PG8_SA
#undef PG8_SB
#undef PG8_STAGE
#undef PG8_LDA
#undef PG8_LDB
#undef PG8_MMA
#undef PG8_WAIT_V
#undef PG8_WAIT_L
#undef PG8_BAR
#undef PG8_SCHED
}
}
constexpr int NWAVES = 8;
constexpr int BATCH = 16, SEQ = 4096, D = 1024, DEPTH = 4;
constexpr int M = BATCH * SEQ;
constexpr int DIN = 3352, PS = 3584;
constexpr int DFF = 2816, NGU = 2 * DFF;
constexpr int C_HQ = 0, C_HF = 512, C_HI = 1024, C_HG = 1536, C_NQ = 2048, C_KC = 2560, C_VC = 2688, C_KS = 2816, C_VS = 2944, C_KW = 3072, C_VW = 3200, C_GT = 3328;
constexpr float LN_EPS = 1e-5f;
constexpr float ALPHA = 1.681792830507429f;
constexpr int NCMP = 255;

#ifndef MK_N_LAUNCHES
#define MK_N_LAUNCHES 1
#endif
constexpr int N_PHASES = 1 + 8 * DEPTH;
constexpr bool ONE_LAUNCH = (MK_N_LAUNCHES == 1);

constexpr size_t MiB = 1u << 20;
constexpr size_t WS_CTL = 0, CTL_ZERO_BYTES = 1 * MiB;
constexpr size_t WS_WIN = 2 * MiB, WS_WOUT = 30 * MiB, WS_WGU = 38 * MiB, WS_WDN = 82 * MiB;
constexpr size_t WS_KCMP = 104 * MiB, WS_VCMP = 105 * MiB;
constexpr size_t WS_W1T = 106 * MiB, WS_W2T = 110 * MiB, WS_POSB = 110 * MiB + 512 * 1024;
constexpr size_t WS_XB = 112 * MiB, WS_MIX = 240 * MiB, WS_OPRE = 368 * MiB, WS_PROJ = 496 * MiB, WS_END = 944 * MiB;
constexpr int CW_TMO = 0, CW_CODE = 1, CW_BAR = 4096;

constexpr int RING_OFF = 0, RING_BYTES = 131072;
constexpr int LDSCTL_OFF = RING_BYTES, MISC_OFF = LDSCTL_OFF + 320;
constexpr int LDS_BYTES = 147456;

#define GAS __attribute__((address_space(1)))
#define LAS __attribute__((address_space(3)))
typedef unsigned short bf16;
typedef unsigned v4u __attribute__((ext_vector_type(4)));
typedef unsigned v2u __attribute__((ext_vector_type(2)));
typedef float f32x4 __attribute__((ext_vector_type(4)));
typedef GAS unsigned gu32;
#define RLX_AGENT __ATOMIC_RELAXED, __HIP_MEMORY_SCOPE_AGENT
#define LDS_WAIT() asm volatile("s_waitcnt lgkmcnt(0)" ::: "memory")
__device__ __forceinline__ unsigned f2bf(float f) { unsigned u = __builtin_bit_cast(unsigned, f); return (u + 0x7fffu + ((u >> 16) & 1u)) >> 16; }
__device__ __forceinline__ unsigned pk2(float lo, float hi) { return f2bf(lo) | (f2bf(hi) << 16); }
__device__ __forceinline__ float bf2f(unsigned h) { return __uint_as_float(h << 16); }
__device__ __forceinline__ float bflo(unsigned w) { return __uint_as_float(w << 16); }
__device__ __forceinline__ float bfhi(unsigned w) { return __uint_as_float(w & 0xffff0000u); }
__device__ __forceinline__ float wave_sum(float v) {
#pragma unroll
    for (int o = 1; o < 64; o <<= 1) v += __shfl_xor(v, o);
    return v;
}
__device__ __forceinline__ float wave_max(float v) {
#pragma unroll
    for (int o = 1; o < 64; o <<= 1) v = fmaxf(v, __shfl_xor(v, o));
    return v;
}
__device__ __forceinline__ float sigmoidf_(float x) { return 1.0f / (1.0f + __expf(-x)); }
__device__ __forceinline__ float gelu_tanh(float x) { const float u = 0.7978845608028654f * (x + 0.044715f * x * x * x); return 0.5f * x * (1.0f + tanhf(u)); }

#define XB_TMO      128
#define XB_XCNT(j)  (256  + 64 * (j))
#define XB_XSUB(j)  (1280 + 64 * (j))
#define XB_XGEN(j)  (2304 + 64 * (j))
#define XB_TOP      3328
#define XB_TOPGEN   3392
#define XCD_BAR_WORDS 3456
#define XB_SPIN_CAP (1u << 18)

__device__ __forceinline__ unsigned xb_ld(unsigned* p)              { return __hip_atomic_load(p, __ATOMIC_RELAXED, __HIP_MEMORY_SCOPE_AGENT); }
__device__ __forceinline__ unsigned xb_add(unsigned* p, unsigned v) { return __hip_atomic_fetch_add(p, v, __ATOMIC_RELAXED, __HIP_MEMORY_SCOPE_AGENT); }
__device__ __forceinline__ unsigned xb_xcc_id() { return (unsigned)__builtin_amdgcn_s_getreg((3 << 11) | 20) & 0xFu; }
#define XB_SPIN(cond, bar) do { unsigned _sp = 0; while (cond) { __builtin_amdgcn_s_sleep(1); \
    if ((++_sp & 255u) == 0u) { if (xb_ld(&(bar)[XB_TMO])) break; if (_sp > XB_SPIN_CAP) { atomicAdd(&(bar)[XB_TMO], 1u); break; } } } } while (0)

struct XcdBarrier {
    unsigned* bar; unsigned x;
    volatile LAS unsigned* st;
};

__device__ __forceinline__ XcdBarrier xcd_barrier_post(unsigned* bar, volatile LAS unsigned* st) {
    XcdBarrier b; b.bar = bar; b.x = xb_xcc_id(); b.st = st;
    if (threadIdx.x == 0) (void)xb_add(&bar[XB_XCNT(b.x)], 1u);
    return b;
}
__device__ __forceinline__ void xcd_barrier_complete(unsigned* bar, unsigned x, unsigned& nloc, unsigned& nx) {
    const unsigned G = gridDim.x * gridDim.y * gridDim.z;
    unsigned sum, cnt, mine, sp = 0u;
    for (;;) {
        sum = 0u; cnt = 0u; mine = 0u;
#pragma unroll
        for (unsigned j = 0; j < 16; ++j) { const unsigned c = xb_ld(&bar[XB_XCNT(j)]); sum += c; cnt += (c > 0u) ? 1u : 0u; mine = (j == x) ? c : mine; }
        if (sum == G) break;
        __builtin_amdgcn_s_sleep(1);
        if ((++sp & 255u) == 0u) { if (xb_ld(&bar[XB_TMO])) break; if (sp > XB_SPIN_CAP) { atomicAdd(&bar[XB_TMO], 1u); break; } }
    }
    nloc = mine > 0u ? mine : 1u; nx = cnt > 0u ? cnt : 1u;
}

__device__ __forceinline__ void xcd_barrier(const XcdBarrier& b) {
    asm volatile("s_waitcnt vmcnt(0)" ::: "memory");
    __syncthreads();
    if (threadIdx.x == 0) {
        unsigned* bar = b.bar;
        __builtin_amdgcn_s_waitcnt(0);
        unsigned nloc = b.st[0], nx = b.st[1];
        if (nloc == 0u) { xcd_barrier_complete(bar, b.x, nloc, nx); b.st[0] = nloc; b.st[1] = nx; }
        const unsigned old = xb_add(&bar[XB_XSUB(b.x)], 1u);
        const unsigned gen = old / nloc;
        if (old + 1u == (gen + 1u) * nloc) {
            __builtin_amdgcn_fence(__ATOMIC_RELEASE, "agent");
            asm volatile("s_waitcnt vmcnt(0)" ::: "memory");
            const unsigned og = xb_add(&bar[XB_TOP], 1u);
            const unsigned tg = og / nx;
            if (og + 1u == (tg + 1u) * nx) xb_add(&bar[XB_TOPGEN], 1u);
            else XB_SPIN(xb_ld(&bar[XB_TOPGEN]) == tg, bar);
            __builtin_amdgcn_fence(__ATOMIC_ACQUIRE, "agent");
            xb_add(&bar[XB_XGEN(b.x)], 1u);
            asm volatile("s_waitcnt vmcnt(0)" ::: "memory");
        } else {
            XB_SPIN(xb_ld(&bar[XB_XGEN(b.x)]) == gen, bar);
            __builtin_amdgcn_fence(__ATOMIC_ACQUIRE, "agent");
            asm volatile("s_waitcnt vmcnt(0)" ::: "memory");
        }
    }
    __syncthreads();
}

struct Ctx {
    LAS unsigned char* lds;
    int tid, lane, wave, vcu, G;
    const float *x, *w_in, *lb_param, *norm_w, *pos_k, *w1_k, *w2_k, *pos_v, *w1_v, *w2_v, *rel_bias, *w_out, *ln1_g, *ln1_b, *w_gate, *w_up, *w_down, *ln2_g, *ln2_b;
    float* out;
    bf16 *win_t, *wout_t, *wgu_t, *wdn_t, *kcmp, *vcmp, *xb, *mix, *proj, *w1t, *w2t;
    float *opre, *posb;
};

__device__ __forceinline__ void transpose_item(const float* W, int K, int N, bf16* WT, int dst_row0, LAS float* scr, int k0, int n0, int lane) {
#pragma unroll 8
    for (int i = 0; i < 32; ++i) { const int kk = 2 * i + (lane >> 5); const int n = n0 + (lane & 31); scr[kk * 33 + (lane & 31)] = (n < N) ? W[(size_t)(k0 + kk) * N + n] : 0.f; }
    LDS_WAIT(); asm volatile("" ::: "memory");
    const int c = lane & 7;
#pragma unroll
    for (int j = 0; j < 4; ++j) { const int n = (lane >> 3) + 8 * j; const LAS float* s = scr + (8 * c) * 33 + n;
        v4u o; o.x = pk2(s[0 * 33], s[1 * 33]); o.y = pk2(s[2 * 33], s[3 * 33]); o.z = pk2(s[4 * 33], s[5 * 33]); o.w = pk2(s[6 * 33], s[7 * 33]);
        *(v4u*)(WT + (size_t)(dst_row0 + n) * K + k0 + 8 * c) = o; }
    LDS_WAIT(); asm volatile("" ::: "memory");
}
__device__ __forceinline__ void p_prologue(const Ctx& F) {
    LAS float* scr = (LAS float*)(F.lds + RING_OFF + F.wave * 16384);
    const int gw = F.vcu * NWAVES + F.wave, NGW = F.G * NWAVES;
    constexpr int I_IN = (D / 64) * (PS / 32), I_OUT = (D / 64) * (D / 32), I_G = (D / 64) * (DFF / 32), I_DN = (DFF / 64) * (D / 32);
    constexpr int PER_L = I_IN + I_OUT + 2 * I_G + I_DN;
    for (int it = gw; it < PER_L * DEPTH; it += NGW) {
        const int l = it / PER_L; int r = it % PER_L;
        if (r < I_IN) { const int nb = r % (PS / 32), kb = r / (PS / 32); transpose_item(F.w_in + (size_t)l * D * DIN, D, DIN, F.win_t + (size_t)l * PS * D, 32 * nb, scr, 64 * kb, 32 * nb, F.lane); continue; } r -= I_IN;
        if (r < I_OUT) { const int nb = r % (D / 32), kb = r / (D / 32); transpose_item(F.w_out + (size_t)l * D * D, D, D, F.wout_t + (size_t)l * D * D, 32 * nb, scr, 64 * kb, 32 * nb, F.lane); continue; } r -= I_OUT;
        if (r < 2 * I_G) { const int up = r >= I_G; if (up) r -= I_G; const int nb = r % (DFF / 32), kb = r / (DFF / 32); const int n0 = 32 * nb;
            transpose_item((up ? F.w_up : F.w_gate) + (size_t)l * D * DFF, D, DFF, F.wgu_t + (size_t)l * NGU * D, (n0 / 128) * 256 + (up ? 128 : 0) + (n0 % 128), scr, 64 * kb, n0, F.lane); continue; } r -= 2 * I_G;
        { const int nb = r % (D / 32), kb = r / (D / 32); transpose_item(F.w_down + (size_t)l * DFF * D, DFF, D, F.wdn_t + (size_t)l * D * DFF, 32 * nb, scr, 64 * kb, 32 * nb, F.lane); }
    }
    for (int it = gw; it < DEPTH * 2 * (128 + 4); it += NGW) {
        const int lk = it / 132, r = it % 132, l = lk >> 1, kv = lk & 1;
        if (r < 128) { const int nb = r & 3, kb = r >> 2; transpose_item((kv ? F.w1_v : F.w1_k) + (size_t)l * 2048 * 128, 2048, 128, F.w1t + (size_t)lk * 128 * 2048, 32 * nb, scr, 64 * kb, 32 * nb, F.lane); }
        else { const int q = r - 128, nb = q & 1, kb = q >> 1; transpose_item((kv ? F.w2_v : F.w2_k) + (size_t)l * 128 * 64, 128, 64, F.w2t + (size_t)lk * 64 * 128, 32 * nb, scr, 64 * kb, 32 * nb, F.lane); }
    }
    for (int it = gw; it < DEPTH * 2 * 2; it += NGW) {
        const int lk = it >> 1, l = lk >> 1, kv = lk & 1, j = (it & 1) * 64 + F.lane;
        const float* pos = (kv ? F.pos_v : F.pos_k) + (size_t)l * 2048; const float* W1 = (kv ? F.w1_v : F.w1_k) + (size_t)l * 2048 * 128;
        float a = 0.f;
        for (int k = 0; k < 2048; ++k) a += pos[k] * W1[(size_t)k * 128 + j];
        F.posb[lk * 128 + j] = a;
    }
    for (int m = gw; m < M; m += NGW) {
        const f32x4* xr = (const f32x4*)(F.x + (size_t)m * D) + F.lane; v2u* o8 = (v2u*)(F.xb + (size_t)m * D) + F.lane;
#pragma unroll
        for (int j = 0; j < 4; ++j) { const f32x4 v = xr[64 * j]; v2u w; w.x = pk2(v.x, v.y); w.y = pk2(v.z, v.w); o8[64 * j] = w; }
    }
}

__device__ __forceinline__ void p_layernorm(const Ctx& F, const float* gam, const float* bet) {
    const int gw = F.vcu * NWAVES + F.wave, NGW = F.G * NWAVES;
    f32x4 gv[4], bv[4];
#pragma unroll
    for (int j = 0; j < 4; ++j) { gv[j] = ((const f32x4*)gam)[F.lane + 64 * j]; bv[j] = ((const f32x4*)bet)[F.lane + 64 * j]; }
    for (int m = gw; m < M; m += NGW) {
        f32x4* xr = (f32x4*)(F.out + (size_t)m * D) + F.lane; v2u* o8 = (v2u*)(F.xb + (size_t)m * D) + F.lane;
        f32x4 v[4]; float s = 0.f;
#pragma unroll
        for (int j = 0; j < 4; ++j) { v[j] = xr[64 * j]; s += (v[j].x + v[j].y) + (v[j].z + v[j].w); }
        const float mean = wave_sum(s) * (1.f / D); float s2 = 0.f;
#pragma unroll
        for (int j = 0; j < 4; ++j) { v[j] = v[j] - mean; s2 += (v[j].x * v[j].x + v[j].y * v[j].y) + (v[j].z * v[j].z + v[j].w * v[j].w); }
        const float rstd = 1.f / sqrtf(wave_sum(s2) * (1.f / D) + LN_EPS);
#pragma unroll
        for (int j = 0; j < 4; ++j) { const f32x4 o = v[j] * rstd * gv[j] + bv[j]; xr[64 * j] = o; v2u w; w.x = pk2(o.x, o.y); w.y = pk2(o.z, o.w); o8[64 * j] = w; }
    }
}

__device__ __forceinline__ void hgrn_scan_unit(const Ctx& F, int l, int u) {
    constexpr int TT = 16;
    const int b = u >> 4, h = (u >> 2) & 3, dvs = u & 3;
    LAS float* qs = (LAS float*)(F.lds + RING_OFF);
    LAS float* fs = qs + TT * 128;
    LAS float* vs = fs + TT * 128;
    LAS float* part = vs + TT * 32;
    LAS float* lbs = part + TT * 16 * 32;
    const int tid = F.tid, dv = tid & 31, kg = tid >> 5;
    if (tid < 128) {
        const int c = h * 128 + tid; float p[DEPTH], mx = -1e30f;
#pragma unroll
        for (int i = 0; i < DEPTH; ++i) { p[i] = F.lb_param[i * 512 + c]; mx = fmaxf(mx, p[i]); }
        float sum = 0.f, acc = 0.f;
#pragma unroll
        for (int i = 0; i < DEPTH; ++i) { p[i] = expf(p[i] - mx); sum += p[i]; }
#pragma unroll
        for (int i = 1; i < DEPTH; ++i) { if (i <= l) acc += p[i]; }
        lbs[tid] = acc / sum;
    }
    __syncthreads();
    float S[8];
#pragma unroll
    for (int j = 0; j < 8; ++j) S[j] = 0.f;
    const bf16* P = F.proj + (size_t)b * SEQ * PS;
    const int lr = tid >> 5, lc = tid & 31;
    for (int t0 = 0; t0 < SEQ; t0 += TT) {
        {   const bf16* row = P + (size_t)(t0 + lr) * PS;
            const v2u qw = *(const v2u*)(row + C_HQ + h * 128 + lc * 4), fw = *(const v2u*)(row + C_HF + h * 128 + lc * 4);
            f32x4 qv = {bflo(qw.x), bfhi(qw.x), bflo(qw.y), bfhi(qw.y)}, zv = {bflo(fw.x), bfhi(fw.x), bflo(fw.y), bfhi(fw.y)};
            const f32x4 lbv = *(LAS f32x4*)(lbs + lc * 4); f32x4 fv;
            fv.x = lbv.x + (1.f - lbv.x) * sigmoidf_(zv.x); fv.y = lbv.y + (1.f - lbv.y) * sigmoidf_(zv.y); fv.z = lbv.z + (1.f - lbv.z) * sigmoidf_(zv.z); fv.w = lbv.w + (1.f - lbv.w) * sigmoidf_(zv.w);
            *(LAS f32x4*)(qs + lr * 128 + lc * 4) = qv; *(LAS f32x4*)(fs + lr * 128 + lc * 4) = fv;
            vs[lr * 32 + lc] = bf2f(row[C_HI + h * 128 + dvs * 32 + lc]);
        }
        __syncthreads();
#pragma unroll 4
        for (int tt = 0; tt < TT; ++tt) {
            const float v = vs[tt * 32 + dv];
            const f32x4 f0 = *(LAS f32x4*)(fs + tt * 128 + kg * 8), f1 = *(LAS f32x4*)(fs + tt * 128 + kg * 8 + 4);
            const f32x4 q0 = *(LAS f32x4*)(qs + tt * 128 + kg * 8), q1 = *(LAS f32x4*)(qs + tt * 128 + kg * 8 + 4);
            float o = 0.f;
            S[0] = f0.x * S[0] + (1.f - f0.x) * v; o += q0.x * S[0];
            S[1] = f0.y * S[1] + (1.f - f0.y) * v; o += q0.y * S[1];
            S[2] = f0.z * S[2] + (1.f - f0.z) * v; o += q0.z * S[2];
            S[3] = f0.w * S[3] + (1.f - f0.w) * v; o += q0.w * S[3];
            S[4] = f1.x * S[4] + (1.f - f1.x) * v; o += q1.x * S[4];
            S[5] = f1.y * S[5] + (1.f - f1.y) * v; o += q1.y * S[5];
            S[6] = f1.z * S[6] + (1.f - f1.z) * v; o += q1.z * S[6];
            S[7] = f1.w * S[7] + (1.f - f1.w) * v; o += q1.w * S[7];
            part[(tt * 16 + kg) * 32 + dv] = o;
        }
        __syncthreads();
        {   const int tt = tid >> 5; float o = 0.f;
#pragma unroll
            for (int k = 0; k < 16; ++k) o += part[(tt * 16 + k) * 32 + dv];
            F.opre[(size_t)(b * SEQ + t0 + tt) * 512 + h * 128 + dvs * 32 + dv] = o;
        }
    }
    __syncthreads();
}
__device__ __forceinline__ void hgrn_finalize(const Ctx& F, int l) {
    const int gw = F.vcu * NWAVES + F.wave, NGW = F.G * NWAVES;
    const float* nw = F.norm_w + l * 128 + (F.lane & 15) * 8;
    float w[8];
#pragma unroll
    for (int i = 0; i < 8; ++i) w[i] = nw[i];
    for (int m = gw; m < M; m += NGW) {
        const f32x4* op = (const f32x4*)(F.opre + (size_t)m * 512 + F.lane * 8);
        const f32x4 a = op[0], c = op[1];
        float o[8] = {a.x, a.y, a.z, a.w, c.x, c.y, c.z, c.w};
        float ss = 0.f;
#pragma unroll
        for (int i = 0; i < 8; ++i) ss += o[i] * o[i];
        ss += __shfl_xor(ss, 1); ss += __shfl_xor(ss, 2); ss += __shfl_xor(ss, 4); ss += __shfl_xor(ss, 8);
        const float r = 1.0f / sqrtf(ss * (1.f / 128.f) + 1e-6f);
        const v4u gw4 = *(const v4u*)(F.proj + (size_t)m * PS + C_HG + F.lane * 8);
        const float g[8] = {bflo(gw4.x), bfhi(gw4.x), bflo(gw4.y), bfhi(gw4.y), bflo(gw4.z), bfhi(gw4.z), bflo(gw4.w), bfhi(gw4.w)};
        float y[8];
#pragma unroll
        for (int i = 0; i < 8; ++i) y[i] = o[i] * r * w[i] * (g[i] * sigmoidf_(g[i]));
        v4u ov; ov.x = pk2(y[0], y[1]); ov.y = pk2(y[2], y[3]); ov.z = pk2(y[4], y[5]); ov.w = pk2(y[6], y[7]);
        *(v4u*)(F.mix + (size_t)m * D + F.lane * 8) = ov;
    }
}

__device__ __forceinline__ void cmp_unit(const Ctx& F, int l, int cu) {
    const int b = cu >> 6, g = (cu >> 5) & 1, kv = (cu >> 4) & 1, nb = cu & 15, n0 = nb * 16;
    LAS float* X = (LAS float*)(F.lds + RING_OFF);
    LAS float* posl = X + 272 * 64;
    LAS float* hid = posl + 32 * 64;
    const int tid = F.tid;
    const bf16* P = F.proj + (size_t)b * SEQ * PS + (kv ? C_VC : C_KC) + g * 64;
    const float* pos = (kv ? F.pos_v : F.pos_k) + (size_t)l * 32 * 64;
    const float* W1 = (kv ? F.w1_v : F.w1_k) + (size_t)l * 2048 * 128;
    const float* W2 = (kv ? F.w2_v : F.w2_k) + (size_t)l * 128 * 64;
    for (int i = tid; i < 272 * 16; i += 512) { const int r = i >> 4, c4 = (i & 15) * 4, t = n0 * 16 + r;
        f32x4 v = {0.f, 0.f, 0.f, 0.f};
        if (t < SEQ) { const v2u w = *(const v2u*)(P + (size_t)t * PS + c4); v = (f32x4){bflo(w.x), bfhi(w.x), bflo(w.y), bfhi(w.y)}; }
        *(LAS f32x4*)(X + r * 64 + c4) = v; }
    for (int i = tid; i < 32 * 64; i += 512) posl[i] = pos[i];
    __syncthreads();
    const int j = tid & 127, nq = tid >> 7;
    float acc[4] = {0.f, 0.f, 0.f, 0.f}, pacc = 0.f;
    for (int p = 0; p < 32; ++p) {
#pragma unroll 2
        for (int d = 0; d < 64; d += 4) {
            const float* wp = W1 + (size_t)(p * 64 + d) * 128 + j;
            const float w0 = wp[0], w1 = wp[128], w2 = wp[256], w3 = wp[384];
            const f32x4 pv = *(LAS f32x4*)(posl + p * 64 + d);
            pacc += pv.x * w0 + pv.y * w1 + pv.z * w2 + pv.w * w3;
#pragma unroll
            for (int i = 0; i < 4; ++i) { const f32x4 xv = *(LAS f32x4*)(X + ((nq * 4 + i) * 16 + p) * 64 + d); acc[i] += xv.x * w0 + xv.y * w1 + xv.z * w2 + xv.w * w3; }
        }
    }
#pragma unroll
    for (int i = 0; i < 4; ++i) hid[(nq * 4 + i) * 128 + j] = gelu_tanh(acc[i] + pacc);
    __syncthreads();
    bf16* O = (kv ? F.vcmp : F.kcmp) + (size_t)(b * 2 + g) * 256 * 64;
    const int c = tid & 63;
#pragma unroll
    for (int r = 0; r < 2; ++r) { const int nl = (tid >> 6) + 8 * r; float o = 0.f;
        for (int jj = 0; jj < 128; ++jj) o += hid[nl * 128 + jj] * W2[jj * 64 + c];
        const int n = n0 + nl; O[(size_t)n * 64 + c] = (bf16)((n < NCMP) ? f2bf(o) : 0u); }
    __syncthreads();
}

__device__ __forceinline__ int t5_bucket(int n) {
    if (n < 16) return n;
    int b = 16;
    b += (n >= 19); b += (n >= 21); b += (n >= 24); b += (n >= 27); b += (n >= 31); b += (n >= 35); b += (n >= 40); b += (n >= 46);
    b += (n >= 52); b += (n >= 59); b += (n >= 67); b += (n >= 77); b += (n >= 87); b += (n >= 99); b += (n >= 113);
    return b;
}
__device__ __forceinline__ void build_bias_table(const Ctx& F, LAS float* tab) {
    for (int i = F.tid; i < 8 * 129; i += NWAVES * 64) { const int h = i / 129, n = i % 129; tab[h * 132 + n] = F.rel_bias[t5_bucket(n) * 8 + h]; }
}
__device__ __forceinline__ void dot4(const bf16* krow, const LAS float* qf, float (&s)[4]) {
    s[0] = s[1] = s[2] = s[3] = 0.f;
#pragma unroll 2
    for (int i = 0; i < 8; ++i) {
        asm volatile("" ::: "memory");
        const v4u kv = *(const v4u*)(krow + 8 * i);
        const float k0 = bflo(kv.x), k1 = bfhi(kv.x), k2 = bflo(kv.y), k3 = bfhi(kv.y), k4 = bflo(kv.z), k5 = bfhi(kv.z), k6 = bflo(kv.w), k7 = bfhi(kv.w);
#pragma unroll
        for (int h = 0; h < 4; ++h) { const f32x4 qa = *(const LAS f32x4*)(qf + h * 64 + 8 * i), qb = *(const LAS f32x4*)(qf + h * 64 + 8 * i + 4);
            s[h] += k0 * qa.x + k1 * qa.y + k2 * qa.z + k3 * qa.w + k4 * qb.x + k5 * qb.y + k6 * qb.z + k7 * qb.w; }
    }
}
template <int MODE>
__device__ __forceinline__ void nsa_branch(const bf16* Kb, const bf16* Vb, int pitch, int nblk, unsigned long long sel, int t, int lim,
                                           const LAS float* qf, const LAS float* tab, LAS float* pe, int lane, float (&o)[4]) {
    float mx[4], lp[4];
#pragma unroll
    for (int h = 0; h < 4; ++h) { mx[h] = -INFINITY; lp[h] = 0.f; o[h] = 0.f; }
#pragma unroll 1
    for (int c = (MODE == 2 && t < 511) ? ((511 - t) >> 6) : 0; c < nblk; ++c) {
        int row0;
        if (MODE == 0) row0 = 64 * c; else if (MODE == 1) { row0 = 64 * (int)__builtin_ctzll(sel); sel &= sel - 1; } else row0 = t - 511 + 64 * c;
        const int key = row0 + lane; bool valid; int dist;
        if (MODE == 0) { valid = key < lim; dist = t - (16 * key + 31); } else { valid = (key >= 0) && (key <= t); dist = t - key; }
        const int krow = key < 0 ? 0 : key;
        float d4[4]; dot4(Kb + (size_t)krow * pitch, qf, d4);
        const int di = dist < 0 ? 0 : (dist > 128 ? 128 : dist);
        float e[4];
#pragma unroll
        for (int h = 0; h < 4; ++h) {
            const float sv = valid ? d4[h] + tab[h * 132 + di] : -INFINITY;
            if (MODE == 0) pe[h * 256 + key] = sv;
            const float mn = fmaxf(mx[h], wave_max(sv));
            const float scl = (mx[h] == mn) ? 1.f : __expf(mx[h] - mn);
            e[h] = valid ? __expf(sv - mn) : 0.f; lp[h] = lp[h] * scl + e[h]; o[h] *= scl; mx[h] = mn;
        }
#pragma unroll 2
        for (int kk = 0; kk < 64; ++kk) {
            int row = row0 + kk; row = row < 0 ? 0 : row;
            const float v = bf2f(Vb[(size_t)row * pitch + lane]);
#pragma unroll
            for (int h = 0; h < 4; ++h) o[h] += __int_as_float(__builtin_amdgcn_readlane(__float_as_int(e[h]), kk)) * v;
        }
    }
#pragma unroll
    for (int h = 0; h < 4; ++h) { lp[h] = 1.0f / wave_sum(lp[h]); o[h] *= lp[h]; }
    if (MODE == 0) {
        LDS_WAIT(); asm volatile("" ::: "memory");
#pragma unroll
        for (int c = 0; c < 4; ++c)
#pragma unroll
            for (int h = 0; h < 4; ++h) { const int n = 64 * c + lane; const float sv = (c < nblk) ? pe[h * 256 + n] : -INFINITY; pe[h * 256 + n] = __expf(sv - mx[h]) * lp[h]; }
    }
}
__device__ __forceinline__ void nsa_attn_phase(const Ctx& F, int l) {
    LAS float* tab = (LAS float*)(F.lds + RING_OFF);
    LAS float* qf = tab + 8 * 132 + F.wave * 64 * 4;
    LAS float* pe = tab + 8 * 132 + NWAVES * 256 + F.wave * 1024;
    build_bias_table(F, tab);
    __syncthreads();
    const int gw = F.vcu * NWAVES + F.wave, NGW = F.G * NWAVES, lane = F.lane;
    for (int idx = gw; idx < M * 2; idx += NGW) {
        const int g = idx & 1, m = idx >> 1, b = m >> 12, t = m & (SEQ - 1);
        const bf16* prow = F.proj + (size_t)m * PS;
        const LAS float* tg = tab + g * 4 * 132;
#pragma unroll
        for (int h = 0; h < 4; ++h) qf[h * 64 + lane] = 0.125f * bf2f(prow[C_NQ + (g * 4 + h) * 64 + lane]);
        LDS_WAIT(); asm volatile("" ::: "memory");
        const bf16* P0 = F.proj + (size_t)b * SEQ * PS;
        float oc[4] = {0.f, 0.f, 0.f, 0.f};
        const int nv = (t >= 31) ? ((t - 31) >> 4) + 1 : 0;
        if (nv > 0) {
            nsa_branch<0>(F.kcmp + (size_t)(b * 2 + g) * 256 * 64, F.vcmp + (size_t)(b * 2 + g) * 256 * 64, 64, (nv + 63) >> 6, 0ull, t, nv, qf, tg, pe, lane, oc);
            LDS_WAIT(); asm volatile("" ::: "memory");
        }
        const int cur = t >> 6;
        float imp = 0.f;
        if (nv > 0) {
#pragma unroll
            for (int k = -1; k <= 3; ++k) { const int n = 4 * lane + k; if (n >= 0 && n < NCMP) { const float p = pe[n] + pe[256 + n] + pe[512 + n] + pe[768 + n]; imp += (k >= 0 && k <= 2) ? 2.f * p : p; } }
        }
        const bool causal = lane <= cur, forced = (lane == 0) || (lane == cur) || (lane + 1 == cur);
        const float sc = forced ? 1e9f : (causal ? imp : -1e9f);
        int cnt = 0;
        for (int i = 0; i < 64; ++i) { const float o = __int_as_float(__builtin_amdgcn_readlane(__float_as_int(sc), i)); cnt += ((o > sc) || (o == sc && i < lane)) ? 1 : 0; }
        unsigned long long sel = __ballot((cnt < 16) && causal);
        float os[4];
        nsa_branch<1>(P0 + C_KS + g * 64, P0 + C_VS + g * 64, PS, __builtin_popcountll(sel), sel, t, 0, qf, tg, nullptr, lane, os);
        float ow[4];
        nsa_branch<2>(P0 + C_KW + g * 64, P0 + C_VW + g * 64, PS, 8, 0ull, t, 0, qf, tg, nullptr, lane, ow);
#pragma unroll
        for (int h = 0; h < 4; ++h) {
            const float gc = sigmoidf_(bf2f(prow[C_GT + 0 + g * 4 + h])), gs = sigmoidf_(bf2f(prow[C_GT + 8 + g * 4 + h])), gwn = sigmoidf_(bf2f(prow[C_GT + 16 + g * 4 + h]));
            F.mix[(size_t)m * D + 512 + (g * 4 + h) * 64 + lane] = (bf16)f2bf(gc * oc[h] + gs * os[h] + gwn * ow[h]);
        }
    }
    __syncthreads();
}

namespace nsa {
typedef short bf16x8 __attribute__((ext_vector_type(8)));
typedef float f32x16 __attribute__((ext_vector_type(16)));
typedef float f32x2_t __attribute__((ext_vector_type(2)));
typedef __bf16 bf16x2_t __attribute__((ext_vector_type(2)));
__device__ __forceinline__ unsigned cvtpk(float lo, float hi) { f32x2_t v = {lo, hi}; bf16x2_t b = __builtin_convertvector(v, bf16x2_t); return __builtin_bit_cast(unsigned, b); }
#define NSA_MFMA(a, b, c) __builtin_amdgcn_mfma_f32_32x32x16_bf16((a), (b), (c), 0, 0, 0)
constexpr int KP = 144, VP = 136;
constexpr int KT_BYTES = 64 * KP, VT_BYTES = 64 * VP;
constexpr int L_K = 0, L_V = 2 * KT_BYTES, L_TAB = L_V + 2 * VT_BYTES, L_IMPM = L_TAB + 8 * 132 * 4, L_IMPC = L_IMPM + 16384, L_STASH = L_IMPM  , L_SEL = L_STASH + 65536, L_END = L_SEL + 512;
static_assert(L_END <= RING_BYTES, "NSA LDS map");
constexpr float LOG2E = 1.4426950408889634f, C1 = 0.125f * LOG2E;
__device__ __forceinline__ int crow(int reg, int h) { return (reg & 3) + 8 * (reg >> 2) + 4 * h; }

struct Stage { v4u k, v; };
__device__ __forceinline__ void st_load(Stage& s, const bf16* kb, const bf16* vb, int pitch, int row0, int tid) {
    const size_t off = (size_t)(row0 + (tid >> 3)) * pitch + (tid & 7) * 8;
    s.k = *(const v4u*)(kb + off); s.v = *(const v4u*)(vb + off);
}
__device__ __forceinline__ void st_store(const Stage& s, LAS unsigned char* kl, LAS unsigned char* vl, int tid) {
    const int key = tid >> 3, ch = tid & 7;
    *(LAS v4u*)(kl + key * KP + ch * 16) = s.k;
    LAS unsigned short* vp = (LAS unsigned short*)(vl + (ch * 8) * VP + key * 2);
    vp[0 * (VP / 2)] = (unsigned short)(s.v.x & 0xffffu); vp[1 * (VP / 2)] = (unsigned short)(s.v.x >> 16);
    vp[2 * (VP / 2)] = (unsigned short)(s.v.y & 0xffffu); vp[3 * (VP / 2)] = (unsigned short)(s.v.y >> 16);
    vp[4 * (VP / 2)] = (unsigned short)(s.v.z & 0xffffu); vp[5 * (VP / 2)] = (unsigned short)(s.v.z >> 16);
    vp[6 * (VP / 2)] = (unsigned short)(s.v.w & 0xffffu); vp[7 * (VP / 2)] = (unsigned short)(s.v.w >> 16);
}
__device__ __forceinline__ void qk(f32x16& p0, f32x16& p1, const LAS unsigned char* kl, const bf16x8 (&qf)[4], int r, int h) {
    const LAS unsigned char* a = kl + r * KP + h * 16;
    f32x16 z;
#pragma unroll
    for (int i = 0; i < 16; ++i) z[i] = 0.f;
#pragma unroll
    for (int s = 0; s < 4; ++s) {
        const bf16x8 a0 = *(const LAS bf16x8*)(a + 32 * s), a1 = *(const LAS bf16x8*)(a + 32 * KP + 32 * s);
        p0 = NSA_MFMA(a0, qf[s], s ? p0 : z); p1 = NSA_MFMA(a1, qf[s], s ? p1 : z);
    }
}
__device__ __forceinline__ void pv(f32x16 (&o)[2], const LAS unsigned char* vl, const f32x16& p0, const f32x16& p1, int r, int h) {
#pragma unroll
    for (int kt = 0; kt < 2; ++kt)
#pragma unroll
        for (int s = 0; s < 2; ++s) {
            const f32x16& p = kt ? p1 : p0;
            v4u w; w.x = cvtpk(p[8 * s], p[8 * s + 1]); w.y = cvtpk(p[8 * s + 2], p[8 * s + 3]); w.z = cvtpk(p[8 * s + 4], p[8 * s + 5]); w.w = cvtpk(p[8 * s + 6], p[8 * s + 7]);
            const bf16x8 pb = __builtin_bit_cast(bf16x8, w);
#pragma unroll
            for (int dt = 0; dt < 2; ++dt) {
                const LAS unsigned char* va = vl + (32 * dt + r) * VP + (32 * kt + 16 * s + 4 * h) * 2;
                const v2u lo = *(const LAS v2u*)va, hi = *(const LAS v2u*)(va + 16);
                v4u vv; vv.x = lo.x; vv.y = lo.y; vv.z = hi.x; vv.w = hi.y;
                o[dt] = NSA_MFMA(__builtin_bit_cast(bf16x8, vv), pb, o[dt]);
            }
            __builtin_amdgcn_sched_barrier(0);
        }
}
template <int BR, bool NEAR>
__device__ __forceinline__ void to_scores_(f32x16& p0, f32x16& p1, int tile, int t, int lim, bool lsel, const LAS float* tabh, float bfar, int h) {
#pragma unroll
    for (int kt = 0; kt < 2; ++kt)
#pragma unroll
        for (int reg = 0; reg < 16; ++reg) {
            const int kk = 64 * tile + 32 * kt + crow(reg, h);
            int dist; bool valid;
            if (BR == 0) { valid = kk < lim; dist = t - 16 * kk - 31; }
            else { dist = t - kk; valid = (BR == 1) ? (lsel && dist >= 0) : (dist >= 0 && dist < 512); }
            float bb = bfar;
            if (NEAR) { const int di = dist < 0 ? 0 : (dist > 128 ? 128 : dist); bb = tabh[di]; }
            if (kt) p1[reg] = valid ? __builtin_fmaf(p1[reg], C1, bb) : -INFINITY; else p0[reg] = valid ? __builtin_fmaf(p0[reg], C1, bb) : -INFINITY;
        }
}
template <int BR>
__device__ __forceinline__ void to_scores(f32x16& p0, f32x16& p1, int tile, int t, int lim, bool lsel, bool near, const LAS float* tabh, float bfar, int h) {
    if (near) to_scores_<BR, true>(p0, p1, tile, t, lim, lsel, tabh, bfar, h); else to_scores_<BR, false>(p0, p1, tile, t, lim, lsel, tabh, bfar, h);
}
__device__ __forceinline__ float max32(const f32x16& p0, const f32x16& p1) {
    float a = fmaxf(p0[0], p1[0]);
#pragma unroll
    for (int i = 1; i < 16; ++i) a = fmaxf(a, fmaxf(p0[i], p1[i]));
    return fmaxf(a, __shfl_xor(a, 32));
}
__device__ __forceinline__ void online(f32x16& p0, f32x16& p1, float& m, float& l, f32x16 (&o)[2], bool with_o) {
    const float tm = max32(p0, p1), mn = fmaxf(m, tm), mu = (mn == -INFINITY) ? 0.f : mn;
    const float alpha = __builtin_amdgcn_exp2f(m - mu); m = mn;
    float sum = 0.f;
#pragma unroll
    for (int i = 0; i < 16; ++i) { p0[i] = __builtin_amdgcn_exp2f(p0[i] - mu); p1[i] = __builtin_amdgcn_exp2f(p1[i] - mu); sum += p0[i] + p1[i]; }
    l = l * alpha + sum;
    if (with_o) {
#pragma unroll
        for (int i = 0; i < 16; ++i) { o[0][i] *= alpha; o[1][i] *= alpha; }
    }
}

__device__ __forceinline__ size_t row_of(int b, int qb, int w, int lane_opaque) { return (size_t)b * SEQ + 64 * qb + 8 * w + ((lane_opaque & 31) >> 2); }
#define NSA_OPAQUE_LANE(v) int v = lane; asm volatile("" : "+v"(v))
__device__ __forceinline__ void unit(const Ctx& F, int b, int g, int qb) {
    LAS unsigned char* L = F.lds + RING_OFF;
    const LAS float* tab2 = (const LAS float*)(L + L_TAB);
    LAS float* impM = (LAS float*)(L + L_IMPM); LAS float* impC = (LAS float*)(L + L_IMPC);
    LAS unsigned* selw = (LAS unsigned*)(L + L_SEL);
    const int tid = F.tid, lane = F.lane, w = F.wave, r = lane & 31, h = lane >> 5;
    const int t0 = 64 * qb, cur = qb, ql = 8 * w + (r >> 2), hp = r & 3, t = t0 + ql;
    const LAS float* tabh = tab2 + (g * 4 + hp) * 132; const float bfar = tabh[128];
    bf16x8 qf[4];
#pragma unroll
    for (int s = 0; s < 4; ++s) qf[s] = *(const bf16x8*)(F.proj + ((size_t)b * SEQ + t) * PS + C_NQ + (g * 4 + hp) * 64 + 16 * s + 8 * h);
    __syncthreads();
    for (int i = tid; i < 8192; i += NWAVES * 64) impM[i] = 0.f;
    f32x16 out[2], o[2];
#pragma unroll
    for (int i = 0; i < 16; ++i) { out[0][i] = 0.f; out[1][i] = 0.f; }
    Stage st;
    const bf16* P0 = F.proj + (size_t)b * SEQ * PS;
    {
        const bf16* kb = F.kcmp + (size_t)(b * 2 + g) * 256 * 64; const bf16* vb = F.vcmp + (size_t)(b * 2 + g) * 256 * 64;
        const int ntc = (4 * qb + 3 + 63) >> 6, nv = (t >= 31) ? ((t - 31) >> 4) + 1 : 0;
        float m = -INFINITY, l = 0.f;
#pragma unroll 1
        for (int pass = 0; pass < 2; ++pass) {
            float mu = 0.f, linv = 0.f;
            if (pass == 1) { l += __shfl_xor(l, 32); mu = (m == -INFINITY) ? 0.f : m; linv = (l > 0.f) ? 1.0f / l : 0.f;
#pragma unroll
                for (int i = 0; i < 16; ++i) { o[0][i] = 0.f; o[1][i] = 0.f; } }
            st_load(st, kb, vb, 64, 0, tid); st_store(st, L + L_K, L + L_V, tid); __syncthreads();
#pragma unroll 1
            for (int c = 0; c < ntc; ++c) {
                const int bi = c & 1;
                if (c + 1 < ntc) st_load(st, kb, vb, 64, 64 * (c + 1), tid);
                f32x16 p0, p1; qk(p0, p1, L + L_K + bi * KT_BYTES, qf, r, h);
                const bool near = (t0 - 16 * (64 * c + 63) - 31) < 128;
                __builtin_amdgcn_sched_barrier(0);
                to_scores<0>(p0, p1, c, t, nv, true, near, tabh, bfar, h);
                __builtin_amdgcn_sched_barrier(0);
                if (pass == 0) { online(p0, p1, m, l, o, false); }
                else {
#pragma unroll
                    for (int i = 0; i < 16; ++i) { p0[i] = __builtin_amdgcn_exp2f(p0[i] - mu) * linv; p1[i] = __builtin_amdgcn_exp2f(p1[i] - mu) * linv; }
#pragma unroll
                    for (int kt = 0; kt < 2; ++kt)
#pragma unroll
                        for (int q4 = 0; q4 < 4; ++q4) {
                            const f32x16& p = kt ? p1 : p0;
                            float carry = p[4 * q4 + 3], mainv = 2.f * (p[4 * q4] + p[4 * q4 + 1] + p[4 * q4 + 2]) + carry;
                            mainv += __shfl_xor(mainv, 1); mainv += __shfl_xor(mainv, 2); carry += __shfl_xor(carry, 1); carry += __shfl_xor(carry, 2);
                            const int j = 16 * c + 8 * kt + 2 * q4 + h;
                            if (hp == 0) { impM[ql * 64 + j] = mainv; if (j + 1 < 64) impC[ql * 64 + j + 1] = carry; }
                        }
                    __builtin_amdgcn_sched_barrier(0);
                    pv(o, L + L_V + bi * VT_BYTES, p0, p1, r, h);
                }
                if (c + 1 < ntc) st_store(st, L + L_K + (bi ^ 1) * KT_BYTES, L + L_V + (bi ^ 1) * VT_BYTES, tid);
                __syncthreads();
            }
        }
        NSA_OPAQUE_LANE(lo_); const float gc = sigmoidf_(bf2f(F.proj[row_of(b, qb, w, lo_) * PS + C_GT + 0 + g * 4 + (lo_ & 3)]));
#pragma unroll
        for (int i = 0; i < 16; ++i) { out[0][i] += gc * o[0][i]; out[1][i] += gc * o[1][i]; }
    }
    if (cur >= 16) {
        int tq_ = tid; asm volatile("" : "+v"(tq_));
        const int q = tq_ >> 3, part = tq_ & 7;
        const LAS float* im = impM + q * 64; const LAS float* ic = impC + q * 64;
        float sc[8]; int cnt[8];
#pragma unroll
        for (int i = 0; i < 8; ++i) { const int j = part * 8 + i; const float v = im[j] + ic[j]; sc[i] = (j == 0 || j == cur || j + 1 == cur) ? 1e9f : (j <= cur ? v : -1e9f); cnt[i] = 0; }
#pragma unroll 4
        for (int jj = 0; jj < 64; ++jj) {
            const float v = im[jj] + ic[jj]; const float sv = (jj == 0 || jj == cur || jj + 1 == cur) ? 1e9f : (jj <= cur ? v : -1e9f);
#pragma unroll
            for (int i = 0; i < 8; ++i) cnt[i] += ((sv > sc[i]) || (sv == sc[i] && jj < part * 8 + i)) ? 1 : 0;
        }
        unsigned bits = 0;
#pragma unroll
        for (int i = 0; i < 8; ++i) bits |= ((cnt[i] < 16) && (part * 8 + i <= cur)) ? (1u << i) : 0u;
        unsigned lo = (part < 4) ? (bits << (8 * part)) : 0u, hi = (part >= 4) ? (bits << (8 * (part - 4))) : 0u;
        lo |= __shfl_xor(lo, 1); lo |= __shfl_xor(lo, 2); lo |= __shfl_xor(lo, 4); hi |= __shfl_xor(hi, 1); hi |= __shfl_xor(hi, 2); hi |= __shfl_xor(hi, 4);
        if (part == 0) { selw[2 * q] = lo; selw[2 * q + 1] = hi; }
    } else {
        if (tid < 64) { selw[2 * tid] = (1u << (cur + 1)) - 1u; selw[2 * tid + 1] = 0u; }
    }
    __syncthreads();
    const unsigned selLo = selw[2 * ql], selHi = selw[2 * ql + 1];
    LAS float* stash = (LAS float*)(L + L_STASH) + tid;
#pragma unroll
    for (int i = 0; i < 16; ++i) { stash[i * 512] = out[0][i]; stash[(16 + i) * 512] = out[1][i]; }
    unsigned long long U;
    { unsigned ulo = selw[2 * lane], uhi = selw[2 * lane + 1];
#pragma unroll
      for (int s = 1; s < 64; s <<= 1) { ulo |= __shfl_xor(ulo, s); uhi |= __shfl_xor(uhi, s); }
      U = ((unsigned long long)(unsigned)__builtin_amdgcn_readfirstlane(uhi) << 32) | (unsigned)__builtin_amdgcn_readfirstlane(ulo); }
    {
        const bf16* kb = P0 + C_KS + g * 64; const bf16* vb = P0 + C_VS + g * 64;
        float m = -INFINITY, l = 0.f;
#pragma unroll
        for (int i = 0; i < 16; ++i) { o[0][i] = 0.f; o[1][i] = 0.f; }
        unsigned long long rem = U; int j = (int)__builtin_ctzll(rem); rem &= rem - 1;
        st_load(st, kb, vb, PS, 64 * j, tid); st_store(st, L + L_K, L + L_V, tid); __syncthreads();
        int bi = 0;
#pragma unroll 1
        for (;;) {
            const bool more = rem != 0ull; int jn = 0;
            if (more) { jn = (int)__builtin_ctzll(rem); rem &= rem - 1; st_load(st, kb, vb, PS, 64 * jn, tid); }
            f32x16 p0, p1; qk(p0, p1, L + L_K + bi * KT_BYTES, qf, r, h);
            const bool lsel = ((j < 32 ? (selLo >> j) : (selHi >> (j - 32))) & 1u) != 0u;
            __builtin_amdgcn_sched_barrier(0);
            to_scores<1>(p0, p1, j, t, 0, lsel, (cur - j) <= 2, tabh, bfar, h);
            __builtin_amdgcn_sched_barrier(0);
            online(p0, p1, m, l, o, true);
            __builtin_amdgcn_sched_barrier(0);
            pv(o, L + L_V + bi * VT_BYTES, p0, p1, r, h);
            if (more) st_store(st, L + L_K + (bi ^ 1) * KT_BYTES, L + L_V + (bi ^ 1) * VT_BYTES, tid);
            __syncthreads();
            if (!more) break;
            j = jn; bi ^= 1;
        }
        l += __shfl_xor(l, 32);
        NSA_OPAQUE_LANE(lo_); const float gs = sigmoidf_(bf2f(F.proj[row_of(b, qb, w, lo_) * PS + C_GT + 8 + g * 4 + (lo_ & 3)])) / l;
#pragma unroll
        for (int i = 0; i < 16; ++i) { stash[i * 512] += gs * o[0][i]; stash[(16 + i) * 512] += gs * o[1][i]; }
    }
    {
        const bf16* kb = P0 + C_KW + g * 64; const bf16* vb = P0 + C_VW + g * 64;
        float m = -INFINITY, l = 0.f;
#pragma unroll
        for (int i = 0; i < 16; ++i) { o[0][i] = 0.f; o[1][i] = 0.f; }
        const int j0 = cur >= 8 ? cur - 8 : 0;
        st_load(st, kb, vb, PS, 64 * j0, tid); st_store(st, L + L_K, L + L_V, tid); __syncthreads();
#pragma unroll 1
        for (int j = j0; j <= cur; ++j) {
            const int bi = (j - j0) & 1;
            if (j < cur) st_load(st, kb, vb, PS, 64 * (j + 1), tid);
            f32x16 p0, p1; qk(p0, p1, L + L_K + bi * KT_BYTES, qf, r, h);
            __builtin_amdgcn_sched_barrier(0);
            to_scores<2>(p0, p1, j, t, 0, true, (cur - j) <= 2, tabh, bfar, h);
            __builtin_amdgcn_sched_barrier(0);
            online(p0, p1, m, l, o, true);
            __builtin_amdgcn_sched_barrier(0);
            pv(o, L + L_V + bi * VT_BYTES, p0, p1, r, h);
            if (j < cur) st_store(st, L + L_K + (bi ^ 1) * KT_BYTES, L + L_V + (bi ^ 1) * VT_BYTES, tid);
            __syncthreads();
        }
        l += __shfl_xor(l, 32);
        NSA_OPAQUE_LANE(lo_); const float gw = sigmoidf_(bf2f(F.proj[row_of(b, qb, w, lo_) * PS + C_GT + 16 + g * 4 + (lo_ & 3)])) / l;
#pragma unroll
        for (int i = 0; i < 16; ++i) { out[0][i] = stash[i * 512] + gw * o[0][i]; out[1][i] = stash[(16 + i) * 512] + gw * o[1][i]; }
    }
    NSA_OPAQUE_LANE(lo2_);
    bf16* orow = F.mix + row_of(b, qb, w, lo2_) * D + 512 + (g * 4 + (lo2_ & 3)) * 64 + 4 * (lo2_ >> 5);
#pragma unroll
    for (int dt = 0; dt < 2; ++dt)
#pragma unroll
        for (int q4 = 0; q4 < 4; ++q4) { v2u wv; wv.x = cvtpk(out[dt][4 * q4], out[dt][4 * q4 + 1]); wv.y = cvtpk(out[dt][4 * q4 + 2], out[dt][4 * q4 + 3]); *(v2u*)(orow + 32 * dt + 8 * q4) = wv; }
}
__device__ __forceinline__ void phase(const Ctx& F) {
    LAS float* tab2 = (LAS float*)(F.lds + RING_OFF + L_TAB);
    for (int i = F.tid; i < 8 * 129; i += NWAVES * 64) { const int hh = i / 129, n = i % 129; tab2[hh * 132 + n] = F.rel_bias[t5_bucket(n) * 8 + hh] * LOG2E; }
    __syncthreads();
    const int nper = (2048 + F.G - 1) / F.G;
#pragma unroll 1
    for (int k = 0; k < nper; ++k) {
        int b, g, qb;
        if (F.G == 256) { const int a = F.vcu & 7, bg = F.vcu >> 3; qb = 63 - 8 * k - ((k & 1) ? (7 - a) : a); b = bg >> 1; g = bg & 1; }
        else { const int u = F.vcu + k * F.G; if (u >= 2048) break; b = (u & 31) >> 1; g = u & 1; qb = 63 - (u >> 5); }
        unit(F, b, g, qb);
    }
    __syncthreads();
}
#undef NSA_MFMA
#undef NSA_OPAQUE_LANE
}

namespace cmpx {
typedef short bf16x8 __attribute__((ext_vector_type(8)));
typedef float f32x16 __attribute__((ext_vector_type(16)));
#define CMP_MFMA(a, b, c) __builtin_amdgcn_mfma_f32_32x32x16_bf16((a), (b), (c), 0, 0, 0)
__device__ __forceinline__ void wave_unit(const Ctx& F, int l, int wu, int lane) {
    const int nt = wu & 7, kv = (wu >> 3) & 1, g = (wu >> 4) & 1, b = wu >> 5;
    const int r = lane & 31, h = lane >> 5, n = 32 * nt + r;
    const bf16* W1T = F.w1t + (size_t)(l * 2 + kv) * 128 * 2048 + (size_t)r * 2048 + 8 * h;
    const bf16* X = F.proj + (size_t)b * SEQ * PS + (kv ? C_VC : C_KC) + g * 64 + 8 * h;
    f32x16 acc[4];
#pragma unroll
    for (int jt = 0; jt < 4; ++jt)
#pragma unroll
        for (int i = 0; i < 16; ++i) acc[jt][i] = 0.f;
#pragma unroll 2
    for (int p = 0; p < 32; ++p) {
        int row = 16 * n + p; row = row > SEQ - 1 ? SEQ - 1 : row;
        const bf16* xr = X + (size_t)row * PS;
#pragma unroll
        for (int s4 = 0; s4 < 4; ++s4) {
            const bf16x8 xb = *(const bf16x8*)(xr + 16 * s4);
#pragma unroll
            for (int jt = 0; jt < 4; ++jt) { const bf16x8 wa = *(const bf16x8*)(W1T + (size_t)(32 * jt) * 2048 + 64 * p + 16 * s4); acc[jt] = CMP_MFMA(wa, xb, acc[jt]); }
        }
    }
    const float* pb = F.posb + (l * 2 + kv) * 128 + 4 * h;
    const bf16* W2T = F.w2t + (size_t)(l * 2 + kv) * 64 * 128 + (size_t)r * 128 + 4 * h;
    f32x16 o2[2];
#pragma unroll
    for (int i = 0; i < 16; ++i) { o2[0][i] = 0.f; o2[1][i] = 0.f; }
#pragma unroll
    for (int jt = 0; jt < 4; ++jt) {
#pragma unroll
        for (int i = 0; i < 16; ++i) acc[jt][i] = gelu_tanh(acc[jt][i] + pb[32 * jt + (i & 3) + 8 * (i >> 2)]);
#pragma unroll
        for (int s = 0; s < 2; ++s) {
            v4u w; w.x = nsa::cvtpk(acc[jt][8 * s], acc[jt][8 * s + 1]); w.y = nsa::cvtpk(acc[jt][8 * s + 2], acc[jt][8 * s + 3]); w.z = nsa::cvtpk(acc[jt][8 * s + 4], acc[jt][8 * s + 5]); w.w = nsa::cvtpk(acc[jt][8 * s + 6], acc[jt][8 * s + 7]);
            const bf16x8 hb = __builtin_bit_cast(bf16x8, w);
#pragma unroll
            for (int ct = 0; ct < 2; ++ct) {
                const bf16* wp = W2T + (size_t)(32 * ct) * 128 + 32 * jt + 16 * s;
                const v2u lo = *(const v2u*)wp, hi = *(const v2u*)(wp + 8);
                v4u vv; vv.x = lo.x; vv.y = lo.y; vv.z = hi.x; vv.w = hi.y;
                o2[ct] = CMP_MFMA(__builtin_bit_cast(bf16x8, vv), hb, o2[ct]);
            }
        }
    }
    bf16* O = (kv ? F.vcmp : F.kcmp) + ((size_t)(b * 2 + g) * 256 + n) * 64 + 4 * h;
    const bool live = n < NCMP;
#pragma unroll
    for (int ct = 0; ct < 2; ++ct)
#pragma unroll
        for (int q4 = 0; q4 < 4; ++q4) { v2u wv; wv.x = live ? nsa::cvtpk(o2[ct][4 * q4], o2[ct][4 * q4 + 1]) : 0u; wv.y = live ? nsa::cvtpk(o2[ct][4 * q4 + 2], o2[ct][4 * q4 + 3]) : 0u; *(v2u*)(O + 32 * ct + 8 * q4) = wv; }
}
__device__ __forceinline__ void phase(const Ctx& F, int l) {
    if ((F.wave & 3) == 0) {
        const int gq = F.vcu * 2 + (F.wave >> 2), nq = F.G * 2;
        for (int wu = gq; wu < 512; wu += nq) wave_unit(F, l, wu, F.lane);
    }
}
#undef CMP_MFMA
}

struct Args { const float* in[19]; float* out; unsigned char* ws; int ph_lo, ph_hi; };
__global__ void __launch_bounds__(NWAVES * 64, 2) fwd(Args args) {
    extern __shared__ __attribute__((aligned(16))) unsigned char lds[];
    Ctx F;
    F.lds = (LAS unsigned char*)lds;
    volatile LAS unsigned* MISC = (volatile LAS unsigned*)(F.lds + MISC_OFF);
    F.tid = threadIdx.x; F.lane = F.tid & 63; F.wave = __builtin_amdgcn_readfirstlane(F.tid >> 6);
    F.G = gridDim.x; { const int bx = blockIdx.x; F.vcu = (F.G % 8 == 0) ? (bx % 8) * (F.G / 8) + bx / 8 : bx; }
    unsigned char* ws = args.ws;
    gu32* ctl = (gu32*)(ws + WS_CTL);
    F.x = args.in[0]; F.w_in = args.in[1]; F.lb_param = args.in[2]; F.norm_w = args.in[3]; F.pos_k = args.in[4]; F.w1_k = args.in[5]; F.w2_k = args.in[6];
    F.pos_v = args.in[7]; F.w1_v = args.in[8]; F.w2_v = args.in[9]; F.rel_bias = args.in[10]; F.w_out = args.in[11]; F.ln1_g = args.in[12]; F.ln1_b = args.in[13];
    F.w_gate = args.in[14]; F.w_up = args.in[15]; F.w_down = args.in[16]; F.ln2_g = args.in[17]; F.ln2_b = args.in[18]; F.out = args.out;
    F.win_t = (bf16*)(ws + WS_WIN); F.wout_t = (bf16*)(ws + WS_WOUT); F.wgu_t = (bf16*)(ws + WS_WGU); F.wdn_t = (bf16*)(ws + WS_WDN);
    F.kcmp = (bf16*)(ws + WS_KCMP); F.vcmp = (bf16*)(ws + WS_VCMP); F.xb = (bf16*)(ws + WS_XB); F.mix = (bf16*)(ws + WS_MIX); F.proj = (bf16*)(ws + WS_PROJ);
    F.opre = (float*)(ws + WS_OPRE); F.w1t = (bf16*)(ws + WS_W1T); F.w2t = (bf16*)(ws + WS_W2T); F.posb = (float*)(ws + WS_POSB);
    for (int u = F.tid; u < (LDS_BYTES - LDSCTL_OFF) / 4; u += NWAVES * 64) ((LAS unsigned*)(F.lds + LDSCTL_OFF))[u] = 0u;
    __syncthreads();
    XcdBarrier bar; bar.bar = (unsigned*)(ctl + CW_BAR); bar.x = 0; bar.st = nullptr;
    if (ONE_LAUNCH) bar = xcd_barrier_post((unsigned*)(ctl + CW_BAR), MISC + 8);
    const int lo = args.ph_lo, hi = args.ph_hi;
#define IN(k) (lo <= (k) && (k) < hi)
#define FRESH() do { int t_ = threadIdx.x; asm volatile("" : "+v"(t_)); F.tid = t_; F.lane = t_ & 63; } while (0)
#define SEAM(k) do { if (IN(k) && IN((k) + 1)) { if (ONE_LAUNCH) xcd_barrier(bar); } } while (0)

    if (IN(0)) { p_prologue(F); } SEAM(0);
    for (int l = 0; l < DEPTH; ++l) {
        const int p0 = 1 + 8 * l;
        const float* xin = (l == 0) ? F.x : F.out;
        if (IN(p0 + 0)) {
            pg8::Gemm g{F.xb, F.win_t + (size_t)l * PS * D, M, PS, D}; pg8::StaticOrder S; S.init(M, PS, F.G, (int)blockIdx.x);
            pg8::EpiBf16<0> E{F.proj, PS, nullptr, 0, 0, 1.f};
            pg8::gemm_phase<pg8::EpiBf16<0>, pg8::StaticOrder, true, true>(F.lds + RING_OFF, g, S, E);
        } SEAM(p0 + 0);
        if (IN(p0 + 1)) { FRESH();
            for (int u = F.vcu; u < 256; u += F.G) hgrn_scan_unit(F, l, u);
#if defined(CMP_SCALAR)
            for (int cu = F.vcu; cu < 1024; cu += F.G) cmp_unit(F, l, cu);
#else
            cmpx::phase(F, l);
#endif
        } SEAM(p0 + 1);
        if (IN(p0 + 2)) { FRESH();
            hgrn_finalize(F, l);
#if defined(NSA_SCALAR)
            FRESH(); nsa_attn_phase(F, l);
#else
            FRESH(); nsa::phase(F);
#endif
        } SEAM(p0 + 2);
        if (IN(p0 + 3)) {
            pg8::Gemm g{F.mix, F.wout_t + (size_t)l * D * D, M, D, D}; pg8::StaticOrder S; S.init(M, D, F.G, (int)blockIdx.x);
            pg8::EpiResid E{xin, F.out, D, ALPHA};
            pg8::gemm_phase<pg8::EpiResid, pg8::StaticOrder, true, true>(F.lds + RING_OFF, g, S, E);
        } SEAM(p0 + 3);
        if (IN(p0 + 4)) { FRESH(); p_layernorm(F, F.ln1_g + l * D, F.ln1_b + l * D); } SEAM(p0 + 4);
        if (IN(p0 + 5)) {
            pg8::Gemm g{F.xb, F.wgu_t + (size_t)l * NGU * D, M, NGU, D}; pg8::StaticOrder S; S.init(M, NGU, F.G, (int)blockIdx.x);
            pg8::EpiSwiGLU E{F.proj, DFF};
            pg8::gemm_phase<pg8::EpiSwiGLU, pg8::StaticOrder, true, true>(F.lds + RING_OFF, g, S, E);
        } SEAM(p0 + 5);
        if (IN(p0 + 6)) {
            pg8::Gemm g{F.proj, F.wdn_t + (size_t)l * D * DFF, M, D, DFF}; pg8::StaticOrder S; S.init(M, D, F.G, (int)blockIdx.x);
            pg8::EpiResid E{F.out, F.out, D, ALPHA};
            pg8::gemm_phase<pg8::EpiResid, pg8::StaticOrder, true, true>(F.lds + RING_OFF, g, S, E);
        } SEAM(p0 + 6);
        if (IN(p0 + 7)) { FRESH(); p_layernorm(F, F.ln2_g + l * D, F.ln2_b + l * D); } SEAM(p0 + 7);
    }
#undef IN
#undef SEAM
}

extern "C" void kernel_launch(void* const* d_in, const int* in_sizes, int n_in, void* d_out, int out_size, void* d_ws, size_t ws_size, hipStream_t stream) {
    static int grid = 0;
    if (grid == 0) {
        if (n_in != 19 || in_sizes[0] != M * D || out_size != M * D || ws_size < WS_END) { fprintf(stderr, "kernel_launch: unexpected shapes (n_in %d, in0 %d, out %d, ws %zu); nothing launched\n", n_in, n_in > 0 ? in_sizes[0] : -1, out_size, ws_size); grid = -1; return; }
        int dev = 0, cus = 0, per_cu = 0;
        if (hipGetDevice(&dev) != hipSuccess || hipDeviceGetAttribute(&cus, hipDeviceAttributeMultiprocessorCount, dev) != hipSuccess) { grid = -1; return; }
        if (hipFuncSetAttribute((const void*)fwd, hipFuncAttributeMaxDynamicSharedMemorySize, LDS_BYTES) != hipSuccess) { fprintf(stderr, "kernel_launch: hipFuncSetAttribute failed\n"); grid = -1; return; }
        if (hipOccupancyMaxActiveBlocksPerMultiprocessor(&per_cu, (const void*)fwd, NWAVES * 64, LDS_BYTES) != hipSuccess || per_cu < 1) fprintf(stderr, "kernel_launch: note: occupancy query reports %d\n", per_cu);
        (void)hipGetLastError();
        grid = cus;
    }
    if (grid < 0) return;
    if (hipMemsetAsync((char*)d_ws + WS_CTL, 0, CTL_ZERO_BYTES, stream) != hipSuccess) return;
    Args a{};
    for (int i = 0; i < 19; ++i) a.in[i] = (const float*)d_in[i];
    a.out = (float*)d_out; a.ws = (unsigned char*)d_ws;
    if (ONE_LAUNCH) { a.ph_lo = 0; a.ph_hi = N_PHASES; hipLaunchKernelGGL(fwd, dim3(grid), dim3(NWAVES * 64), LDS_BYTES, stream, a); }
    else { for (int p = 0; p < N_PHASES; ++p) { a.ph_lo = p; a.ph_hi = p + 1; hipLaunchKernelGGL(fwd, dim3(grid), dim3(NWAVES * 64), LDS_BYTES, stream, a); } }
}
```

```cpp
#define MK_N_LAUNCHES 1
#include <hip/hip_runtime.h>
#include <cstdio>
#include <cstdint>
#include <cmath>
namespace pg8 {
#define PG8_LAS __attribute__((address_space(3)))
typedef unsigned short bf16_t;
typedef short bf16x8 __attribute__((ext_vector_type(8)));
typedef float f32x4 __attribute__((ext_vector_type(4)));
typedef unsigned u32x4 __attribute__((ext_vector_type(4)));
constexpr int BM = 256, BK = 64, HALF = 128, HTB = HALF * BK * 2  , STAGE_BYTES = 8 * HTB, NXCD = 8, WGM = 8;

__host__ __device__ __forceinline__ int lds_byte(int r, int c) { const int st = (r >> 4) * 2 + (c >> 5), rr = r & 15, cc = c & 31, ob = rr * 64 + cc * 2; return st * 1024 + (ob ^ (((ob >> 9) & 1) << 5)); }
__host__ __device__ __forceinline__ void stage_rc(int b, int& R, int& C) { const int st = b / 1024, sb = b % 1024, swz = sb ^ (((sb >> 9) & 1) << 5); R = (st >> 1) * 16 + swz / 64; C = (st & 1) * 32 + (swz % 64) / 2; }
__host__ __device__ __forceinline__ int perm32(int rho) { const int n = rho >> 4, i = rho & 15; return 8 * (i >> 2) + 4 * n + (i & 3); }

struct Unit { int pm, pn; };
struct Gemm { const bf16_t* A; const bf16_t* Bt; int M, N, K; };

struct StaticOrder {
    int nM, nN, nwg, G, c;
    __host__ __device__ void init(int M, int N, int G_, int c_) { nM = M / BM; nN = N / BM; nwg = nM * nN; G = G_; c = c_; }
    __host__ __device__ bool next(int i, Unit& u) const {
        const long L = (long)i * G + c; if (L >= nwg) return false;
        int wgid = (int)L; { const int q = nwg / NXCD, r = nwg % NXCD, xcd = wgid % NXCD, off = wgid / NXCD; wgid = (xcd < r ? xcd * (q + 1) : r * (q + 1) + (xcd - r) * q) + off; }
        const int nig = WGM * nN, gid = wgid / nig, fm = gid * WGM, gsz = (nM - fm) < WGM ? (nM - fm) : WGM;
        u.pm = fm + ((wgid % nig) % gsz); u.pn = (wgid % nig) / gsz; return true;
    }
    __device__ __forceinline__ void a_ready(const Unit&) const {}
    __device__ __forceinline__ void done(const Unit&) const {}
};

__device__ __forceinline__ unsigned cvt_pk_bf16(float lo, float hi) { unsigned r; asm volatile("v_cvt_pk_bf16_f32 %0, %1, %2" : "=v"(r) : "v"(lo), "v"(hi)); return r; }
typedef float f32x2 __attribute__((ext_vector_type(2)));
__device__ __forceinline__ f32x2 gelu_pk(f32x2 v) {
    const f32x2 av = __builtin_elementwise_abs(v), d = av * 0.2316418882f + 1.0f;
    f32x2 t; t.x = __builtin_amdgcn_rcpf(d.x); t.y = __builtin_amdgcn_rcpf(d.y);
    f32x2 q = t * 0.5307027145f + (-0.7265760135f); q = q * t + 0.7107068705f; q = q * t + (-0.142248368f); q = q * t + 0.127414796f; q = q * t;
    const f32x2 s = (v * v) * (-0.72134752044f);
    f32x2 e; e.x = __builtin_amdgcn_exp2f(s.x); e.y = __builtin_amdgcn_exp2f(s.y);
    const f32x2 m = v * (q * e), r = v - m;
    f32x2 o; o.x = v.x < 0.f ? m.x : r.x; o.y = v.y < 0.f ? m.y : r.y; return o;
}

template <int ACT  > struct EpiBf16 {
    static constexpr bool PERM = true, AFTER_DRAIN = false; static_assert(ACT == 0 || ACT == 1, "EpiBf16: ACT is 0 (none) or 1 (gelu_pk)");
    bf16_t* O; int ldc; const float* bias; int split_cols; size_t split_stride; float scale0;
    __device__ __forceinline__ void operator()(const f32x4 (&acc)[2][2][4][2], const Unit& u, int wr, int wc, int fr, int fq) const {
        const int row0 = u.pm * BM + wr * 64 + fr; int colt = u.pn * BM; bf16_t* base = O;
        float sc = 1.f; if (split_cols) { const int t = colt / split_cols; base += (size_t)t * split_stride; colt -= t * split_cols; if (t == 0) sc = scale0; }
        const int col0 = colt + wc * 32 + 8 * fq, bcol0 = u.pn * BM + wc * 32 + 8 * fq;
        f32x4 bv[2][2];
#pragma unroll
        for (int bj = 0; bj < 2; ++bj)
#pragma unroll
            for (int n = 0; n < 2; ++n) bv[bj][n] = bias ? *(const f32x4*)(bias + bcol0 + bj * HALF + 4 * n) : (f32x4){0.f, 0.f, 0.f, 0.f};
#pragma unroll
        for (int ai = 0; ai < 2; ++ai)
#pragma unroll
            for (int m = 0; m < 4; ++m) { bf16_t* rowp = base + (size_t)(row0 + ai * HALF + m * 16) * ldc + col0;
#pragma unroll
                for (int bj = 0; bj < 2; ++bj) { f32x4 v0 = acc[ai][bj][m][0] + bv[bj][0], v1 = acc[ai][bj][m][1] + bv[bj][1];
                    if (ACT == 1) { f32x2 a = gelu_pk((f32x2){v0[0], v0[1]}), b = gelu_pk((f32x2){v0[2], v0[3]}), c = gelu_pk((f32x2){v1[0], v1[1]}), d = gelu_pk((f32x2){v1[2], v1[3]});
                        v0 = (f32x4){a.x, a.y, b.x, b.y}; v1 = (f32x4){c.x, c.y, d.x, d.y}; }
                    v0 = v0 * sc; v1 = v1 * sc; u32x4 w; w.x = cvt_pk_bf16(v0[0], v0[1]); w.y = cvt_pk_bf16(v0[2], v0[3]); w.z = cvt_pk_bf16(v1[0], v1[1]); w.w = cvt_pk_bf16(v1[2], v1[3]);
                    *(u32x4*)(rowp + bj * HALF) = w; } }
    }
};

struct EpiResid {
    static constexpr bool PERM = false, AFTER_DRAIN = false;
    const float* xin; float* out; int ldc; float alpha;
    __device__ __forceinline__ void operator()(const f32x4 (&acc)[2][2][4][2], const Unit& u, int wr, int wc, int fr, int fq) const {
        const int col0 = u.pn * BM + wc * 32 + 4 * fq;
#pragma unroll
        for (int ai = 0; ai < 2; ++ai)
#pragma unroll
            for (int m = 0; m < 4; ++m) { const size_t off = (size_t)(u.pm * BM + ai * HALF + wr * 64 + m * 16 + fr) * ldc + col0;
#pragma unroll
                for (int bj = 0; bj < 2; ++bj)
#pragma unroll
                    for (int n = 0; n < 2; ++n) { const size_t p = off + bj * HALF + n * 16; const f32x4 xv = *(const f32x4*)(xin + p); *(f32x4*)(out + p) = xv * alpha + acc[ai][bj][m][n]; } }
    }
};
struct EpiSwiGLU {
    static constexpr bool PERM = true, AFTER_DRAIN = false;
    bf16_t* H; int ldh;
    __device__ __forceinline__ static float silu(float x) { return x * __builtin_amdgcn_rcpf(1.0f + __expf(-x)); }
    __device__ __forceinline__ void operator()(const f32x4 (&acc)[2][2][4][2], const Unit& u, int wr, int wc, int fr, int fq) const {
        const int row0 = u.pm * BM + wr * 64 + fr, col0 = u.pn * HALF + wc * 32 + 8 * fq;
#pragma unroll
        for (int ai = 0; ai < 2; ++ai)
#pragma unroll
            for (int m = 0; m < 4; ++m) { bf16_t* rowp = H + (size_t)(row0 + ai * HALF + m * 16) * ldh + col0;
                const f32x4 g0 = acc[ai][0][m][0], g1 = acc[ai][0][m][1], u0 = acc[ai][1][m][0], u1 = acc[ai][1][m][1];
                u32x4 w; w.x = cvt_pk_bf16(silu(g0[0]) * u0[0], silu(g0[1]) * u0[1]); w.y = cvt_pk_bf16(silu(g0[2]) * u0[2], silu(g0[3]) * u0[3]);
                w.z = cvt_pk_bf16(silu(g1[0]) * u1[0], silu(g1[1]) * u1[1]); w.w = cvt_pk_bf16(silu(g1[2]) * u1[2], silu(g1[3]) * u1[3]);
                *(u32x4*)rowp = w; }
    }
};
template <class Epi, class Sched, bool ALIGN_EPI = false, bool SP2 = false>
__device__ __forceinline__ void gemm_phase(PG8_LAS unsigned char* lds, const Gemm g, const Sched& S, const Epi& E) {
    int tid_ = threadIdx.x; asm volatile("" : "+v"(tid_));
    const int tid = tid_, wid = __builtin_amdgcn_readfirstlane(tid >> 6), lane = tid & 63, wr = wid >> 2, wc = wid & 3, fr = lane & 15, fq = lane >> 4;
    const int K = g.K, nt = K / BK;
    unsigned voffA[2], voffB[2];
#pragma unroll
    for (int i = 0; i < 2; ++i) { int R, C; stage_rc(tid * 16 + i * 8192, R, C); const int Rb = Epi::PERM ? ((R & ~31) + perm32(R & 31)) : R;
        voffA[i] = (unsigned)(R * K + C) * 2u; voffB[i] = (unsigned)(Rb * K + C) * 2u; }
    const size_t kstep = (size_t)(BK * 2);
    const size_t hstep = (size_t)HALF * K * 2;
    const size_t tstep = 2 * hstep;
    const unsigned ldsw = (unsigned)wid * 1024u;
    const int aoff = lds_byte(wr * 64 + fr, fq * 8), boff = lds_byte(wc * 32 + fr, fq * 8);
#define PG8_SA(b, h) (((b) * 2 + (h)) * HTB)
#define PG8_SB(b, h) ((4 + (b) * 2 + (h)) * HTB)
#define PG8_STAGE(bufoff, gbase, voff) do { _Pragma("unroll") for (int _i = 0; _i < 2; ++_i) \
        __builtin_amdgcn_global_load_lds((const unsigned*)((const char*)(gbase) + (voff)[_i]), (PG8_LAS unsigned*)(lds + (bufoff) + ldsw + _i * 8192), 16, 0, 0); } while (0)
#define PG8_LDA(dst, b, h) do { _Pragma("unroll") for (int m = 0; m < 4; ++m) _Pragma("unroll") for (int k = 0; k < 2; ++k) dst[m][k] = *(const PG8_LAS bf16x8*)(lds + PG8_SA(b, h) + aoff + m * 2048 + k * 1024); } while (0)
#define PG8_LDB(dst, b, h) do { _Pragma("unroll") for (int n = 0; n < 2; ++n) _Pragma("unroll") for (int k = 0; k < 2; ++k) dst[n][k] = *(const PG8_LAS bf16x8*)(lds + PG8_SB(b, h) + boff + n * 2048 + k * 1024); } while (0)
#define PG8_MMA(ai, bj, At, Bt) do { __builtin_amdgcn_s_setprio(1); _Pragma("unroll") for (int m = 0; m < 4; ++m) _Pragma("unroll") for (int n = 0; n < 2; ++n) _Pragma("unroll") for (int k = 0; k < 2; ++k) \
        acc[ai][bj][m][n] = __builtin_amdgcn_mfma_f32_16x16x32_bf16(Bt[n][k], At[m][k], acc[ai][bj][m][n], 0, 0, 0); __builtin_amdgcn_s_setprio(0); } while (0)
#define PG8_WAIT_V(n) asm volatile("s_waitcnt vmcnt(" #n ")" ::: "memory")
#define PG8_WAIT_L(n) asm volatile("s_waitcnt lgkmcnt(" #n ")" ::: "memory")
#define PG8_BAR __builtin_amdgcn_s_barrier()
#define PG8_SCHED __builtin_amdgcn_sched_barrier(0)
    Unit cur, nxt; int ui = 0;
    if (!S.next(0, cur)) return;
    f32x4 acc[2][2][4][2];
#pragma unroll
    for (int a = 0; a < 2; ++a)
#pragma unroll
        for (int b = 0; b < 2; ++b)
#pragma unroll
            for (int m = 0; m < 4; ++m)
#pragma unroll
                for (int n = 0; n < 2; ++n) acc[a][b][m][n] = (f32x4){0.f, 0.f, 0.f, 0.f};
    bf16x8 At[4][2], B0[2][2], B1[2][2];
    const char* cA = (const char*)g.A + (size_t)cur.pm * tstep; const char* cB = (const char*)g.Bt + (size_t)cur.pn * tstep;
    S.a_ready(cur);
    if constexpr (SP2) {
        PG8_STAGE(PG8_SB(0, 0), cB, voffB); PG8_STAGE(PG8_SB(0, 1), cB + hstep, voffB); PG8_STAGE(PG8_SA(0, 0), cA, voffA); PG8_STAGE(PG8_SA(0, 1), cA + hstep, voffA);
        if (wr == 1) PG8_BAR;
        PG8_WAIT_V(2); PG8_BAR;
        PG8_STAGE(PG8_SB(1, 0), cB + kstep, voffB); PG8_STAGE(PG8_SA(1, 0), cA + kstep, voffA); PG8_STAGE(PG8_SB(1, 1), cB + hstep + kstep, voffB);
        PG8_WAIT_V(6); PG8_BAR;
    } else {
        PG8_STAGE(PG8_SB(0, 0), cB, voffB); PG8_STAGE(PG8_SA(0, 0), cA, voffA); PG8_STAGE(PG8_SB(0, 1), cB + hstep, voffB); PG8_STAGE(PG8_SA(0, 1), cA + hstep, voffA);
        if (wr == 1) PG8_BAR;
        PG8_WAIT_V(4); PG8_BAR;
        PG8_STAGE(PG8_SB(1, 0), cB + kstep, voffB); PG8_STAGE(PG8_SA(1, 0), cA + kstep, voffA); PG8_STAGE(PG8_SB(1, 1), cB + hstep + kstep, voffB);
        PG8_WAIT_V(6); PG8_BAR;
    }
    for (;;) {
        const bool has_next = S.next(ui + 1, nxt);
        const char* nA = has_next ? (const char*)g.A + (size_t)nxt.pm * tstep : cA; const char* nB = has_next ? (const char*)g.Bt + (size_t)nxt.pn * tstep : cB;
        for (int t = 0; t < nt; t += 2) {
            const bool last = (t == nt - 2);
            const char* a1 = cA + (size_t)(t + 1) * kstep;
            const char* a2 = last ? nA : cA + (size_t)(t + 2) * kstep; const char* b2 = last ? nB : cB + (size_t)(t + 2) * kstep;
            const char* a3 = a2 + kstep; const char* b3 = b2 + kstep;
            if (last && has_next) S.a_ready(nxt);
            if constexpr (SP2) {
            PG8_LDB(B0, 0, 0); PG8_LDB(B1, 0, 1); PG8_SCHED; PG8_LDA(At, 0, 0); PG8_STAGE(PG8_SA(1, 1), a1 + hstep, voffA);
            PG8_WAIT_V(8); PG8_WAIT_L(0); PG8_BAR; PG8_MMA(0, 0, At, B0); PG8_MMA(0, 1, At, B1); PG8_BAR; PG8_SCHED;
            PG8_LDA(At, 0, 1); PG8_STAGE(PG8_SB(0, 0), b2, voffB); PG8_STAGE(PG8_SB(0, 1), b2 + hstep, voffB); PG8_STAGE(PG8_SA(0, 0), a2, voffA);
            PG8_WAIT_V(8); PG8_WAIT_L(0); PG8_BAR; PG8_MMA(1, 0, At, B0); PG8_MMA(1, 1, At, B1); PG8_BAR; PG8_SCHED;
            PG8_LDB(B0, 1, 0); PG8_LDB(B1, 1, 1); PG8_SCHED; PG8_LDA(At, 1, 0); PG8_STAGE(PG8_SA(0, 1), a2 + hstep, voffA);
            PG8_WAIT_V(8); PG8_WAIT_L(0); PG8_BAR; PG8_MMA(0, 0, At, B0); PG8_MMA(0, 1, At, B1); PG8_BAR; PG8_SCHED;
            PG8_LDA(At, 1, 1); PG8_STAGE(PG8_SB(1, 0), b3, voffB); PG8_STAGE(PG8_SB(1, 1), b3 + hstep, voffB); PG8_STAGE(PG8_SA(1, 0), a3, voffA);
            PG8_WAIT_V(8); PG8_WAIT_L(0); PG8_BAR; PG8_MMA(1, 0, At, B0); PG8_MMA(1, 1, At, B1); PG8_BAR; PG8_SCHED;
            } else {
            PG8_LDB(B0, 0, 0); PG8_SCHED; PG8_LDA(At, 0, 0); PG8_STAGE(PG8_SA(1, 1), a1 + hstep, voffA);
            PG8_WAIT_L(8); PG8_BAR; PG8_WAIT_L(0); PG8_MMA(0, 0, At, B0); PG8_BAR; PG8_SCHED;
            PG8_LDB(B1, 0, 1); PG8_STAGE(PG8_SB(0, 0), b2, voffB);
            PG8_BAR; PG8_WAIT_L(0); PG8_MMA(0, 1, At, B1); PG8_BAR;
            PG8_LDA(At, 0, 1); PG8_STAGE(PG8_SA(0, 0), a2, voffA);
            PG8_BAR; PG8_WAIT_L(0); PG8_MMA(1, 0, At, B0); PG8_BAR; PG8_SCHED;
            PG8_STAGE(PG8_SB(0, 1), b2 + hstep, voffB);
            PG8_WAIT_V(6); PG8_BAR; PG8_MMA(1, 1, At, B1); PG8_BAR;
            PG8_LDB(B0, 1, 0); PG8_SCHED; PG8_LDA(At, 1, 0); PG8_STAGE(PG8_SA(0, 1), a2 + hstep, voffA);
            PG8_WAIT_L(8); PG8_BAR; PG8_WAIT_L(0); PG8_MMA(0, 0, At, B0); PG8_BAR; PG8_SCHED;
            PG8_LDB(B1, 1, 1); PG8_STAGE(PG8_SB(1, 0), b3, voffB);
            PG8_BAR; PG8_WAIT_L(0); PG8_MMA(0, 1, At, B1); PG8_BAR;
            PG8_LDA(At, 1, 1); PG8_STAGE(PG8_SA(1, 0), a3, voffA);
            PG8_BAR; PG8_WAIT_L(0); PG8_MMA(1, 0, At, B0); PG8_BAR; PG8_SCHED;
            PG8_STAGE(PG8_SB(1, 1), b3 + hstep, voffB);
            PG8_WAIT_V(6); PG8_BAR; PG8_MMA(1, 1, At, B1); PG8_BAR;
            }
        }
        if constexpr (ALIGN_EPI) { if (wr == 0) PG8_BAR; }
        if constexpr (!Epi::AFTER_DRAIN) { E(acc, cur, wr, wc, fr, fq); S.done(cur); }
        if (!has_next) break;
#pragma unroll
        for (int a = 0; a < 2; ++a)
#pragma unroll
            for (int b = 0; b < 2; ++b)
#pragma unroll
                for (int m = 0; m < 4; ++m)
#pragma unroll
                    for (int n = 0; n < 2; ++n) acc[a][b][m][n] = (f32x4){0.f, 0.f, 0.f, 0.f};
        cur = nxt; cA = nA; cB = nB; ++ui;
        if constexpr (ALIGN_EPI) { if (wr == 1) PG8_BAR; }
    }
    PG8_WAIT_V(0);
    if constexpr (!ALIGN_EPI) { if (wr == 0) PG8_BAR; }
    PG8_BAR;
    if constexpr (Epi::AFTER_DRAIN) { E.fused(acc, cur, wr, wc, fr, fq, lds, wid, lane); S.done(cur); }
#undef PG8_SA
#undef PG8_SB
#undef PG8_STAGE
#undef PG8_LDA
#undef PG8_LDB
#undef PG8_MMA
#undef PG8_WAIT_V
#undef PG8_WAIT_L
#undef PG8_BAR
#undef PG8_SCHED
}
}
constexpr int NWAVES = 8;
constexpr int BATCH = 16, SEQ = 4096, D = 1024, DEPTH = 4;
constexpr int M = BATCH * SEQ;
constexpr int DIN = 3352, PS = 3584;
constexpr int DFF = 2816, NGU = 2 * DFF;
constexpr int C_HQ = 0, C_HF = 512, C_HI = 1024, C_HG = 1536, C_NQ = 2048, C_KC = 2560, C_VC = 2688, C_KS = 2816, C_VS = 2944, C_KW = 3072, C_VW = 3200, C_GT = 3328;
constexpr float LN_EPS = 1e-5f;
constexpr float ALPHA = 1.681792830507429f;
constexpr int NCMP = 255;

#ifndef MK_N_LAUNCHES
#define MK_N_LAUNCHES 1
#endif
constexpr int N_PHASES = 1 + 9 * DEPTH;
constexpr bool ONE_LAUNCH = (MK_N_LAUNCHES == 1);

constexpr size_t MiB = 1u << 20;
constexpr size_t WS_CTL = 0, CTL_ZERO_BYTES = 1 * MiB;
constexpr size_t WS_WIN = 2 * MiB, WS_WOUT = 30 * MiB, WS_WGU = 38 * MiB, WS_WDN = 82 * MiB;
constexpr size_t WS_KCMP = 104 * MiB, WS_VCMP = 105 * MiB;
constexpr size_t WS_W1T = 106 * MiB, WS_W2T = 110 * MiB, WS_POSB = 110 * MiB + 512 * 1024;
constexpr size_t WS_XB = 112 * MiB, WS_MIX = 240 * MiB, WS_OPRE = 368 * MiB, WS_PROJ = 496 * MiB, WS_END = 944 * MiB;
constexpr int CW_TMO = 0, CW_CODE = 1, CW_BAR = 4096;

constexpr int RING_OFF = 0, RING_BYTES = 131072;
constexpr int LDSCTL_OFF = RING_BYTES, MISC_OFF = LDSCTL_OFF + 320;
constexpr int LDS_BYTES = 147456;

#define GAS __attribute__((address_space(1)))
#define LAS __attribute__((address_space(3)))
typedef unsigned short bf16;
typedef unsigned v4u __attribute__((ext_vector_type(4)));
typedef unsigned v2u __attribute__((ext_vector_type(2)));
typedef float f32x4 __attribute__((ext_vector_type(4)));
typedef GAS unsigned gu32;
#define RLX_AGENT __ATOMIC_RELAXED, __HIP_MEMORY_SCOPE_AGENT
#define LDS_WAIT() asm volatile("s_waitcnt lgkmcnt(0)" ::: "memory")
__device__ __forceinline__ unsigned f2bf(float f) { unsigned u = __builtin_bit_cast(unsigned, f); return (u + 0x7fffu + ((u >> 16) & 1u)) >> 16; }
__device__ __forceinline__ unsigned pk2(float lo, float hi) { return f2bf(lo) | (f2bf(hi) << 16); }
__device__ __forceinline__ float bf2f(unsigned h) { return __uint_as_float(h << 16); }
__device__ __forceinline__ float bflo(unsigned w) { return __uint_as_float(w << 16); }
__device__ __forceinline__ float bfhi(unsigned w) { return __uint_as_float(w & 0xffff0000u); }
__device__ __forceinline__ float wave_sum(float v) {
#pragma unroll
    for (int o = 1; o < 64; o <<= 1) v += __shfl_xor(v, o);
    return v;
}
__device__ __forceinline__ float wave_max(float v) {
#pragma unroll
    for (int o = 1; o < 64; o <<= 1) v = fmaxf(v, __shfl_xor(v, o));
    return v;
}
__device__ __forceinline__ float sigmoidf_(float x) { return 1.0f / (1.0f + __expf(-x)); }
__device__ __forceinline__ float gelu_tanh(float x) { const float u = 0.7978845608028654f * (x + 0.044715f * x * x * x); return 0.5f * x * (1.0f + tanhf(u)); }

#define XB_TMO      128
#define XB_XCNT(j)  (256  + 64 * (j))
#define XB_XSUB(j)  (1280 + 64 * (j))
#define XB_XGEN(j)  (2304 + 64 * (j))
#define XB_TOP      3328
#define XB_TOPGEN   3392
#define XCD_BAR_WORDS 3456
#define XB_SPIN_CAP (1u << 18)

__device__ __forceinline__ unsigned xb_ld(unsigned* p)              { return __hip_atomic_load(p, __ATOMIC_RELAXED, __HIP_MEMORY_SCOPE_AGENT); }
__device__ __forceinline__ unsigned xb_add(unsigned* p, unsigned v) { return __hip_atomic_fetch_add(p, v, __ATOMIC_RELAXED, __HIP_MEMORY_SCOPE_AGENT); }
__device__ __forceinline__ unsigned xb_xcc_id() { return (unsigned)__builtin_amdgcn_s_getreg((3 << 11) | 20) & 0xFu; }
#define XB_SPIN(cond, bar) do { unsigned _sp = 0; while (cond) { __builtin_amdgcn_s_sleep(1); \
    if ((++_sp & 255u) == 0u) { if (xb_ld(&(bar)[XB_TMO])) break; if (_sp > XB_SPIN_CAP) { atomicAdd(&(bar)[XB_TMO], 1u); break; } } } } while (0)

struct XcdBarrier {
    unsigned* bar; unsigned x;
    volatile LAS unsigned* st;
};

__device__ __forceinline__ XcdBarrier xcd_barrier_post(unsigned* bar, volatile LAS unsigned* st) {
    XcdBarrier b; b.bar = bar; b.x = xb_xcc_id(); b.st = st;
    if (threadIdx.x == 0) (void)xb_add(&bar[XB_XCNT(b.x)], 1u);
    return b;
}
__device__ __forceinline__ void xcd_barrier_complete(unsigned* bar, unsigned x, unsigned& nloc, unsigned& nx) {
    const unsigned G = gridDim.x * gridDim.y * gridDim.z;
    unsigned sum, cnt, mine, sp = 0u;
    for (;;) {
        sum = 0u; cnt = 0u; mine = 0u;
#pragma unroll
        for (unsigned j = 0; j < 16; ++j) { const unsigned c = xb_ld(&bar[XB_XCNT(j)]); sum += c; cnt += (c > 0u) ? 1u : 0u; mine = (j == x) ? c : mine; }
        if (sum == G) break;
        __builtin_amdgcn_s_sleep(1);
        if ((++sp & 255u) == 0u) { if (xb_ld(&bar[XB_TMO])) break; if (sp > XB_SPIN_CAP) { atomicAdd(&bar[XB_TMO], 1u); break; } }
    }
    nloc = mine > 0u ? mine : 1u; nx = cnt > 0u ? cnt : 1u;
}

__device__ __forceinline__ void xcd_barrier(const XcdBarrier& b) {
    asm volatile("s_waitcnt vmcnt(0)" ::: "memory");
    __syncthreads();
    if (threadIdx.x == 0) {
        unsigned* bar = b.bar;
        __builtin_amdgcn_s_waitcnt(0);
        unsigned nloc = b.st[0], nx = b.st[1];
        if (nloc == 0u) { xcd_barrier_complete(bar, b.x, nloc, nx); b.st[0] = nloc; b.st[1] = nx; }
        const unsigned old = xb_add(&bar[XB_XSUB(b.x)], 1u);
        const unsigned gen = old / nloc;
        if (old + 1u == (gen + 1u) * nloc) {
            __builtin_amdgcn_fence(__ATOMIC_RELEASE, "agent");
            asm volatile("s_waitcnt vmcnt(0)" ::: "memory");
            const unsigned og = xb_add(&bar[XB_TOP], 1u);
            const unsigned tg = og / nx;
            if (og + 1u == (tg + 1u) * nx) xb_add(&bar[XB_TOPGEN], 1u);
            else XB_SPIN(xb_ld(&bar[XB_TOPGEN]) == tg, bar);
            __builtin_amdgcn_fence(__ATOMIC_ACQUIRE, "agent");
            xb_add(&bar[XB_XGEN(b.x)], 1u);
            asm volatile("s_waitcnt vmcnt(0)" ::: "memory");
        } else {
            XB_SPIN(xb_ld(&bar[XB_XGEN(b.x)]) == gen, bar);
            __builtin_amdgcn_fence(__ATOMIC_ACQUIRE, "agent");
            asm volatile("s_waitcnt vmcnt(0)" ::: "memory");
        }
    }
    __syncthreads();
}

struct Ctx {
    LAS unsigned char* lds;
    int tid, lane, wave, vcu, G;
    const float *x, *w_in, *lb_param, *norm_w, *pos_k, *w1_k, *w2_k, *pos_v, *w1_v, *w2_v, *rel_bias, *w_out, *ln1_g, *ln1_b, *w_gate, *w_up, *w_down, *ln2_g, *ln2_b;
    float* out;
    bf16 *win_t, *wout_t, *wgu_t, *wdn_t, *kcmp, *vcmp, *xb, *mix, *proj, *w1t, *w2t, *kvt;
    float *opre, *posb, *dlast;
};

__device__ __forceinline__ void transpose_item(const float* W, int K, int N, bf16* WT, int dst_row0, LAS float* scr, int k0, int n0, int lane) {
#pragma unroll 8
    for (int i = 0; i < 32; ++i) { const int kk = 2 * i + (lane >> 5); const int n = n0 + (lane & 31); scr[kk * 33 + (lane & 31)] = (n < N) ? W[(size_t)(k0 + kk) * N + n] : 0.f; }
    LDS_WAIT(); asm volatile("" ::: "memory");
    const int c = lane & 7;
#pragma unroll
    for (int j = 0; j < 4; ++j) { const int n = (lane >> 3) + 8 * j; const LAS float* s = scr + (8 * c) * 33 + n;
        v4u o; o.x = pk2(s[0 * 33], s[1 * 33]); o.y = pk2(s[2 * 33], s[3 * 33]); o.z = pk2(s[4 * 33], s[5 * 33]); o.w = pk2(s[6 * 33], s[7 * 33]);
        *(v4u*)(WT + (size_t)(dst_row0 + n) * K + k0 + 8 * c) = o; }
    LDS_WAIT(); asm volatile("" ::: "memory");
}
__device__ __forceinline__ void p_prologue(const Ctx& F) {
    LAS float* scr = (LAS float*)(F.lds + RING_OFF + F.wave * 16384);
    const int gw = F.vcu * NWAVES + F.wave, NGW = F.G * NWAVES;
    constexpr int I_IN = (D / 64) * (PS / 32), I_OUT = (D / 64) * (D / 32), I_G = (D / 64) * (DFF / 32), I_DN = (DFF / 64) * (D / 32);
    constexpr int PER_L = I_IN + I_OUT + 2 * I_G + I_DN;
    for (int it = gw; it < PER_L * DEPTH; it += NGW) {
        const int l = it / PER_L; int r = it % PER_L;
        if (r < I_IN) { const int nb = r % (PS / 32), kb = r / (PS / 32); transpose_item(F.w_in + (size_t)l * D * DIN, D, DIN, F.win_t + (size_t)l * PS * D, 32 * nb, scr, 64 * kb, 32 * nb, F.lane); continue; } r -= I_IN;
        if (r < I_OUT) { const int nb = r % (D / 32), kb = r / (D / 32); transpose_item(F.w_out + (size_t)l * D * D, D, D, F.wout_t + (size_t)l * D * D, 32 * nb, scr, 64 * kb, 32 * nb, F.lane); continue; } r -= I_OUT;
        if (r < 2 * I_G) { const int up = r >= I_G; if (up) r -= I_G; const int nb = r % (DFF / 32), kb = r / (DFF / 32); const int n0 = 32 * nb;
            transpose_item((up ? F.w_up : F.w_gate) + (size_t)l * D * DFF, D, DFF, F.wgu_t + (size_t)l * NGU * D, (n0 / 128) * 256 + (up ? 128 : 0) + (n0 % 128), scr, 64 * kb, n0, F.lane); continue; } r -= 2 * I_G;
        { const int nb = r % (D / 32), kb = r / (D / 32); transpose_item(F.w_down + (size_t)l * DFF * D, DFF, D, F.wdn_t + (size_t)l * D * DFF, 32 * nb, scr, 64 * kb, 32 * nb, F.lane); }
    }
    for (int it = gw; it < DEPTH * 2 * (128 + 4); it += NGW) {
        const int lk = it / 132, r = it % 132, l = lk >> 1, kv = lk & 1;
        if (r < 128) { const int nb = r & 3, kb = r >> 2; transpose_item((kv ? F.w1_v : F.w1_k) + (size_t)l * 2048 * 128, 2048, 128, F.w1t + (size_t)lk * 128 * 2048, 32 * nb, scr, 64 * kb, 32 * nb, F.lane); }
        else { const int q = r - 128, nb = q & 1, kb = q >> 1; transpose_item((kv ? F.w2_v : F.w2_k) + (size_t)l * 128 * 64, 128, 64, F.w2t + (size_t)lk * 64 * 128, 32 * nb, scr, 64 * kb, 32 * nb, F.lane); }
    }
    for (int it = gw; it < DEPTH * 2 * 2; it += NGW) {
        const int lk = it >> 1, l = lk >> 1, kv = lk & 1, j = (it & 1) * 64 + F.lane;
        const float* pos = (kv ? F.pos_v : F.pos_k) + (size_t)l * 2048; const float* W1 = (kv ? F.w1_v : F.w1_k) + (size_t)l * 2048 * 128;
        float a = 0.f;
        for (int k = 0; k < 2048; ++k) a += pos[k] * W1[(size_t)k * 128 + j];
        F.posb[lk * 128 + j] = a;
    }
    for (int m = gw; m < M; m += NGW) {
        const f32x4* xr = (const f32x4*)(F.x + (size_t)m * D) + F.lane; v2u* o8 = (v2u*)(F.xb + (size_t)m * D) + F.lane;
#pragma unroll
        for (int j = 0; j < 4; ++j) { const f32x4 v = xr[64 * j]; v2u w; w.x = pk2(v.x, v.y); w.y = pk2(v.z, v.w); o8[64 * j] = w; }
    }
}

__device__ __forceinline__ void p_layernorm(const Ctx& F, const float* gam, const float* bet) {
    const int gw = F.vcu * NWAVES + F.wave, NGW = F.G * NWAVES;
    f32x4 gv[4], bv[4];
#pragma unroll
    for (int j = 0; j < 4; ++j) { gv[j] = ((const f32x4*)gam)[F.lane + 64 * j]; bv[j] = ((const f32x4*)bet)[F.lane + 64 * j]; }
    for (int m = gw; m < M; m += NGW) {
        f32x4* xr = (f32x4*)(F.out + (size_t)m * D) + F.lane; v2u* o8 = (v2u*)(F.xb + (size_t)m * D) + F.lane;
        f32x4 v[4]; float s = 0.f;
#pragma unroll
        for (int j = 0; j < 4; ++j) { v[j] = xr[64 * j]; s += (v[j].x + v[j].y) + (v[j].z + v[j].w); }
        const float mean = wave_sum(s) * (1.f / D); float s2 = 0.f;
#pragma unroll
        for (int j = 0; j < 4; ++j) { v[j] = v[j] - mean; s2 += (v[j].x * v[j].x + v[j].y * v[j].y) + (v[j].z * v[j].z + v[j].w * v[j].w); }
        const float rstd = 1.f / sqrtf(wave_sum(s2) * (1.f / D) + LN_EPS);
#pragma unroll
        for (int j = 0; j < 4; ++j) { const f32x4 o = v[j] * rstd * gv[j] + bv[j]; xr[64 * j] = o; v2u w; w.x = pk2(o.x, o.y); w.y = pk2(o.z, o.w); o8[64 * j] = w; }
    }
}

__device__ __forceinline__ void hgrn_scan_unit(const Ctx& F, int l, int u) {
    constexpr int TT = 16;
    const int b = u >> 4, h = (u >> 2) & 3, dvs = u & 3;
    LAS float* qs = (LAS float*)(F.lds + RING_OFF);
    LAS float* fs = qs + TT * 128;
    LAS float* vs = fs + TT * 128;
    LAS float* part = vs + TT * 32;
    LAS float* lbs = part + TT * 16 * 32;
    const int tid = F.tid, dv = tid & 31, kg = tid >> 5;
    if (tid < 128) {
        const int c = h * 128 + tid; float p[DEPTH], mx = -1e30f;
#pragma unroll
        for (int i = 0; i < DEPTH; ++i) { p[i] = F.lb_param[i * 512 + c]; mx = fmaxf(mx, p[i]); }
        float sum = 0.f, acc = 0.f;
#pragma unroll
        for (int i = 0; i < DEPTH; ++i) { p[i] = expf(p[i] - mx); sum += p[i]; }
#pragma unroll
        for (int i = 1; i < DEPTH; ++i) { if (i <= l) acc += p[i]; }
        lbs[tid] = acc / sum;
    }
    __syncthreads();
    float S[8];
#pragma unroll
    for (int j = 0; j < 8; ++j) S[j] = 0.f;
    const bf16* P = F.proj + (size_t)b * SEQ * PS;
    const int lr = tid >> 5, lc = tid & 31;
    for (int t0 = 0; t0 < SEQ; t0 += TT) {
        {   const bf16* row = P + (size_t)(t0 + lr) * PS;
            const v2u qw = *(const v2u*)(row + C_HQ + h * 128 + lc * 4), fw = *(const v2u*)(row + C_HF + h * 128 + lc * 4);
            f32x4 qv = {bflo(qw.x), bfhi(qw.x), bflo(qw.y), bfhi(qw.y)}, zv = {bflo(fw.x), bfhi(fw.x), bflo(fw.y), bfhi(fw.y)};
            const f32x4 lbv = *(LAS f32x4*)(lbs + lc * 4); f32x4 fv;
            fv.x = lbv.x + (1.f - lbv.x) * sigmoidf_(zv.x); fv.y = lbv.y + (1.f - lbv.y) * sigmoidf_(zv.y); fv.z = lbv.z + (1.f - lbv.z) * sigmoidf_(zv.z); fv.w = lbv.w + (1.f - lbv.w) * sigmoidf_(zv.w);
            *(LAS f32x4*)(qs + lr * 128 + lc * 4) = qv; *(LAS f32x4*)(fs + lr * 128 + lc * 4) = fv;
            vs[lr * 32 + lc] = bf2f(row[C_HI + h * 128 + dvs * 32 + lc]);
        }
        __syncthreads();
#pragma unroll 4
        for (int tt = 0; tt < TT; ++tt) {
            const float v = vs[tt * 32 + dv];
            const f32x4 f0 = *(LAS f32x4*)(fs + tt * 128 + kg * 8), f1 = *(LAS f32x4*)(fs + tt * 128 + kg * 8 + 4);
            const f32x4 q0 = *(LAS f32x4*)(qs + tt * 128 + kg * 8), q1 = *(LAS f32x4*)(qs + tt * 128 + kg * 8 + 4);
            float o = 0.f;
            S[0] = f0.x * S[0] + (1.f - f0.x) * v; o += q0.x * S[0];
            S[1] = f0.y * S[1] + (1.f - f0.y) * v; o += q0.y * S[1];
            S[2] = f0.z * S[2] + (1.f - f0.z) * v; o += q0.z * S[2];
            S[3] = f0.w * S[3] + (1.f - f0.w) * v; o += q0.w * S[3];
            S[4] = f1.x * S[4] + (1.f - f1.x) * v; o += q1.x * S[4];
            S[5] = f1.y * S[5] + (1.f - f1.y) * v; o += q1.y * S[5];
            S[6] = f1.z * S[6] + (1.f - f1.z) * v; o += q1.z * S[6];
            S[7] = f1.w * S[7] + (1.f - f1.w) * v; o += q1.w * S[7];
            part[(tt * 16 + kg) * 32 + dv] = o;
        }
        __syncthreads();
        {   const int tt = tid >> 5; float o = 0.f;
#pragma unroll
            for (int k = 0; k < 16; ++k) o += part[(tt * 16 + k) * 32 + dv];
            F.opre[(size_t)(b * SEQ + t0 + tt) * 512 + h * 128 + dvs * 32 + dv] = o;
        }
    }
    __syncthreads();
}
__device__ __forceinline__ void hgrn_finalize(const Ctx& F, int l) {
    const int gw = F.vcu * NWAVES + F.wave, NGW = F.G * NWAVES;
    const float* nw = F.norm_w + l * 128 + (F.lane & 15) * 8;
    float w[8];
#pragma unroll
    for (int i = 0; i < 8; ++i) w[i] = nw[i];
    for (int m = gw; m < M; m += NGW) {
        const f32x4* op = (const f32x4*)(F.opre + (size_t)m * 512 + F.lane * 8);
        const f32x4 a = op[0], c = op[1];
        float o[8] = {a.x, a.y, a.z, a.w, c.x, c.y, c.z, c.w};
        float ss = 0.f;
#pragma unroll
        for (int i = 0; i < 8; ++i) ss += o[i] * o[i];
        ss += __shfl_xor(ss, 1); ss += __shfl_xor(ss, 2); ss += __shfl_xor(ss, 4); ss += __shfl_xor(ss, 8);
        const float r = 1.0f / sqrtf(ss * (1.f / 128.f) + 1e-6f);
        const v4u gw4 = *(const v4u*)(F.proj + (size_t)m * PS + C_HG + F.lane * 8);
        const float g[8] = {bflo(gw4.x), bfhi(gw4.x), bflo(gw4.y), bfhi(gw4.y), bflo(gw4.z), bfhi(gw4.z), bflo(gw4.w), bfhi(gw4.w)};
        float y[8];
#pragma unroll
        for (int i = 0; i < 8; ++i) y[i] = o[i] * r * w[i] * (g[i] * sigmoidf_(g[i]));
        v4u ov; ov.x = pk2(y[0], y[1]); ov.y = pk2(y[2], y[3]); ov.z = pk2(y[4], y[5]); ov.w = pk2(y[6], y[7]);
        *(v4u*)(F.mix + (size_t)m * D + F.lane * 8) = ov;
    }
}

__device__ __forceinline__ void cmp_unit(const Ctx& F, int l, int cu) {
    const int b = cu >> 6, g = (cu >> 5) & 1, kv = (cu >> 4) & 1, nb = cu & 15, n0 = nb * 16;
    LAS float* X = (LAS float*)(F.lds + RING_OFF);
    LAS float* posl = X + 272 * 64;
    LAS float* hid = posl + 32 * 64;
    const int tid = F.tid;
    const bf16* P = F.proj + (size_t)b * SEQ * PS + (kv ? C_VC : C_KC) + g * 64;
    const float* pos = (kv ? F.pos_v : F.pos_k) + (size_t)l * 32 * 64;
    const float* W1 = (kv ? F.w1_v : F.w1_k) + (size_t)l * 2048 * 128;
    const float* W2 = (kv ? F.w2_v : F.w2_k) + (size_t)l * 128 * 64;
    for (int i = tid; i < 272 * 16; i += 512) { const int r = i >> 4, c4 = (i & 15) * 4, t = n0 * 16 + r;
        f32x4 v = {0.f, 0.f, 0.f, 0.f};
        if (t < SEQ) { const v2u w = *(const v2u*)(P + (size_t)t * PS + c4); v = (f32x4){bflo(w.x), bfhi(w.x), bflo(w.y), bfhi(w.y)}; }
        *(LAS f32x4*)(X + r * 64 + c4) = v; }
    for (int i = tid; i < 32 * 64; i += 512) posl[i] = pos[i];
    __syncthreads();
    const int j = tid & 127, nq = tid >> 7;
    float acc[4] = {0.f, 0.f, 0.f, 0.f}, pacc = 0.f;
    for (int p = 0; p < 32; ++p) {
#pragma unroll 2
        for (int d = 0; d < 64; d += 4) {
            const float* wp = W1 + (size_t)(p * 64 + d) * 128 + j;
            const float w0 = wp[0], w1 = wp[128], w2 = wp[256], w3 = wp[384];
            const f32x4 pv = *(LAS f32x4*)(posl + p * 64 + d);
            pacc += pv.x * w0 + pv.y * w1 + pv.z * w2 + pv.w * w3;
#pragma unroll
            for (int i = 0; i < 4; ++i) { const f32x4 xv = *(LAS f32x4*)(X + ((nq * 4 + i) * 16 + p) * 64 + d); acc[i] += xv.x * w0 + xv.y * w1 + xv.z * w2 + xv.w * w3; }
        }
    }
#pragma unroll
    for (int i = 0; i < 4; ++i) hid[(nq * 4 + i) * 128 + j] = gelu_tanh(acc[i] + pacc);
    __syncthreads();
    bf16* O = (kv ? F.vcmp : F.kcmp) + (size_t)(b * 2 + g) * 256 * 64;
    const int c = tid & 63;
#pragma unroll
    for (int r = 0; r < 2; ++r) { const int nl = (tid >> 6) + 8 * r; float o = 0.f;
        for (int jj = 0; jj < 128; ++jj) o += hid[nl * 128 + jj] * W2[jj * 64 + c];
        const int n = n0 + nl; O[(size_t)n * 64 + c] = (bf16)((n < NCMP) ? f2bf(o) : 0u); }
    __syncthreads();
}

__device__ __forceinline__ int t5_bucket(int n) {
    if (n < 16) return n;
    int b = 16;
    b += (n >= 19); b += (n >= 21); b += (n >= 24); b += (n >= 27); b += (n >= 31); b += (n >= 35); b += (n >= 40); b += (n >= 46);
    b += (n >= 52); b += (n >= 59); b += (n >= 67); b += (n >= 77); b += (n >= 87); b += (n >= 99); b += (n >= 113);
    return b;
}
__device__ __forceinline__ void build_bias_table(const Ctx& F, LAS float* tab) {
    for (int i = F.tid; i < 8 * 129; i += NWAVES * 64) { const int h = i / 129, n = i % 129; tab[h * 132 + n] = F.rel_bias[t5_bucket(n) * 8 + h]; }
}
__device__ __forceinline__ void dot4(const bf16* krow, const LAS float* qf, float (&s)[4]) {
    s[0] = s[1] = s[2] = s[3] = 0.f;
#pragma unroll 2
    for (int i = 0; i < 8; ++i) {
        asm volatile("" ::: "memory");
        const v4u kv = *(const v4u*)(krow + 8 * i);
        const float k0 = bflo(kv.x), k1 = bfhi(kv.x), k2 = bflo(kv.y), k3 = bfhi(kv.y), k4 = bflo(kv.z), k5 = bfhi(kv.z), k6 = bflo(kv.w), k7 = bfhi(kv.w);
#pragma unroll
        for (int h = 0; h < 4; ++h) { const f32x4 qa = *(const LAS f32x4*)(qf + h * 64 + 8 * i), qb = *(const LAS f32x4*)(qf + h * 64 + 8 * i + 4);
            s[h] += k0 * qa.x + k1 * qa.y + k2 * qa.z + k3 * qa.w + k4 * qb.x + k5 * qb.y + k6 * qb.z + k7 * qb.w; }
    }
}
template <int MODE>
__device__ __forceinline__ void nsa_branch(const bf16* Kb, const bf16* Vb, int pitch, int nblk, unsigned long long sel, int t, int lim,
                                           const LAS float* qf, const LAS float* tab, LAS float* pe, int lane, float (&o)[4]) {
    float mx[4], lp[4];
#pragma unroll
    for (int h = 0; h < 4; ++h) { mx[h] = -INFINITY; lp[h] = 0.f; o[h] = 0.f; }
#pragma unroll 1
    for (int c = (MODE == 2 && t < 511) ? ((511 - t) >> 6) : 0; c < nblk; ++c) {
        int row0;
        if (MODE == 0) row0 = 64 * c; else if (MODE == 1) { row0 = 64 * (int)__builtin_ctzll(sel); sel &= sel - 1; } else row0 = t - 511 + 64 * c;
        const int key = row0 + lane; bool valid; int dist;
        if (MODE == 0) { valid = key < lim; dist = t - (16 * key + 31); } else { valid = (key >= 0) && (key <= t); dist = t - key; }
        const int krow = key < 0 ? 0 : key;
        float d4[4]; dot4(Kb + (size_t)krow * pitch, qf, d4);
        const int di = dist < 0 ? 0 : (dist > 128 ? 128 : dist);
        float e[4];
#pragma unroll
        for (int h = 0; h < 4; ++h) {
            const float sv = valid ? d4[h] + tab[h * 132 + di] : -INFINITY;
            if (MODE == 0) pe[h * 256 + key] = sv;
            const float mn = fmaxf(mx[h], wave_max(sv));
            const float scl = (mx[h] == mn) ? 1.f : __expf(mx[h] - mn);
            e[h] = valid ? __expf(sv - mn) : 0.f; lp[h] = lp[h] * scl + e[h]; o[h] *= scl; mx[h] = mn;
        }
#pragma unroll 2
        for (int kk = 0; kk < 64; ++kk) {
            int row = row0 + kk; row = row < 0 ? 0 : row;
            const float v = bf2f(Vb[(size_t)row * pitch + lane]);
#pragma unroll
            for (int h = 0; h < 4; ++h) o[h] += __int_as_float(__builtin_amdgcn_readlane(__float_as_int(e[h]), kk)) * v;
        }
    }
#pragma unroll
    for (int h = 0; h < 4; ++h) { lp[h] = 1.0f / wave_sum(lp[h]); o[h] *= lp[h]; }
    if (MODE == 0) {
        LDS_WAIT(); asm volatile("" ::: "memory");
#pragma unroll
        for (int c = 0; c < 4; ++c)
#pragma unroll
            for (int h = 0; h < 4; ++h) { const int n = 64 * c + lane; const float sv = (c < nblk) ? pe[h * 256 + n] : -INFINITY; pe[h * 256 + n] = __expf(sv - mx[h]) * lp[h]; }
    }
}
__device__ __forceinline__ void nsa_attn_phase(const Ctx& F, int l) {
    LAS float* tab = (LAS float*)(F.lds + RING_OFF);
    LAS float* qf = tab + 8 * 132 + F.wave * 64 * 4;
    LAS float* pe = tab + 8 * 132 + NWAVES * 256 + F.wave * 1024;
    build_bias_table(F, tab);
    __syncthreads();
    const int gw = F.vcu * NWAVES + F.wave, NGW = F.G * NWAVES, lane = F.lane;
    for (int idx = gw; idx < M * 2; idx += NGW) {
        const int g = idx & 1, m = idx >> 1, b = m >> 12, t = m & (SEQ - 1);
        const bf16* prow = F.proj + (size_t)m * PS;
        const LAS float* tg = tab + g * 4 * 132;
#pragma unroll
        for (int h = 0; h < 4; ++h) qf[h * 64 + lane] = 0.125f * bf2f(prow[C_NQ + (g * 4 + h) * 64 + lane]);
        LDS_WAIT(); asm volatile("" ::: "memory");
        const bf16* P0 = F.proj + (size_t)b * SEQ * PS;
        float oc[4] = {0.f, 0.f, 0.f, 0.f};
        const int nv = (t >= 31) ? ((t - 31) >> 4) + 1 : 0;
        if (nv > 0) {
            nsa_branch<0>(F.kcmp + (size_t)(b * 2 + g) * 256 * 64, F.vcmp + (size_t)(b * 2 + g) * 256 * 64, 64, (nv + 63) >> 6, 0ull, t, nv, qf, tg, pe, lane, oc);
            LDS_WAIT(); asm volatile("" ::: "memory");
        }
        const int cur = t >> 6;
        float imp = 0.f;
        if (nv > 0) {
#pragma unroll
            for (int k = -1; k <= 3; ++k) { const int n = 4 * lane + k; if (n >= 0 && n < NCMP) { const float p = pe[n] + pe[256 + n] + pe[512 + n] + pe[768 + n]; imp += (k >= 0 && k <= 2) ? 2.f * p : p; } }
        }
        const bool causal = lane <= cur, forced = (lane == 0) || (lane == cur) || (lane + 1 == cur);
        const float sc = forced ? 1e9f : (causal ? imp : -1e9f);
        int cnt = 0;
        for (int i = 0; i < 64; ++i) { const float o = __int_as_float(__builtin_amdgcn_readlane(__float_as_int(sc), i)); cnt += ((o > sc) || (o == sc && i < lane)) ? 1 : 0; }
        unsigned long long sel = __ballot((cnt < 16) && causal);
        float os[4];
        nsa_branch<1>(P0 + C_KS + g * 64, P0 + C_VS + g * 64, PS, __builtin_popcountll(sel), sel, t, 0, qf, tg, nullptr, lane, os);
        float ow[4];
        nsa_branch<2>(P0 + C_KW + g * 64, P0 + C_VW + g * 64, PS, 8, 0ull, t, 0, qf, tg, nullptr, lane, ow);
#pragma unroll
        for (int h = 0; h < 4; ++h) {
            const float gc = sigmoidf_(bf2f(prow[C_GT + 0 + g * 4 + h])), gs = sigmoidf_(bf2f(prow[C_GT + 8 + g * 4 + h])), gwn = sigmoidf_(bf2f(prow[C_GT + 16 + g * 4 + h]));
            F.mix[(size_t)m * D + 512 + (g * 4 + h) * 64 + lane] = (bf16)f2bf(gc * oc[h] + gs * os[h] + gwn * ow[h]);
        }
    }
    __syncthreads();
}

namespace nsa {
typedef short bf16x8 __attribute__((ext_vector_type(8)));
typedef float f32x16 __attribute__((ext_vector_type(16)));
typedef float f32x2_t __attribute__((ext_vector_type(2)));
typedef __bf16 bf16x2_t __attribute__((ext_vector_type(2)));
__device__ __forceinline__ unsigned cvtpk(float lo, float hi) { f32x2_t v = {lo, hi}; bf16x2_t b = __builtin_convertvector(v, bf16x2_t); return __builtin_bit_cast(unsigned, b); }
#define NSA_MFMA(a, b, c) __builtin_amdgcn_mfma_f32_32x32x16_bf16((a), (b), (c), 0, 0, 0)
constexpr int KP = 144, VP = 136;
constexpr int KT_BYTES = 64 * KP, VT_BYTES = 64 * VP;
constexpr int L_K = 0, L_V = 2 * KT_BYTES, L_TAB = L_V + 2 * VT_BYTES, L_IMPM = L_TAB + 8 * 132 * 4, L_IMPC = L_IMPM + 16384, L_STASH = L_IMPM  , L_SEL = L_STASH + 65536, L_END = L_SEL + 512;
static_assert(L_END <= RING_BYTES, "NSA LDS map");
constexpr float LOG2E = 1.4426950408889634f, C1 = 0.125f * LOG2E;
__device__ __forceinline__ int crow(int reg, int h) { return (reg & 3) + 8 * (reg >> 2) + 4 * h; }

struct Stage { v4u k, v; };
__device__ __forceinline__ void st_load(Stage& s, const bf16* kb, const bf16* vb, int pitch, int row0, int tid) {
    const size_t off = (size_t)(row0 + (tid >> 3)) * pitch + (tid & 7) * 8;
    s.k = *(const v4u*)(kb + off); s.v = *(const v4u*)(vb + off);
}
__device__ __forceinline__ void st_store(const Stage& s, LAS unsigned char* kl, LAS unsigned char* vl, int tid) {
    const int key = tid >> 3, ch = tid & 7;
    *(LAS v4u*)(kl + key * KP + ch * 16) = s.k;
    LAS unsigned short* vp = (LAS unsigned short*)(vl + (ch * 8) * VP + key * 2);
    vp[0 * (VP / 2)] = (unsigned short)(s.v.x & 0xffffu); vp[1 * (VP / 2)] = (unsigned short)(s.v.x >> 16);
    vp[2 * (VP / 2)] = (unsigned short)(s.v.y & 0xffffu); vp[3 * (VP / 2)] = (unsigned short)(s.v.y >> 16);
    vp[4 * (VP / 2)] = (unsigned short)(s.v.z & 0xffffu); vp[5 * (VP / 2)] = (unsigned short)(s.v.z >> 16);
    vp[6 * (VP / 2)] = (unsigned short)(s.v.w & 0xffffu); vp[7 * (VP / 2)] = (unsigned short)(s.v.w >> 16);
}
__device__ __forceinline__ void qk(f32x16& p0, f32x16& p1, const LAS unsigned char* kl, const bf16x8 (&qf)[4], int r, int h) {
    const LAS unsigned char* a = kl + r * KP + h * 16;
    f32x16 z;
#pragma unroll
    for (int i = 0; i < 16; ++i) z[i] = 0.f;
#pragma unroll
    for (int s = 0; s < 4; ++s) {
        const bf16x8 a0 = *(const LAS bf16x8*)(a + 32 * s), a1 = *(const LAS bf16x8*)(a + 32 * KP + 32 * s);
        p0 = NSA_MFMA(a0, qf[s], s ? p0 : z); p1 = NSA_MFMA(a1, qf[s], s ? p1 : z);
    }
}
__device__ __forceinline__ void pv(f32x16 (&o)[2], const LAS unsigned char* vl, const f32x16& p0, const f32x16& p1, int r, int h) {
#pragma unroll
    for (int kt = 0; kt < 2; ++kt)
#pragma unroll
        for (int s = 0; s < 2; ++s) {
            const f32x16& p = kt ? p1 : p0;
            v4u w; w.x = cvtpk(p[8 * s], p[8 * s + 1]); w.y = cvtpk(p[8 * s + 2], p[8 * s + 3]); w.z = cvtpk(p[8 * s + 4], p[8 * s + 5]); w.w = cvtpk(p[8 * s + 6], p[8 * s + 7]);
            const bf16x8 pb = __builtin_bit_cast(bf16x8, w);
#pragma unroll
            for (int dt = 0; dt < 2; ++dt) {
                const LAS unsigned char* va = vl + (32 * dt + r) * VP + (32 * kt + 16 * s + 4 * h) * 2;
                const v2u lo = *(const LAS v2u*)va, hi = *(const LAS v2u*)(va + 16);
                v4u vv; vv.x = lo.x; vv.y = lo.y; vv.z = hi.x; vv.w = hi.y;
                o[dt] = NSA_MFMA(__builtin_bit_cast(bf16x8, vv), pb, o[dt]);
            }
            __builtin_amdgcn_sched_barrier(0);
        }
}
template <int BR, bool NEAR>
__device__ __forceinline__ void to_scores_(f32x16& p0, f32x16& p1, int tile, int t, int lim, bool lsel, const LAS float* tabh, float bfar, int h) {
#pragma unroll
    for (int kt = 0; kt < 2; ++kt)
#pragma unroll
        for (int reg = 0; reg < 16; ++reg) {
            const int kk = 64 * tile + 32 * kt + crow(reg, h);
            int dist; bool valid;
            if (BR == 0) { valid = kk < lim; dist = t - 16 * kk - 31; }
            else { dist = t - kk; valid = (BR == 1) ? (lsel && dist >= 0) : (dist >= 0 && dist < 512); }
            float bb = bfar;
            if (NEAR) { const int di = dist < 0 ? 0 : (dist > 128 ? 128 : dist); bb = tabh[di]; }
            if (kt) p1[reg] = valid ? __builtin_fmaf(p1[reg], C1, bb) : -INFINITY; else p0[reg] = valid ? __builtin_fmaf(p0[reg], C1, bb) : -INFINITY;
        }
}
template <int BR>
__device__ __forceinline__ void to_scores(f32x16& p0, f32x16& p1, int tile, int t, int lim, bool lsel, bool near, const LAS float* tabh, float bfar, int h) {
    if (near) to_scores_<BR, true>(p0, p1, tile, t, lim, lsel, tabh, bfar, h); else to_scores_<BR, false>(p0, p1, tile, t, lim, lsel, tabh, bfar, h);
}
__device__ __forceinline__ float max32(const f32x16& p0, const f32x16& p1) {
    float a = fmaxf(p0[0], p1[0]);
#pragma unroll
    for (int i = 1; i < 16; ++i) a = fmaxf(a, fmaxf(p0[i], p1[i]));
    return fmaxf(a, __shfl_xor(a, 32));
}
__device__ __forceinline__ void online(f32x16& p0, f32x16& p1, float& m, float& l, f32x16 (&o)[2], bool with_o) {
    const float tm = max32(p0, p1), mn = fmaxf(m, tm), mu = (mn == -INFINITY) ? 0.f : mn;
    const float alpha = __builtin_amdgcn_exp2f(m - mu); m = mn;
    float sum = 0.f;
#pragma unroll
    for (int i = 0; i < 16; ++i) { p0[i] = __builtin_amdgcn_exp2f(p0[i] - mu); p1[i] = __builtin_amdgcn_exp2f(p1[i] - mu); sum += p0[i] + p1[i]; }
    l = l * alpha + sum;
    if (with_o) {
#pragma unroll
        for (int i = 0; i < 16; ++i) { o[0][i] *= alpha; o[1][i] *= alpha; }
    }
}

__device__ __forceinline__ size_t row_of(int b, int qb, int w, int lane_opaque) { return (size_t)b * SEQ + 64 * qb + 8 * w + ((lane_opaque & 31) >> 2); }
#define NSA_OPAQUE_LANE(v) int v = lane; asm volatile("" : "+v"(v))
__device__ __forceinline__ void unit(const Ctx& F, int b, int g, int qb) {
    LAS unsigned char* L = F.lds + RING_OFF;
    const LAS float* tab2 = (const LAS float*)(L + L_TAB);
    LAS float* impM = (LAS float*)(L + L_IMPM); LAS float* impC = (LAS float*)(L + L_IMPC);
    LAS unsigned* selw = (LAS unsigned*)(L + L_SEL);
    const int tid = F.tid, lane = F.lane, w = F.wave, r = lane & 31, h = lane >> 5;
    const int t0 = 64 * qb, cur = qb, ql = 8 * w + (r >> 2), hp = r & 3, t = t0 + ql;
    const LAS float* tabh = tab2 + (g * 4 + hp) * 132; const float bfar = tabh[128];
    bf16x8 qf[4];
#pragma unroll
    for (int s = 0; s < 4; ++s) qf[s] = *(const bf16x8*)(F.proj + ((size_t)b * SEQ + t) * PS + C_NQ + (g * 4 + hp) * 64 + 16 * s + 8 * h);
    __syncthreads();
    for (int i = tid; i < 8192; i += NWAVES * 64) impM[i] = 0.f;
    f32x16 out[2], o[2];
#pragma unroll
    for (int i = 0; i < 16; ++i) { out[0][i] = 0.f; out[1][i] = 0.f; }
    Stage st;
    const bf16* P0 = F.proj + (size_t)b * SEQ * PS;
    {
        const bf16* kb = F.kcmp + (size_t)(b * 2 + g) * 256 * 64; const bf16* vb = F.vcmp + (size_t)(b * 2 + g) * 256 * 64;
        const int ntc = (4 * qb + 3 + 63) >> 6, nv = (t >= 31) ? ((t - 31) >> 4) + 1 : 0;
        float m = -INFINITY, l = 0.f;
#pragma unroll 1
        for (int pass = 0; pass < 2; ++pass) {
            float mu = 0.f, linv = 0.f;
            if (pass == 1) { l += __shfl_xor(l, 32); mu = (m == -INFINITY) ? 0.f : m; linv = (l > 0.f) ? 1.0f / l : 0.f;
#pragma unroll
                for (int i = 0; i < 16; ++i) { o[0][i] = 0.f; o[1][i] = 0.f; } }
            st_load(st, kb, vb, 64, 0, tid); st_store(st, L + L_K, L + L_V, tid); __syncthreads();
#pragma unroll 1
            for (int c = 0; c < ntc; ++c) {
                const int bi = c & 1;
                if (c + 1 < ntc) st_load(st, kb, vb, 64, 64 * (c + 1), tid);
                f32x16 p0, p1; qk(p0, p1, L + L_K + bi * KT_BYTES, qf, r, h);
                const bool near = (t0 - 16 * (64 * c + 63) - 31) < 128;
                __builtin_amdgcn_sched_barrier(0);
                to_scores<0>(p0, p1, c, t, nv, true, near, tabh, bfar, h);
                __builtin_amdgcn_sched_barrier(0);
                if (pass == 0) { online(p0, p1, m, l, o, false); }
                else {
#pragma unroll
                    for (int i = 0; i < 16; ++i) { p0[i] = __builtin_amdgcn_exp2f(p0[i] - mu) * linv; p1[i] = __builtin_amdgcn_exp2f(p1[i] - mu) * linv; }
#pragma unroll
                    for (int kt = 0; kt < 2; ++kt)
#pragma unroll
                        for (int q4 = 0; q4 < 4; ++q4) {
                            const f32x16& p = kt ? p1 : p0;
                            float carry = p[4 * q4 + 3], mainv = 2.f * (p[4 * q4] + p[4 * q4 + 1] + p[4 * q4 + 2]) + carry;
                            mainv += __shfl_xor(mainv, 1); mainv += __shfl_xor(mainv, 2); carry += __shfl_xor(carry, 1); carry += __shfl_xor(carry, 2);
                            const int j = 16 * c + 8 * kt + 2 * q4 + h;
                            if (hp == 0) { impM[ql * 64 + j] = mainv; if (j + 1 < 64) impC[ql * 64 + j + 1] = carry; }
                        }
                    __builtin_amdgcn_sched_barrier(0);
                    pv(o, L + L_V + bi * VT_BYTES, p0, p1, r, h);
                }
                if (c + 1 < ntc) st_store(st, L + L_K + (bi ^ 1) * KT_BYTES, L + L_V + (bi ^ 1) * VT_BYTES, tid);
                __syncthreads();
            }
        }
        NSA_OPAQUE_LANE(lo_); const float gc = sigmoidf_(bf2f(F.proj[row_of(b, qb, w, lo_) * PS + C_GT + 0 + g * 4 + (lo_ & 3)]));
#pragma unroll
        for (int i = 0; i < 16; ++i) { out[0][i] += gc * o[0][i]; out[1][i] += gc * o[1][i]; }
    }
    if (cur >= 16) {
        int tq_ = tid; asm volatile("" : "+v"(tq_));
        const int q = tq_ >> 3, part = tq_ & 7;
        const LAS float* im = impM + q * 64; const LAS float* ic = impC + q * 64;
        float sc[8]; int cnt[8];
#pragma unroll
        for (int i = 0; i < 8; ++i) { const int j = part * 8 + i; const float v = im[j] + ic[j]; sc[i] = (j == 0 || j == cur || j + 1 == cur) ? 1e9f : (j <= cur ? v : -1e9f); cnt[i] = 0; }
#pragma unroll 4
        for (int jj = 0; jj < 64; ++jj) {
            const float v = im[jj] + ic[jj]; const float sv = (jj == 0 || jj == cur || jj + 1 == cur) ? 1e9f : (jj <= cur ? v : -1e9f);
#pragma unroll
            for (int i = 0; i < 8; ++i) cnt[i] += ((sv > sc[i]) || (sv == sc[i] && jj < part * 8 + i)) ? 1 : 0;
        }
        unsigned bits = 0;
#pragma unroll
        for (int i = 0; i < 8; ++i) bits |= ((cnt[i] < 16) && (part * 8 + i <= cur)) ? (1u << i) : 0u;
        unsigned lo = (part < 4) ? (bits << (8 * part)) : 0u, hi = (part >= 4) ? (bits << (8 * (part - 4))) : 0u;
        lo |= __shfl_xor(lo, 1); lo |= __shfl_xor(lo, 2); lo |= __shfl_xor(lo, 4); hi |= __shfl_xor(hi, 1); hi |= __shfl_xor(hi, 2); hi |= __shfl_xor(hi, 4);
        if (part == 0) { selw[2 * q] = lo; selw[2 * q + 1] = hi; }
    } else {
        if (tid < 64) { selw[2 * tid] = (1u << (cur + 1)) - 1u; selw[2 * tid + 1] = 0u; }
    }
    __syncthreads();
    const unsigned selLo = selw[2 * ql], selHi = selw[2 * ql + 1];
    LAS float* stash = (LAS float*)(L + L_STASH) + tid;
#pragma unroll
    for (int i = 0; i < 16; ++i) { stash[i * 512] = out[0][i]; stash[(16 + i) * 512] = out[1][i]; }
    unsigned long long U;
    { unsigned ulo = selw[2 * lane], uhi = selw[2 * lane + 1];
#pragma unroll
      for (int s = 1; s < 64; s <<= 1) { ulo |= __shfl_xor(ulo, s); uhi |= __shfl_xor(uhi, s); }
      U = ((unsigned long long)(unsigned)__builtin_amdgcn_readfirstlane(uhi) << 32) | (unsigned)__builtin_amdgcn_readfirstlane(ulo); }
    {
        const bf16* kb = P0 + C_KS + g * 64; const bf16* vb = P0 + C_VS + g * 64;
        float m = -INFINITY, l = 0.f;
#pragma unroll
        for (int i = 0; i < 16; ++i) { o[0][i] = 0.f; o[1][i] = 0.f; }
        unsigned long long rem = U; int j = (int)__builtin_ctzll(rem); rem &= rem - 1;
        st_load(st, kb, vb, PS, 64 * j, tid); st_store(st, L + L_K, L + L_V, tid); __syncthreads();
        int bi = 0;
#pragma unroll 1
        for (;;) {
            const bool more = rem != 0ull; int jn = 0;
            if (more) { jn = (int)__builtin_ctzll(rem); rem &= rem - 1; st_load(st, kb, vb, PS, 64 * jn, tid); }
            f32x16 p0, p1; qk(p0, p1, L + L_K + bi * KT_BYTES, qf, r, h);
            const bool lsel = ((j < 32 ? (selLo >> j) : (selHi >> (j - 32))) & 1u) != 0u;
            __builtin_amdgcn_sched_barrier(0);
            to_scores<1>(p0, p1, j, t, 0, lsel, (cur - j) <= 2, tabh, bfar, h);
            __builtin_amdgcn_sched_barrier(0);
            online(p0, p1, m, l, o, true);
            __builtin_amdgcn_sched_barrier(0);
            pv(o, L + L_V + bi * VT_BYTES, p0, p1, r, h);
            if (more) st_store(st, L + L_K + (bi ^ 1) * KT_BYTES, L + L_V + (bi ^ 1) * VT_BYTES, tid);
            __syncthreads();
            if (!more) break;
            j = jn; bi ^= 1;
        }
        l += __shfl_xor(l, 32);
        NSA_OPAQUE_LANE(lo_); const float gs = sigmoidf_(bf2f(F.proj[row_of(b, qb, w, lo_) * PS + C_GT + 8 + g * 4 + (lo_ & 3)])) / l;
#pragma unroll
        for (int i = 0; i < 16; ++i) { stash[i * 512] += gs * o[0][i]; stash[(16 + i) * 512] += gs * o[1][i]; }
    }
    {
        const bf16* kb = P0 + C_KW + g * 64; const bf16* vb = P0 + C_VW + g * 64;
        float m = -INFINITY, l = 0.f;
#pragma unroll
        for (int i = 0; i < 16; ++i) { o[0][i] = 0.f; o[1][i] = 0.f; }
        const int j0 = cur >= 8 ? cur - 8 : 0;
        st_load(st, kb, vb, PS, 64 * j0, tid); st_store(st, L + L_K, L + L_V, tid); __syncthreads();
#pragma unroll 1
        for (int j = j0; j <= cur; ++j) {
            const int bi = (j - j0) & 1;
            if (j < cur) st_load(st, kb, vb, PS, 64 * (j + 1), tid);
            f32x16 p0, p1; qk(p0, p1, L + L_K + bi * KT_BYTES, qf, r, h);
            __builtin_amdgcn_sched_barrier(0);
            to_scores<2>(p0, p1, j, t, 0, true, (cur - j) <= 2, tabh, bfar, h);
            __builtin_amdgcn_sched_barrier(0);
            online(p0, p1, m, l, o, true);
            __builtin_amdgcn_sched_barrier(0);
            pv(o, L + L_V + bi * VT_BYTES, p0, p1, r, h);
            if (j < cur) st_store(st, L + L_K + (bi ^ 1) * KT_BYTES, L + L_V + (bi ^ 1) * VT_BYTES, tid);
            __syncthreads();
        }
        l += __shfl_xor(l, 32);
        NSA_OPAQUE_LANE(lo_); const float gw = sigmoidf_(bf2f(F.proj[row_of(b, qb, w, lo_) * PS + C_GT + 16 + g * 4 + (lo_ & 3)])) / l;
#pragma unroll
        for (int i = 0; i < 16; ++i) { out[0][i] = stash[i * 512] + gw * o[0][i]; out[1][i] = stash[(16 + i) * 512] + gw * o[1][i]; }
    }
    NSA_OPAQUE_LANE(lo2_);
    bf16* orow = F.mix + row_of(b, qb, w, lo2_) * D + 512 + (g * 4 + (lo2_ & 3)) * 64 + 4 * (lo2_ >> 5);
#pragma unroll
    for (int dt = 0; dt < 2; ++dt)
#pragma unroll
        for (int q4 = 0; q4 < 4; ++q4) { v2u wv; wv.x = cvtpk(out[dt][4 * q4], out[dt][4 * q4 + 1]); wv.y = cvtpk(out[dt][4 * q4 + 2], out[dt][4 * q4 + 3]); *(v2u*)(orow + 32 * dt + 8 * q4) = wv; }
}
__device__ __forceinline__ void phase(const Ctx& F) {
    LAS float* tab2 = (LAS float*)(F.lds + RING_OFF + L_TAB);
    for (int i = F.tid; i < 8 * 129; i += NWAVES * 64) { const int hh = i / 129, n = i % 129; tab2[hh * 132 + n] = F.rel_bias[t5_bucket(n) * 8 + hh] * LOG2E; }
    __syncthreads();
    const int nper = (2048 + F.G - 1) / F.G;
#pragma unroll 1
    for (int k = 0; k < nper; ++k) {
        int b, g, qb;
        if (F.G == 256) { const int a = F.vcu & 7, bg = F.vcu >> 3; qb = 63 - 8 * k - ((k & 1) ? (7 - a) : a); b = bg >> 1; g = bg & 1; }
        else { const int u = F.vcu + k * F.G; if (u >= 2048) break; b = (u & 31) >> 1; g = u & 1; qb = 63 - (u >> 5); }
        unit(F, b, g, qb);
    }
    __syncthreads();
}
#undef NSA_MFMA
#undef NSA_OPAQUE_LANE
}

namespace cmpx {
typedef short bf16x8 __attribute__((ext_vector_type(8)));
typedef float f32x16 __attribute__((ext_vector_type(16)));
#define CMP_MFMA(a, b, c) __builtin_amdgcn_mfma_f32_32x32x16_bf16((a), (b), (c), 0, 0, 0)
__device__ __forceinline__ void wave_unit(const Ctx& F, int l, int wu, int lane) {
    const int nt = wu & 7, kv = (wu >> 3) & 1, g = (wu >> 4) & 1, b = wu >> 5;
    const int r = lane & 31, h = lane >> 5, n = 32 * nt + r;
    const bf16* W1T = F.w1t + (size_t)(l * 2 + kv) * 128 * 2048 + (size_t)r * 2048 + 8 * h;
    const bf16* X = F.proj + (size_t)b * SEQ * PS + (kv ? C_VC : C_KC) + g * 64 + 8 * h;
    f32x16 acc[4];
#pragma unroll
    for (int jt = 0; jt < 4; ++jt)
#pragma unroll
        for (int i = 0; i < 16; ++i) acc[jt][i] = 0.f;
#pragma unroll 2
    for (int p = 0; p < 32; ++p) {
        int row = 16 * n + p; row = row > SEQ - 1 ? SEQ - 1 : row;
        const bf16* xr = X + (size_t)row * PS;
#pragma unroll
        for (int s4 = 0; s4 < 4; ++s4) {
            const bf16x8 xb = *(const bf16x8*)(xr + 16 * s4);
#pragma unroll
            for (int jt = 0; jt < 4; ++jt) { const bf16x8 wa = *(const bf16x8*)(W1T + (size_t)(32 * jt) * 2048 + 64 * p + 16 * s4); acc[jt] = CMP_MFMA(wa, xb, acc[jt]); }
        }
    }
    const float* pb = F.posb + (l * 2 + kv) * 128 + 4 * h;
    const bf16* W2T = F.w2t + (size_t)(l * 2 + kv) * 64 * 128 + (size_t)r * 128 + 4 * h;
    f32x16 o2[2];
#pragma unroll
    for (int i = 0; i < 16; ++i) { o2[0][i] = 0.f; o2[1][i] = 0.f; }
#pragma unroll
    for (int jt = 0; jt < 4; ++jt) {
#pragma unroll
        for (int i = 0; i < 16; ++i) acc[jt][i] = gelu_tanh(acc[jt][i] + pb[32 * jt + (i & 3) + 8 * (i >> 2)]);
#pragma unroll
        for (int s = 0; s < 2; ++s) {
            v4u w; w.x = nsa::cvtpk(acc[jt][8 * s], acc[jt][8 * s + 1]); w.y = nsa::cvtpk(acc[jt][8 * s + 2], acc[jt][8 * s + 3]); w.z = nsa::cvtpk(acc[jt][8 * s + 4], acc[jt][8 * s + 5]); w.w = nsa::cvtpk(acc[jt][8 * s + 6], acc[jt][8 * s + 7]);
            const bf16x8 hb = __builtin_bit_cast(bf16x8, w);
#pragma unroll
            for (int ct = 0; ct < 2; ++ct) {
                const bf16* wp = W2T + (size_t)(32 * ct) * 128 + 32 * jt + 16 * s;
                const v2u lo = *(const v2u*)wp, hi = *(const v2u*)(wp + 8);
                v4u vv; vv.x = lo.x; vv.y = lo.y; vv.z = hi.x; vv.w = hi.y;
                o2[ct] = CMP_MFMA(__builtin_bit_cast(bf16x8, vv), hb, o2[ct]);
            }
        }
    }
    bf16* O = (kv ? F.vcmp : F.kcmp) + ((size_t)(b * 2 + g) * 256 + n) * 64 + 4 * h;
    const bool live = n < NCMP;
#pragma unroll
    for (int ct = 0; ct < 2; ++ct)
#pragma unroll
        for (int q4 = 0; q4 < 4; ++q4) { v2u wv; wv.x = live ? nsa::cvtpk(o2[ct][4 * q4], o2[ct][4 * q4 + 1]) : 0u; wv.y = live ? nsa::cvtpk(o2[ct][4 * q4 + 2], o2[ct][4 * q4 + 3]) : 0u; *(v2u*)(O + 32 * ct + 8 * q4) = wv; }
}
__device__ __forceinline__ void phase(const Ctx& F, int l) {
    if ((F.wave & 3) == 0) {
        const int gq = F.vcu * 2 + (F.wave >> 2), nq = F.G * 2;
        for (int wu = gq; wu < 512; wu += nq) wave_unit(F, l, wu, F.lane);
    }
}
#undef CMP_MFMA
}

namespace hg {
typedef short bf16x8 __attribute__((ext_vector_type(8)));
typedef float f32x16 __attribute__((ext_vector_type(16)));
#define HG_MFMA(a, b, c) __builtin_amdgcn_mfma_f32_32x32x16_bf16((a), (b), (c), 0, 0, 0)
constexpr int TP = 272, VP = 136;
constexpr int L_QT = 0, L_KT = 17408, L_QD = 34816, L_VT = 52224, L_KD = 0, L_TOT = 69632, L_SSQ = 71680, L_END = 72704;
static_assert(L_END <= RING_BYTES, "HGRN LDS map");
struct Prep { float b[16], k[16]; float bref, blast; };
__device__ __forceinline__ void prep(const Ctx& F, int l, int b, int h, int n, int tid, LAS float* tot, Prep& P) {
    const int d = tid & 127, tq = tid >> 7;
    float lb;
    {   float p[DEPTH], mx = -1e30f, sum = 0.f, acc = 0.f;
#pragma unroll
        for (int i = 0; i < DEPTH; ++i) { p[i] = F.lb_param[i * 512 + h * 128 + d]; mx = fmaxf(mx, p[i]); }
#pragma unroll
        for (int i = 0; i < DEPTH; ++i) { p[i] = expf(p[i] - mx); sum += p[i]; }
#pragma unroll
        for (int i = 1; i < DEPTH; ++i) { if (i <= l) acc += p[i]; }
        lb = acc / sum; }
    const bf16* zp = F.proj + ((size_t)b * SEQ + 64 * n + 16 * tq) * PS + C_HF + h * 128 + d;
    float run = 0.f;
#pragma unroll
    for (int i = 0; i < 16; ++i) { const float z = bf2f(zp[(size_t)i * PS]); const float f = lb + (1.f - lb) * sigmoidf_(z); run += __logf(f); P.b[i] = run; P.k[i] = 1.f - f; }
    tot[tq * 128 + d] = run;
    __syncthreads();
    const float t0 = tot[d], t1 = tot[128 + d], t2 = tot[256 + d], t3 = tot[384 + d];
    const float off = (tq == 0) ? 0.f : (tq == 1) ? t0 : (tq == 2) ? (t0 + t1) : (t0 + t1 + t2);
#pragma unroll
    for (int i = 0; i < 16; ++i) P.b[i] += off;
    P.bref = t0 + t1; P.blast = (t0 + t1) + (t2 + t3);
}
__device__ __forceinline__ void load_vt(const bf16* vsrc, LAS unsigned char* vt, int tid) {
#pragma unroll
    for (int e = 0; e < 2; ++e) {
        const int id = tid + 512 * e, s = id >> 4, ch = id & 15;
        const v4u x = *(const v4u*)(vsrc + (size_t)s * PS + ch * 8);
        LAS unsigned short* vp = (LAS unsigned short*)(vt + (ch * 8) * VP + s * 2);
        vp[0 * (VP / 2)] = (unsigned short)(x.x & 0xffffu); vp[1 * (VP / 2)] = (unsigned short)(x.x >> 16);
        vp[2 * (VP / 2)] = (unsigned short)(x.y & 0xffffu); vp[3 * (VP / 2)] = (unsigned short)(x.y >> 16);
        vp[4 * (VP / 2)] = (unsigned short)(x.z & 0xffffu); vp[5 * (VP / 2)] = (unsigned short)(x.z >> 16);
        vp[6 * (VP / 2)] = (unsigned short)(x.w & 0xffffu); vp[7 * (VP / 2)] = (unsigned short)(x.w >> 16);
    }
}
__device__ __forceinline__ bf16x8 ld8x2(const LAS unsigned char* p) {
    const v2u lo = *(const LAS v2u*)p, hi = *(const LAS v2u*)(p + 8); v4u v; v.x = lo.x; v.y = lo.y; v.z = hi.x; v.w = hi.y; return __builtin_bit_cast(bf16x8, v);
}
__device__ __forceinline__ void h1_unit(const Ctx& F, int l, int u) {
    LAS unsigned char* L = F.lds + RING_OFF;
    const int tid = F.tid, lane = F.lane, w = F.wave, r = lane & 31, hl = lane >> 5;
    const int b = u >> 8, h = (u >> 6) & 3, n = u & 63;
    Prep P; prep(F, l, b, h, n, tid, (LAS float*)(L + L_TOT), P);
    const int d = tid & 127, tq = tid >> 7;
    {   unsigned wv[8];
#pragma unroll
        for (int i = 0; i < 8; ++i) wv[i] = nsa::cvtpk(P.k[2 * i] * __expf(P.blast - P.b[2 * i]), P.k[2 * i + 1] * __expf(P.blast - P.b[2 * i + 1]));
        LAS v2u* kp = (LAS v2u*)(L + L_KD + d * VP + 32 * tq);
#pragma unroll
        for (int i = 0; i < 4; ++i) { v2u x; x.x = wv[2 * i]; x.y = wv[2 * i + 1]; kp[i] = x; } }
    load_vt(F.proj + ((size_t)b * SEQ + 64 * n) * PS + C_HI + h * 128, L + L_VT, tid);
    if (tq == 0) F.dlast[(size_t)u * 128 + d] = __expf(P.blast);
    __syncthreads();
    const int dkt = w & 3, dvt0 = 2 * (w >> 2);
    f32x16 a0, a1;
#pragma unroll
    for (int i = 0; i < 16; ++i) { a0[i] = 0.f; a1[i] = 0.f; }
#pragma unroll
    for (int ks = 0; ks < 4; ++ks) {
        const bf16x8 A = ld8x2(L + L_KD + (32 * dkt + r) * VP + 32 * ks + 16 * hl);
        const bf16x8 B0 = ld8x2(L + L_VT + (32 * dvt0 + r) * VP + 32 * ks + 16 * hl), B1 = ld8x2(L + L_VT + (32 * dvt0 + 32 + r) * VP + 32 * ks + 16 * hl);
        a0 = HG_MFMA(A, B0, a0); a1 = HG_MFMA(A, B1, a1);
    }
    bf16* O = F.kvt + (size_t)u * 16384 + (size_t)(32 * dvt0 + r) * 128 + 32 * dkt + 4 * hl;
#pragma unroll
    for (int q4 = 0; q4 < 4; ++q4) {
        v2u x; x.x = nsa::cvtpk(a0[4 * q4], a0[4 * q4 + 1]); x.y = nsa::cvtpk(a0[4 * q4 + 2], a0[4 * q4 + 3]); *(v2u*)(O + 8 * q4) = x;
        v2u y; y.x = nsa::cvtpk(a1[4 * q4], a1[4 * q4 + 1]); y.y = nsa::cvtpk(a1[4 * q4 + 2], a1[4 * q4 + 3]); *(v2u*)(O + 32 * 128 + 8 * q4) = y;
    }
    __syncthreads();
}
__device__ __forceinline__ void scan(const Ctx& F) {
    const int gw = F.vcu * NWAVES + F.wave, NGW = F.G * NWAVES, lane = F.lane;
    for (int task = gw; task < 2048; task += NGW) {
        const int bh = task >> 5, part = task & 31, dv = 4 * part + (lane >> 4), dk0 = (lane & 15) * 8;
        bf16* kv = F.kvt + (size_t)bh * 64 * 16384 + (size_t)dv * 128 + dk0;
        const float* dl = F.dlast + (size_t)bh * 64 * 128 + dk0;
        float S[8];
#pragma unroll
        for (int i = 0; i < 8; ++i) S[i] = 0.f;
#pragma unroll 4
        for (int n = 0; n < 63; ++n) {
            const v4u x = *(const v4u*)(kv + (size_t)n * 16384);
            const f32x4 d0 = *(const f32x4*)(dl + n * 128), d1 = *(const f32x4*)(dl + n * 128 + 4);
            S[0] = d0.x * S[0] + bflo(x.x); S[1] = d0.y * S[1] + bfhi(x.x); S[2] = d0.z * S[2] + bflo(x.y); S[3] = d0.w * S[3] + bfhi(x.y);
            S[4] = d1.x * S[4] + bflo(x.z); S[5] = d1.y * S[5] + bfhi(x.z); S[6] = d1.z * S[6] + bflo(x.w); S[7] = d1.w * S[7] + bfhi(x.w);
            v4u y; y.x = nsa::cvtpk(S[0], S[1]); y.y = nsa::cvtpk(S[2], S[3]); y.z = nsa::cvtpk(S[4], S[5]); y.w = nsa::cvtpk(S[6], S[7]);
            *(v4u*)(kv + (size_t)n * 16384) = y;
        }
    }
}
__device__ __forceinline__ void h3_unit(const Ctx& F, int l, int u) {
    LAS unsigned char* L = F.lds + RING_OFF;
    const int tid = F.tid, lane = F.lane, w = F.wave, r = lane & 31, hl = lane >> 5;
    const int b = u >> 8, h = (u >> 6) & 3, n = u & 63;
    const size_t row0 = (size_t)b * SEQ + 64 * n;
    Prep P; prep(F, l, b, h, n, tid, (LAS float*)(L + L_TOT), P);
    {   const int d = tid & 127, tq = tid >> 7;
        const bf16* qp = F.proj + (row0 + 16 * tq) * PS + C_HQ + h * 128 + d;
#pragma unroll
        for (int i = 0; i < 16; ++i) {
            const float q = bf2f(qp[(size_t)i * PS]); const int off = (16 * tq + i) * TP + d * 2;
            *(LAS unsigned short*)(L + L_QT + off) = (unsigned short)f2bf(q * __expf(P.b[i] - P.bref));
            *(LAS unsigned short*)(L + L_KT + off) = (unsigned short)f2bf(P.k[i] * __expf(P.bref - P.b[i]));
            *(LAS unsigned short*)(L + L_QD + off) = (unsigned short)f2bf(q * __expf(P.b[i]));
        } }
    load_vt(F.proj + row0 * PS + C_HI + h * 128, L + L_VT, tid);
    __syncthreads();
    const int dvt = w & 3, tt = w >> 2;
    f32x16 o;
#pragma unroll
    for (int i = 0; i < 16; ++i) o[i] = 0.f;
#pragma unroll 1
    for (int st = 0; st <= tt; ++st) {
        f32x16 a;
#pragma unroll
        for (int i = 0; i < 16; ++i) a[i] = 0.f;
#pragma unroll
        for (int ks = 0; ks < 8; ++ks) {
            const bf16x8 A = *(const LAS bf16x8*)(L + L_KT + (32 * st + r) * TP + 32 * ks + 16 * hl);
            const bf16x8 B = *(const LAS bf16x8*)(L + L_QT + (32 * tt + r) * TP + 32 * ks + 16 * hl);
            a = HG_MFMA(A, B, a);
        }
        if (st == tt) {
#pragma unroll
            for (int i = 0; i < 16; ++i) { const int sl = (i & 3) + 8 * (i >> 2) + 4 * hl; a[i] = (sl <= r) ? a[i] : 0.f; }
        }
#pragma unroll
        for (int s2 = 0; s2 < 2; ++s2) {
            v4u pw; pw.x = nsa::cvtpk(a[8 * s2], a[8 * s2 + 1]); pw.y = nsa::cvtpk(a[8 * s2 + 2], a[8 * s2 + 3]); pw.z = nsa::cvtpk(a[8 * s2 + 4], a[8 * s2 + 5]); pw.w = nsa::cvtpk(a[8 * s2 + 6], a[8 * s2 + 7]);
            const LAS unsigned char* va = L + L_VT + (32 * dvt + r) * VP + (32 * st + 16 * s2 + 4 * hl) * 2;
            const v2u lo = *(const LAS v2u*)va, hi = *(const LAS v2u*)(va + 16);
            v4u vv; vv.x = lo.x; vv.y = lo.y; vv.z = hi.x; vv.w = hi.y;
            o = HG_MFMA(__builtin_bit_cast(bf16x8, vv), __builtin_bit_cast(bf16x8, pw), o);
        }
    }
    if (n > 0) {
        const bf16* Sp = F.kvt + (size_t)(u - 1) * 16384 + (size_t)(32 * dvt + r) * 128 + 8 * hl;
#pragma unroll
        for (int ks = 0; ks < 8; ++ks) {
            const bf16x8 A = *(const bf16x8*)(Sp + 16 * ks);
            const bf16x8 B = *(const LAS bf16x8*)(L + L_QD + (32 * tt + r) * TP + 32 * ks + 16 * hl);
            o = HG_MFMA(A, B, o);
        }
    }
    LAS float* ssq = (LAS float*)(L + L_SSQ);
    float ss = 0.f;
#pragma unroll
    for (int i = 0; i < 16; ++i) ss += o[i] * o[i];
    ss += __shfl_xor(ss, 32);
    if (hl == 0) ssq[dvt * 64 + 32 * tt + r] = ss;
    __syncthreads();
    const int tl = 32 * tt + r;
    const float rinv = 1.0f / sqrtf(((ssq[tl] + ssq[64 + tl]) + (ssq[128 + tl] + ssq[192 + tl])) * (1.f / 128.f) + 1e-6f);
    const bf16* gp = F.proj + (row0 + tl) * PS + C_HG + h * 128 + 32 * dvt + 4 * hl;
    bf16* op = F.mix + (row0 + tl) * D + h * 128 + 32 * dvt + 4 * hl;
    const float* nw = F.norm_w + l * 128 + 32 * dvt + 4 * hl;
#pragma unroll
    for (int q4 = 0; q4 < 4; ++q4) {
        const v2u gw2 = *(const v2u*)(gp + 8 * q4); const f32x4 nv = *(const f32x4*)(nw + 8 * q4);
        const float g0 = bflo(gw2.x), g1 = bfhi(gw2.x), g2 = bflo(gw2.y), g3 = bfhi(gw2.y);
        v2u y; y.x = nsa::cvtpk(o[4 * q4] * rinv * nv.x * (g0 * sigmoidf_(g0)), o[4 * q4 + 1] * rinv * nv.y * (g1 * sigmoidf_(g1)));
        y.y = nsa::cvtpk(o[4 * q4 + 2] * rinv * nv.z * (g2 * sigmoidf_(g2)), o[4 * q4 + 3] * rinv * nv.w * (g3 * sigmoidf_(g3)));
        *(v2u*)(op + 8 * q4) = y;
    }
    __syncthreads();
}
#undef HG_MFMA
}

struct Args { const float* in[19]; float* out; unsigned char* ws; int ph_lo, ph_hi; };
__global__ void __launch_bounds__(NWAVES * 64, 2) fwd(Args args) {
    extern __shared__ __attribute__((aligned(16))) unsigned char lds[];
    Ctx F;
    F.lds = (LAS unsigned char*)lds;
    volatile LAS unsigned* MISC = (volatile LAS unsigned*)(F.lds + MISC_OFF);
    F.tid = threadIdx.x; F.lane = F.tid & 63; F.wave = __builtin_amdgcn_readfirstlane(F.tid >> 6);
    F.G = gridDim.x; { const int bx = blockIdx.x; F.vcu = (F.G % 8 == 0) ? (bx % 8) * (F.G / 8) + bx / 8 : bx; }
    unsigned char* ws = args.ws;
    gu32* ctl = (gu32*)(ws + WS_CTL);
    F.x = args.in[0]; F.w_in = args.in[1]; F.lb_param = args.in[2]; F.norm_w = args.in[3]; F.pos_k = args.in[4]; F.w1_k = args.in[5]; F.w2_k = args.in[6];
    F.pos_v = args.in[7]; F.w1_v = args.in[8]; F.w2_v = args.in[9]; F.rel_bias = args.in[10]; F.w_out = args.in[11]; F.ln1_g = args.in[12]; F.ln1_b = args.in[13];
    F.w_gate = args.in[14]; F.w_up = args.in[15]; F.w_down = args.in[16]; F.ln2_g = args.in[17]; F.ln2_b = args.in[18]; F.out = args.out;
    F.win_t = (bf16*)(ws + WS_WIN); F.wout_t = (bf16*)(ws + WS_WOUT); F.wgu_t = (bf16*)(ws + WS_WGU); F.wdn_t = (bf16*)(ws + WS_WDN);
    F.kcmp = (bf16*)(ws + WS_KCMP); F.vcmp = (bf16*)(ws + WS_VCMP); F.xb = (bf16*)(ws + WS_XB); F.mix = (bf16*)(ws + WS_MIX); F.proj = (bf16*)(ws + WS_PROJ);
    F.opre = (float*)(ws + WS_OPRE); F.w1t = (bf16*)(ws + WS_W1T); F.w2t = (bf16*)(ws + WS_W2T); F.posb = (float*)(ws + WS_POSB);
    F.kvt = (bf16*)(ws + WS_XB);
    F.dlast = (float*)(ws + WS_OPRE);
    for (int u = F.tid; u < (LDS_BYTES - LDSCTL_OFF) / 4; u += NWAVES * 64) ((LAS unsigned*)(F.lds + LDSCTL_OFF))[u] = 0u;
    __syncthreads();
    XcdBarrier bar; bar.bar = (unsigned*)(ctl + CW_BAR); bar.x = 0; bar.st = nullptr;
    if (ONE_LAUNCH) bar = xcd_barrier_post((unsigned*)(ctl + CW_BAR), MISC + 8);
    const int lo = args.ph_lo, hi = args.ph_hi;
#define IN(k) (lo <= (k) && (k) < hi)
#define FRESH() do { int t_ = threadIdx.x; asm volatile("" : "+v"(t_)); F.tid = t_; F.lane = t_ & 63; } while (0)
#define SEAM(k) do { if (IN(k) && IN((k) + 1)) { if (ONE_LAUNCH) xcd_barrier(bar); } } while (0)

    if (IN(0)) { p_prologue(F); } SEAM(0);
    for (int l = 0; l < DEPTH; ++l) {
        const int p0 = 1 + 9 * l;
        const float* xin = (l == 0) ? F.x : F.out;
        if (IN(p0 + 0)) {
            pg8::Gemm g{F.xb, F.win_t + (size_t)l * PS * D, M, PS, D}; pg8::StaticOrder S; S.init(M, PS, F.G, (int)blockIdx.x);
            pg8::EpiBf16<0> E{F.proj, PS, nullptr, 0, 0, 1.f};
            pg8::gemm_phase<pg8::EpiBf16<0>, pg8::StaticOrder, true, true>(F.lds + RING_OFF, g, S, E);
        } SEAM(p0 + 0);
        if (IN(p0 + 1)) { FRESH();
            cmpx::phase(F, l);
#pragma unroll 1
            for (int u = F.vcu; u < 4096; u += F.G) hg::h1_unit(F, l, u);
        } SEAM(p0 + 1);
        if (IN(p0 + 2)) { FRESH();
            hg::scan(F);
            FRESH(); nsa::phase(F);
        } SEAM(p0 + 2);
        if (IN(p0 + 3)) { FRESH();
#pragma unroll 1
            for (int u = F.vcu; u < 4096; u += F.G) hg::h3_unit(F, l, u);
        } SEAM(p0 + 3);
        if (IN(p0 + 4)) {
            pg8::Gemm g{F.mix, F.wout_t + (size_t)l * D * D, M, D, D}; pg8::StaticOrder S; S.init(M, D, F.G, (int)blockIdx.x);
            pg8::EpiResid E{xin, F.out, D, ALPHA};
            pg8::gemm_phase<pg8::EpiResid, pg8::StaticOrder, true, true>(F.lds + RING_OFF, g, S, E);
        } SEAM(p0 + 4);
        if (IN(p0 + 5)) { FRESH(); p_layernorm(F, F.ln1_g + l * D, F.ln1_b + l * D); } SEAM(p0 + 5);
        if (IN(p0 + 6)) {
            pg8::Gemm g{F.xb, F.wgu_t + (size_t)l * NGU * D, M, NGU, D}; pg8::StaticOrder S; S.init(M, NGU, F.G, (int)blockIdx.x);
            pg8::EpiSwiGLU E{F.proj, DFF};
            pg8::gemm_phase<pg8::EpiSwiGLU, pg8::StaticOrder, true, true>(F.lds + RING_OFF, g, S, E);
        } SEAM(p0 + 6);
        if (IN(p0 + 7)) {
            pg8::Gemm g{F.proj, F.wdn_t + (size_t)l * D * DFF, M, D, DFF}; pg8::StaticOrder S; S.init(M, D, F.G, (int)blockIdx.x);
            pg8::EpiResid E{F.out, F.out, D, ALPHA};
            pg8::gemm_phase<pg8::EpiResid, pg8::StaticOrder, true, true>(F.lds + RING_OFF, g, S, E);
        } SEAM(p0 + 7);
        if (IN(p0 + 8)) { FRESH(); p_layernorm(F, F.ln2_g + l * D, F.ln2_b + l * D); } SEAM(p0 + 8);
    }
#undef IN
#undef SEAM
}

extern "C" void kernel_launch(void* const* d_in, const int* in_sizes, int n_in, void* d_out, int out_size, void* d_ws, size_t ws_size, hipStream_t stream) {
    static int grid = 0;
    if (grid == 0) {
        if (n_in != 19 || in_sizes[0] != M * D || out_size != M * D || ws_size < WS_END) { fprintf(stderr, "kernel_launch: unexpected shapes (n_in %d, in0 %d, out %d, ws %zu); nothing launched\n", n_in, n_in > 0 ? in_sizes[0] : -1, out_size, ws_size); grid = -1; return; }
        int dev = 0, cus = 0, per_cu = 0;
        if (hipGetDevice(&dev) != hipSuccess || hipDeviceGetAttribute(&cus, hipDeviceAttributeMultiprocessorCount, dev) != hipSuccess) { grid = -1; return; }
        if (hipFuncSetAttribute((const void*)fwd, hipFuncAttributeMaxDynamicSharedMemorySize, LDS_BYTES) != hipSuccess) { fprintf(stderr, "kernel_launch: hipFuncSetAttribute failed\n"); grid = -1; return; }
        if (hipOccupancyMaxActiveBlocksPerMultiprocessor(&per_cu, (const void*)fwd, NWAVES * 64, LDS_BYTES) != hipSuccess || per_cu < 1) fprintf(stderr, "kernel_launch: note: occupancy query reports %d\n", per_cu);
        (void)hipGetLastError();
        grid = cus;
    }
    if (grid < 0) return;
    if (hipMemsetAsync((char*)d_ws + WS_CTL, 0, CTL_ZERO_BYTES, stream) != hipSuccess) return;
    Args a{};
    for (int i = 0; i < 19; ++i) a.in[i] = (const float*)d_in[i];
    a.out = (float*)d_out; a.ws = (unsigned char*)d_ws;
    if (ONE_LAUNCH) { a.ph_lo = 0; a.ph_hi = N_PHASES; hipLaunchKernelGGL(fwd, dim3(grid), dim3(NWAVES * 64), LDS_BYTES, stream, a); }
    else { for (int p = 0; p < N_PHASES; ++p) { a.ph_lo = p; a.ph_hi = p + 1; hipLaunchKernelGGL(fwd, dim3(grid), dim3(NWAVES * 64), LDS_BYTES, stream, a); } }
}
```

```cpp
#define MK_N_LAUNCHES 1
#include <hip/hip_runtime.h>
#include <cstdio>
#include <cstdint>
#include <cmath>
namespace pg8 {
#define PG8_LAS __attribute__((address_space(3)))
typedef unsigned short bf16_t;
typedef short bf16x8 __attribute__((ext_vector_type(8)));
typedef float f32x4 __attribute__((ext_vector_type(4)));
typedef unsigned u32x4 __attribute__((ext_vector_type(4)));
constexpr int BM = 256, BK = 64, HALF = 128, HTB = HALF * BK * 2  , STAGE_BYTES = 8 * HTB, NXCD = 8, WGM = 8;

__host__ __device__ __forceinline__ int lds_byte(int r, int c) { const int st = (r >> 4) * 2 + (c >> 5), rr = r & 15, cc = c & 31, ob = rr * 64 + cc * 2; return st * 1024 + (ob ^ (((ob >> 9) & 1) << 5)); }
__host__ __device__ __forceinline__ void stage_rc(int b, int& R, int& C) { const int st = b / 1024, sb = b % 1024, swz = sb ^ (((sb >> 9) & 1) << 5); R = (st >> 1) * 16 + swz / 64; C = (st & 1) * 32 + (swz % 64) / 2; }
__host__ __device__ __forceinline__ int perm32(int rho) { const int n = rho >> 4, i = rho & 15; return 8 * (i >> 2) + 4 * n + (i & 3); }

struct Unit { int pm, pn; };
struct Gemm { const bf16_t* A; const bf16_t* Bt; int M, N, K; };

struct StaticOrder {
    int nM, nN, nwg, G, c;
    __host__ __device__ void init(int M, int N, int G_, int c_) { nM = M / BM; nN = N / BM; nwg = nM * nN; G = G_; c = c_; }
    __host__ __device__ bool next(int i, Unit& u) const {
        const long L = (long)i * G + c; if (L >= nwg) return false;
        int wgid = (int)L; { const int q = nwg / NXCD, r = nwg % NXCD, xcd = wgid % NXCD, off = wgid / NXCD; wgid = (xcd < r ? xcd * (q + 1) : r * (q + 1) + (xcd - r) * q) + off; }
        const int nig = WGM * nN, gid = wgid / nig, fm = gid * WGM, gsz = (nM - fm) < WGM ? (nM - fm) : WGM;
        u.pm = fm + ((wgid % nig) % gsz); u.pn = (wgid % nig) / gsz; return true;
    }
    __device__ __forceinline__ void a_ready(const Unit&) const {}
    __device__ __forceinline__ void done(const Unit&) const {}
};

__device__ __forceinline__ unsigned cvt_pk_bf16(float lo, float hi) { unsigned r; asm volatile("v_cvt_pk_bf16_f32 %0, %1, %2" : "=v"(r) : "v"(lo), "v"(hi)); return r; }
typedef float f32x2 __attribute__((ext_vector_type(2)));
__device__ __forceinline__ f32x2 gelu_pk(f32x2 v) {
    const f32x2 av = __builtin_elementwise_abs(v), d = av * 0.2316418882f + 1.0f;
    f32x2 t; t.x = __builtin_amdgcn_rcpf(d.x); t.y = __builtin_amdgcn_rcpf(d.y);
    f32x2 q = t * 0.5307027145f + (-0.7265760135f); q = q * t + 0.7107068705f; q = q * t + (-0.142248368f); q = q * t + 0.127414796f; q = q * t;
    const f32x2 s = (v * v) * (-0.72134752044f);
    f32x2 e; e.x = __builtin_amdgcn_exp2f(s.x); e.y = __builtin_amdgcn_exp2f(s.y);
    const f32x2 m = v * (q * e), r = v - m;
    f32x2 o; o.x = v.x < 0.f ? m.x : r.x; o.y = v.y < 0.f ? m.y : r.y; return o;
}

template <int ACT  > struct EpiBf16 {
    static constexpr bool PERM = true, AFTER_DRAIN = false; static_assert(ACT == 0 || ACT == 1, "EpiBf16: ACT is 0 (none) or 1 (gelu_pk)");
    bf16_t* O; int ldc; const float* bias; int split_cols; size_t split_stride; float scale0;
    __device__ __forceinline__ void operator()(const f32x4 (&acc)[2][2][4][2], const Unit& u, int wr, int wc, int fr, int fq) const {
        const int row0 = u.pm * BM + wr * 64 + fr; int colt = u.pn * BM; bf16_t* base = O;
        float sc = 1.f; if (split_cols) { const int t = colt / split_cols; base += (size_t)t * split_stride; colt -= t * split_cols; if (t == 0) sc = scale0; }
        const int col0 = colt + wc * 32 + 8 * fq, bcol0 = u.pn * BM + wc * 32 + 8 * fq;
        f32x4 bv[2][2];
#pragma unroll
        for (int bj = 0; bj < 2; ++bj)
#pragma unroll
            for (int n = 0; n < 2; ++n) bv[bj][n] = bias ? *(const f32x4*)(bias + bcol0 + bj * HALF + 4 * n) : (f32x4){0.f, 0.f, 0.f, 0.f};
#pragma unroll
        for (int ai = 0; ai < 2; ++ai)
#pragma unroll
            for (int m = 0; m < 4; ++m) { bf16_t* rowp = base + (size_t)(row0 + ai * HALF + m * 16) * ldc + col0;
#pragma unroll
                for (int bj = 0; bj < 2; ++bj) { f32x4 v0 = acc[ai][bj][m][0] + bv[bj][0], v1 = acc[ai][bj][m][1] + bv[bj][1];
                    if (ACT == 1) { f32x2 a = gelu_pk((f32x2){v0[0], v0[1]}), b = gelu_pk((f32x2){v0[2], v0[3]}), c = gelu_pk((f32x2){v1[0], v1[1]}), d = gelu_pk((f32x2){v1[2], v1[3]});
                        v0 = (f32x4){a.x, a.y, b.x, b.y}; v1 = (f32x4){c.x, c.y, d.x, d.y}; }
                    v0 = v0 * sc; v1 = v1 * sc; u32x4 w; w.x = cvt_pk_bf16(v0[0], v0[1]); w.y = cvt_pk_bf16(v0[2], v0[3]); w.z = cvt_pk_bf16(v1[0], v1[1]); w.w = cvt_pk_bf16(v1[2], v1[3]);
                    *(u32x4*)(rowp + bj * HALF) = w; } }
    }
};

struct EpiResid {
    static constexpr bool PERM = false, AFTER_DRAIN = false;
    const float* xin; float* out; int ldc; float alpha;
    __device__ __forceinline__ void operator()(const f32x4 (&acc)[2][2][4][2], const Unit& u, int wr, int wc, int fr, int fq) const {
        const int col0 = u.pn * BM + wc * 32 + 4 * fq;
#pragma unroll
        for (int ai = 0; ai < 2; ++ai)
#pragma unroll
            for (int m = 0; m < 4; ++m) { const size_t off = (size_t)(u.pm * BM + ai * HALF + wr * 64 + m * 16 + fr) * ldc + col0;
#pragma unroll
                for (int bj = 0; bj < 2; ++bj)
#pragma unroll
                    for (int n = 0; n < 2; ++n) { const size_t p = off + bj * HALF + n * 16; const f32x4 xv = *(const f32x4*)(xin + p); *(f32x4*)(out + p) = xv * alpha + acc[ai][bj][m][n]; } }
    }
};
struct EpiSwiGLU {
    static constexpr bool PERM = true, AFTER_DRAIN = false;
    bf16_t* H; int ldh;
    __device__ __forceinline__ static float silu(float x) { return x * __builtin_amdgcn_rcpf(1.0f + __expf(-x)); }
    __device__ __forceinline__ void operator()(const f32x4 (&acc)[2][2][4][2], const Unit& u, int wr, int wc, int fr, int fq) const {
        const int row0 = u.pm * BM + wr * 64 + fr, col0 = u.pn * HALF + wc * 32 + 8 * fq;
#pragma unroll
        for (int ai = 0; ai < 2; ++ai)
#pragma unroll
            for (int m = 0; m < 4; ++m) { bf16_t* rowp = H + (size_t)(row0 + ai * HALF + m * 16) * ldh + col0;
                const f32x4 g0 = acc[ai][0][m][0], g1 = acc[ai][0][m][1], u0 = acc[ai][1][m][0], u1 = acc[ai][1][m][1];
                u32x4 w; w.x = cvt_pk_bf16(silu(g0[0]) * u0[0], silu(g0[1]) * u0[1]); w.y = cvt_pk_bf16(silu(g0[2]) * u0[2], silu(g0[3]) * u0[3]);
                w.z = cvt_pk_bf16(silu(g1[0]) * u1[0], silu(g1[1]) * u1[1]); w.w = cvt_pk_bf16(silu(g1[2]) * u1[2], silu(g1[3]) * u1[3]);
                *(u32x4*)rowp = w; }
    }
};
template <class Epi, class Sched, bool ALIGN_EPI = false, bool SP2 = false>
__device__ __forceinline__ void gemm_phase(PG8_LAS unsigned char* lds, const Gemm g, const Sched& S, const Epi& E) {
    int tid_ = threadIdx.x; asm volatile("" : "+v"(tid_));
    const int tid = tid_, wid = __builtin_amdgcn_readfirstlane(tid >> 6), lane = tid & 63, wr = wid >> 2, wc = wid & 3, fr = lane & 15, fq = lane >> 4;
    const int K = g.K, nt = K / BK;
    unsigned voffA[2], voffB[2];
#pragma unroll
    for (int i = 0; i < 2; ++i) { int R, C; stage_rc(tid * 16 + i * 8192, R, C); const int Rb = Epi::PERM ? ((R & ~31) + perm32(R & 31)) : R;
        voffA[i] = (unsigned)(R * K + C) * 2u; voffB[i] = (unsigned)(Rb * K + C) * 2u; }
    const size_t kstep = (size_t)(BK * 2);
    const size_t hstep = (size_t)HALF * K * 2;
    const size_t tstep = 2 * hstep;
    const unsigned ldsw = (unsigned)wid * 1024u;
    const int aoff = lds_byte(wr * 64 + fr, fq * 8), boff = lds_byte(wc * 32 + fr, fq * 8);
#define PG8_SA(b, h) (((b) * 2 + (h)) * HTB)
#define PG8_SB(b, h) ((4 + (b) * 2 + (h)) * HTB)
#define PG8_STAGE(bufoff, gbase, voff) do { _Pragma("unroll") for (int _i = 0; _i < 2; ++_i) \
        __builtin_amdgcn_global_load_lds((const unsigned*)((const char*)(gbase) + (voff)[_i]), (PG8_LAS unsigned*)(lds + (bufoff) + ldsw + _i * 8192), 16, 0, 0); } while (0)
#define PG8_LDA(dst, b, h) do { _Pragma("unroll") for (int m = 0; m < 4; ++m) _Pragma("unroll") for (int k = 0; k < 2; ++k) dst[m][k] = *(const PG8_LAS bf16x8*)(lds + PG8_SA(b, h) + aoff + m * 2048 + k * 1024); } while (0)
#define PG8_LDB(dst, b, h) do { _Pragma("unroll") for (int n = 0; n < 2; ++n) _Pragma("unroll") for (int k = 0; k < 2; ++k) dst[n][k] = *(const PG8_LAS bf16x8*)(lds + PG8_SB(b, h) + boff + n * 2048 + k * 1024); } while (0)
#define PG8_MMA(ai, bj, At, Bt) do { __builtin_amdgcn_s_setprio(1); _Pragma("unroll") for (int m = 0; m < 4; ++m) _Pragma("unroll") for (int n = 0; n < 2; ++n) _Pragma("unroll") for (int k = 0; k < 2; ++k) \
        acc[ai][bj][m][n] = __builtin_amdgcn_mfma_f32_16x16x32_bf16(Bt[n][k], At[m][k], acc[ai][bj][m][n], 0, 0, 0); __builtin_amdgcn_s_setprio(0); } while (0)
#define PG8_WAIT_V(n) asm volatile("s_waitcnt vmcnt(" #n ")" ::: "memory")
#define PG8_WAIT_L(n) asm volatile("s_waitcnt lgkmcnt(" #n ")" ::: "memory")
#define PG8_BAR __builtin_amdgcn_s_barrier()
#define PG8_SCHED __builtin_amdgcn_sched_barrier(0)
    Unit cur, nxt; int ui = 0;
    if (!S.next(0, cur)) return;
    f32x4 acc[2][2][4][2];
#pragma unroll
    for (int a = 0; a < 2; ++a)
#pragma unroll
        for (int b = 0; b < 2; ++b)
#pragma unroll
            for (int m = 0; m < 4; ++m)
#pragma unroll
                for (int n = 0; n < 2; ++n) acc[a][b][m][n] = (f32x4){0.f, 0.f, 0.f, 0.f};
    bf16x8 At[4][2], B0[2][2], B1[2][2];
    const char* cA = (const char*)g.A + (size_t)cur.pm * tstep; const char* cB = (const char*)g.Bt + (size_t)cur.pn * tstep;
    S.a_ready(cur);
    if constexpr (SP2) {
        PG8_STAGE(PG8_SB(0, 0), cB, voffB); PG8_STAGE(PG8_SB(0, 1), cB + hstep, voffB); PG8_STAGE(PG8_SA(0, 0), cA, voffA); PG8_STAGE(PG8_SA(0, 1), cA + hstep, voffA);
        if (wr == 1) PG8_BAR;
        PG8_WAIT_V(2); PG8_BAR;
        PG8_STAGE(PG8_SB(1, 0), cB + kstep, voffB); PG8_STAGE(PG8_SA(1, 0), cA + kstep, voffA); PG8_STAGE(PG8_SB(1, 1), cB + hstep + kstep, voffB);
        PG8_WAIT_V(6); PG8_BAR;
    } else {
        PG8_STAGE(PG8_SB(0, 0), cB, voffB); PG8_STAGE(PG8_SA(0, 0), cA, voffA); PG8_STAGE(PG8_SB(0, 1), cB + hstep, voffB); PG8_STAGE(PG8_SA(0, 1), cA + hstep, voffA);
        if (wr == 1) PG8_BAR;
        PG8_WAIT_V(4); PG8_BAR;
        PG8_STAGE(PG8_SB(1, 0), cB + kstep, voffB); PG8_STAGE(PG8_SA(1, 0), cA + kstep, voffA); PG8_STAGE(PG8_SB(1, 1), cB + hstep + kstep, voffB);
        PG8_WAIT_V(6); PG8_BAR;
    }
    for (;;) {
        const bool has_next = S.next(ui + 1, nxt);
        const char* nA = has_next ? (const char*)g.A + (size_t)nxt.pm * tstep : cA; const char* nB = has_next ? (const char*)g.Bt + (size_t)nxt.pn * tstep : cB;
        for (int t = 0; t < nt; t += 2) {
            const bool last = (t == nt - 2);
            const char* a1 = cA + (size_t)(t + 1) * kstep;
            const char* a2 = last ? nA : cA + (size_t)(t + 2) * kstep; const char* b2 = last ? nB : cB + (size_t)(t + 2) * kstep;
            const char* a3 = a2 + kstep; const char* b3 = b2 + kstep;
            if (last && has_next) S.a_ready(nxt);
            if constexpr (SP2) {
            PG8_LDB(B0, 0, 0); PG8_LDB(B1, 0, 1); PG8_SCHED; PG8_LDA(At, 0, 0); PG8_STAGE(PG8_SA(1, 1), a1 + hstep, voffA);
            PG8_WAIT_V(8); PG8_WAIT_L(0); PG8_BAR; PG8_MMA(0, 0, At, B0); PG8_MMA(0, 1, At, B1); PG8_BAR; PG8_SCHED;
            PG8_LDA(At, 0, 1); PG8_STAGE(PG8_SB(0, 0), b2, voffB); PG8_STAGE(PG8_SB(0, 1), b2 + hstep, voffB); PG8_STAGE(PG8_SA(0, 0), a2, voffA);
            PG8_WAIT_V(8); PG8_WAIT_L(0); PG8_BAR; PG8_MMA(1, 0, At, B0); PG8_MMA(1, 1, At, B1); PG8_BAR; PG8_SCHED;
            PG8_LDB(B0, 1, 0); PG8_LDB(B1, 1, 1); PG8_SCHED; PG8_LDA(At, 1, 0); PG8_STAGE(PG8_SA(0, 1), a2 + hstep, voffA);
            PG8_WAIT_V(8); PG8_WAIT_L(0); PG8_BAR; PG8_MMA(0, 0, At, B0); PG8_MMA(0, 1, At, B1); PG8_BAR; PG8_SCHED;
            PG8_LDA(At, 1, 1); PG8_STAGE(PG8_SB(1, 0), b3, voffB); PG8_STAGE(PG8_SB(1, 1), b3 + hstep, voffB); PG8_STAGE(PG8_SA(1, 0), a3, voffA);
            PG8_WAIT_V(8); PG8_WAIT_L(0); PG8_BAR; PG8_MMA(1, 0, At, B0); PG8_MMA(1, 1, At, B1); PG8_BAR; PG8_SCHED;
            } else {
            PG8_LDB(B0, 0, 0); PG8_SCHED; PG8_LDA(At, 0, 0); PG8_STAGE(PG8_SA(1, 1), a1 + hstep, voffA);
            PG8_WAIT_L(8); PG8_BAR; PG8_WAIT_L(0); PG8_MMA(0, 0, At, B0); PG8_BAR; PG8_SCHED;
            PG8_LDB(B1, 0, 1); PG8_STAGE(PG8_SB(0, 0), b2, voffB);
            PG8_BAR; PG8_WAIT_L(0); PG8_MMA(0, 1, At, B1); PG8_BAR;
            PG8_LDA(At, 0, 1); PG8_STAGE(PG8_SA(0, 0), a2, voffA);
            PG8_BAR; PG8_WAIT_L(0); PG8_MMA(1, 0, At, B0); PG8_BAR; PG8_SCHED;
            PG8_STAGE(PG8_SB(0, 1), b2 + hstep, voffB);
            PG8_WAIT_V(6); PG8_BAR; PG8_MMA(1, 1, At, B1); PG8_BAR;
            PG8_LDB(B0, 1, 0); PG8_SCHED; PG8_LDA(At, 1, 0); PG8_STAGE(PG8_SA(0, 1), a2 + hstep, voffA);
            PG8_WAIT_L(8); PG8_BAR; PG8_WAIT_L(0); PG8_MMA(0, 0, At, B0); PG8_BAR; PG8_SCHED;
            PG8_LDB(B1, 1, 1); PG8_STAGE(PG8_SB(1, 0), b3, voffB);
            PG8_BAR; PG8_WAIT_L(0); PG8_MMA(0, 1, At, B1); PG8_BAR;
            PG8_LDA(At, 1, 1); PG8_STAGE(PG8_SA(1, 0), a3, voffA);
            PG8_BAR; PG8_WAIT_L(0); PG8_MMA(1, 0, At, B0); PG8_BAR; PG8_SCHED;
            PG8_STAGE(PG8_SB(1, 1), b3 + hstep, voffB);
            PG8_WAIT_V(6); PG8_BAR; PG8_MMA(1, 1, At, B1); PG8_BAR;
            }
        }
        if constexpr (ALIGN_EPI) { if (wr == 0) PG8_BAR; }
        if constexpr (!Epi::AFTER_DRAIN) { E(acc, cur, wr, wc, fr, fq); S.done(cur); }
        if (!has_next) break;
#pragma unroll
        for (int a = 0; a < 2; ++a)
#pragma unroll
            for (int b = 0; b < 2; ++b)
#pragma unroll
                for (int m = 0; m < 4; ++m)
#pragma unroll
                    for (int n = 0; n < 2; ++n) acc[a][b][m][n] = (f32x4){0.f, 0.f, 0.f, 0.f};
        cur = nxt; cA = nA; cB = nB; ++ui;
        if constexpr (ALIGN_EPI) { if (wr == 1) PG8_BAR; }
    }
    PG8_WAIT_V(0);
    if constexpr (!ALIGN_EPI) { if (wr == 0) PG8_BAR; }
    PG8_BAR;
    if constexpr (Epi::AFTER_DRAIN) { E.fused(acc, cur, wr, wc, fr, fq, lds, wid, lane); S.done(cur); }
#undef PG8_SA
#undef PG8_SB
#undef PG8_STAGE
#undef PG8_LDA
#undef PG8_LDB
#undef PG8_MMA
#undef PG8_WAIT_V
#undef PG8_WAIT_L
#undef PG8_BAR
#undef PG8_SCHED
}
}
constexpr int NWAVES = 8;
constexpr int BATCH = 16, SEQ = 4096, D = 1024, DEPTH = 4;
constexpr int M = BATCH * SEQ;
constexpr int DIN = 3352, PS = 3584;
constexpr int DFF = 2816, NGU = 2 * DFF;
constexpr int C_HQ = 0, C_HF = 512, C_HI = 1024, C_HG = 1536, C_NQ = 2048, C_KC = 2560, C_VC = 2688, C_KS = 2816, C_VS = 2944, C_KW = 3072, C_VW = 3200, C_GT = 3328;
constexpr float LN_EPS = 1e-5f;
constexpr float ALPHA = 1.681792830507429f;
constexpr int NCMP = 255;

#ifndef MK_N_LAUNCHES
#define MK_N_LAUNCHES 1
#endif
constexpr int N_PHASES = 1 + 9 * DEPTH;
constexpr bool ONE_LAUNCH = (MK_N_LAUNCHES == 1);

constexpr size_t MiB = 1u << 20;
constexpr size_t WS_CTL = 0, CTL_ZERO_BYTES = 1 * MiB;
constexpr size_t WS_WIN = 2 * MiB, WS_WOUT = 30 * MiB, WS_WGU = 38 * MiB, WS_WDN = 82 * MiB;
constexpr size_t WS_KCMP = 104 * MiB, WS_VCMP = 105 * MiB;
constexpr size_t WS_W1T = 106 * MiB, WS_W2T = 110 * MiB, WS_POSB = 110 * MiB + 512 * 1024;
constexpr size_t WS_XB = 112 * MiB, WS_MIX = 240 * MiB, WS_OPRE = 368 * MiB, WS_PROJ = 496 * MiB, WS_END = 944 * MiB;
constexpr int CW_TMO = 0, CW_CODE = 1, CW_BAR = 4096;

constexpr int RING_OFF = 0, RING_BYTES = 131072;
constexpr int LDSCTL_OFF = RING_BYTES, MISC_OFF = LDSCTL_OFF + 320;
constexpr int LDS_BYTES = 147456;

#define GAS __attribute__((address_space(1)))
#define LAS __attribute__((address_space(3)))
typedef unsigned short bf16;
typedef unsigned v4u __attribute__((ext_vector_type(4)));
typedef unsigned v2u __attribute__((ext_vector_type(2)));
typedef float f32x4 __attribute__((ext_vector_type(4)));
typedef GAS unsigned gu32;
#define RLX_AGENT __ATOMIC_RELAXED, __HIP_MEMORY_SCOPE_AGENT
#define LDS_WAIT() asm volatile("s_waitcnt lgkmcnt(0)" ::: "memory")
__device__ __forceinline__ unsigned f2bf(float f) { unsigned u = __builtin_bit_cast(unsigned, f); return (u + 0x7fffu + ((u >> 16) & 1u)) >> 16; }
__device__ __forceinline__ unsigned pk2(float lo, float hi) { return f2bf(lo) | (f2bf(hi) << 16); }
__device__ __forceinline__ float bf2f(unsigned h) { return __uint_as_float(h << 16); }
__device__ __forceinline__ float bflo(unsigned w) { return __uint_as_float(w << 16); }
__device__ __forceinline__ float bfhi(unsigned w) { return __uint_as_float(w & 0xffff0000u); }
__device__ __forceinline__ float wave_sum(float v) {
#pragma unroll
    for (int o = 1; o < 64; o <<= 1) v += __shfl_xor(v, o);
    return v;
}
__device__ __forceinline__ float wave_max(float v) {
#pragma unroll
    for (int o = 1; o < 64; o <<= 1) v = fmaxf(v, __shfl_xor(v, o));
    return v;
}
__device__ __forceinline__ float sigmoidf_(float x) { return __builtin_amdgcn_rcpf(1.0f + __expf(-x)); }
__device__ __forceinline__ float gelu_tanh(float x) { const float u = 0.7978845608028654f * (x + 0.044715f * x * x * x); return 0.5f * x * (1.0f + tanhf(u)); }

#define XB_TMO      128
#define XB_XCNT(j)  (256  + 64 * (j))
#define XB_XSUB(j)  (1280 + 64 * (j))
#define XB_XGEN(j)  (2304 + 64 * (j))
#define XB_TOP      3328
#define XB_TOPGEN   3392
#define XCD_BAR_WORDS 3456
#define XB_SPIN_CAP (1u << 18)

__device__ __forceinline__ unsigned xb_ld(unsigned* p)              { return __hip_atomic_load(p, __ATOMIC_RELAXED, __HIP_MEMORY_SCOPE_AGENT); }
__device__ __forceinline__ unsigned xb_add(unsigned* p, unsigned v) { return __hip_atomic_fetch_add(p, v, __ATOMIC_RELAXED, __HIP_MEMORY_SCOPE_AGENT); }
__device__ __forceinline__ unsigned xb_xcc_id() { return (unsigned)__builtin_amdgcn_s_getreg((3 << 11) | 20) & 0xFu; }
#define XB_SPIN(cond, bar) do { unsigned _sp = 0; while (cond) { __builtin_amdgcn_s_sleep(1); \
    if ((++_sp & 255u) == 0u) { if (xb_ld(&(bar)[XB_TMO])) break; if (_sp > XB_SPIN_CAP) { atomicAdd(&(bar)[XB_TMO], 1u); break; } } } } while (0)

struct XcdBarrier {
    unsigned* bar; unsigned x;
    volatile LAS unsigned* st;
};

__device__ __forceinline__ XcdBarrier xcd_barrier_post(unsigned* bar, volatile LAS unsigned* st) {
    XcdBarrier b; b.bar = bar; b.x = xb_xcc_id(); b.st = st;
    if (threadIdx.x == 0) (void)xb_add(&bar[XB_XCNT(b.x)], 1u);
    return b;
}
__device__ __forceinline__ void xcd_barrier_complete(unsigned* bar, unsigned x, unsigned& nloc, unsigned& nx) {
    const unsigned G = gridDim.x * gridDim.y * gridDim.z;
    unsigned sum, cnt, mine, sp = 0u;
    for (;;) {
        sum = 0u; cnt = 0u; mine = 0u;
#pragma unroll
        for (unsigned j = 0; j < 16; ++j) { const unsigned c = xb_ld(&bar[XB_XCNT(j)]); sum += c; cnt += (c > 0u) ? 1u : 0u; mine = (j == x) ? c : mine; }
        if (sum == G) break;
        __builtin_amdgcn_s_sleep(1);
        if ((++sp & 255u) == 0u) { if (xb_ld(&bar[XB_TMO])) break; if (sp > XB_SPIN_CAP) { atomicAdd(&bar[XB_TMO], 1u); break; } }
    }
    nloc = mine > 0u ? mine : 1u; nx = cnt > 0u ? cnt : 1u;
}

__device__ __forceinline__ void xcd_barrier(const XcdBarrier& b) {
    asm volatile("s_waitcnt vmcnt(0)" ::: "memory");
    __syncthreads();
    if (threadIdx.x == 0) {
        unsigned* bar = b.bar;
        __builtin_amdgcn_s_waitcnt(0);
        unsigned nloc = b.st[0], nx = b.st[1];
        if (nloc == 0u) { xcd_barrier_complete(bar, b.x, nloc, nx); b.st[0] = nloc; b.st[1] = nx; }
        const unsigned old = xb_add(&bar[XB_XSUB(b.x)], 1u);
        const unsigned gen = old / nloc;
        if (old + 1u == (gen + 1u) * nloc) {
            __builtin_amdgcn_fence(__ATOMIC_RELEASE, "agent");
            asm volatile("s_waitcnt vmcnt(0)" ::: "memory");
            const unsigned og = xb_add(&bar[XB_TOP], 1u);
            const unsigned tg = og / nx;
            if (og + 1u == (tg + 1u) * nx) xb_add(&bar[XB_TOPGEN], 1u);
            else XB_SPIN(xb_ld(&bar[XB_TOPGEN]) == tg, bar);
            __builtin_amdgcn_fence(__ATOMIC_ACQUIRE, "agent");
            xb_add(&bar[XB_XGEN(b.x)], 1u);
            asm volatile("s_waitcnt vmcnt(0)" ::: "memory");
        } else {
            XB_SPIN(xb_ld(&bar[XB_XGEN(b.x)]) == gen, bar);
            __builtin_amdgcn_fence(__ATOMIC_ACQUIRE, "agent");
            asm volatile("s_waitcnt vmcnt(0)" ::: "memory");
        }
    }
    __syncthreads();
}

struct Ctx {
    LAS unsigned char* lds;
    int tid, lane, wave, vcu, G;
    const float *x, *w_in, *lb_param, *norm_w, *pos_k, *w1_k, *w2_k, *pos_v, *w1_v, *w2_v, *rel_bias, *w_out, *ln1_g, *ln1_b, *w_gate, *w_up, *w_down, *ln2_g, *ln2_b;
    float* out;
    bf16 *win_t, *wout_t, *wgu_t, *wdn_t, *kcmp, *vcmp, *xb, *mix, *proj, *w1t, *w2t, *kvt;
    float *opre, *posb, *dlast;
};

__device__ __forceinline__ void transpose_item(const float* W, int K, int N, bf16* WT, int dst_row0, LAS float* scr, int k0, int n0, int lane) {
#pragma unroll 8
    for (int i = 0; i < 32; ++i) { const int kk = 2 * i + (lane >> 5); const int n = n0 + (lane & 31); scr[kk * 33 + (lane & 31)] = (n < N) ? W[(size_t)(k0 + kk) * N + n] : 0.f; }
    LDS_WAIT(); asm volatile("" ::: "memory");
    const int c = lane & 7;
#pragma unroll
    for (int j = 0; j < 4; ++j) { const int n = (lane >> 3) + 8 * j; const LAS float* s = scr + (8 * c) * 33 + n;
        v4u o; o.x = pk2(s[0 * 33], s[1 * 33]); o.y = pk2(s[2 * 33], s[3 * 33]); o.z = pk2(s[4 * 33], s[5 * 33]); o.w = pk2(s[6 * 33], s[7 * 33]);
        *(v4u*)(WT + (size_t)(dst_row0 + n) * K + k0 + 8 * c) = o; }
    LDS_WAIT(); asm volatile("" ::: "memory");
}
__device__ __forceinline__ void p_prologue(const Ctx& F) {
    LAS float* scr = (LAS float*)(F.lds + RING_OFF + F.wave * 16384);
    const int gw = F.vcu * NWAVES + F.wave, NGW = F.G * NWAVES;
    constexpr int I_IN = (D / 64) * (PS / 32), I_OUT = (D / 64) * (D / 32), I_G = (D / 64) * (DFF / 32), I_DN = (DFF / 64) * (D / 32);
    constexpr int PER_L = I_IN + I_OUT + 2 * I_G + I_DN;
    for (int it = gw; it < PER_L * DEPTH; it += NGW) {
        const int l = it / PER_L; int r = it % PER_L;
        if (r < I_IN) { const int nb = r % (PS / 32), kb = r / (PS / 32); transpose_item(F.w_in + (size_t)l * D * DIN, D, DIN, F.win_t + (size_t)l * PS * D, 32 * nb, scr, 64 * kb, 32 * nb, F.lane); continue; } r -= I_IN;
        if (r < I_OUT) { const int nb = r % (D / 32), kb = r / (D / 32); transpose_item(F.w_out + (size_t)l * D * D, D, D, F.wout_t + (size_t)l * D * D, 32 * nb, scr, 64 * kb, 32 * nb, F.lane); continue; } r -= I_OUT;
        if (r < 2 * I_G) { const int up = r >= I_G; if (up) r -= I_G; const int nb = r % (DFF / 32), kb = r / (DFF / 32); const int n0 = 32 * nb;
            transpose_item((up ? F.w_up : F.w_gate) + (size_t)l * D * DFF, D, DFF, F.wgu_t + (size_t)l * NGU * D, (n0 / 128) * 256 + (up ? 128 : 0) + (n0 % 128), scr, 64 * kb, n0, F.lane); continue; } r -= 2 * I_G;
        { const int nb = r % (D / 32), kb = r / (D / 32); transpose_item(F.w_down + (size_t)l * DFF * D, DFF, D, F.wdn_t + (size_t)l * D * DFF, 32 * nb, scr, 64 * kb, 32 * nb, F.lane); }
    }
    for (int it = gw; it < DEPTH * 2 * (128 + 4); it += NGW) {
        const int lk = it / 132, r = it % 132, l = lk >> 1, kv = lk & 1;
        if (r < 128) { const int nb = r & 3, kb = r >> 2; transpose_item((kv ? F.w1_v : F.w1_k) + (size_t)l * 2048 * 128, 2048, 128, F.w1t + (size_t)lk * 128 * 2048, 32 * nb, scr, 64 * kb, 32 * nb, F.lane); }
        else { const int q = r - 128, nb = q & 1, kb = q >> 1; transpose_item((kv ? F.w2_v : F.w2_k) + (size_t)l * 128 * 64, 128, 64, F.w2t + (size_t)lk * 64 * 128, 32 * nb, scr, 64 * kb, 32 * nb, F.lane); }
    }
    for (int it = gw; it < DEPTH * 2 * 2; it += NGW) {
        const int lk = it >> 1, l = lk >> 1, kv = lk & 1, j = (it & 1) * 64 + F.lane;
        const float* pos = (kv ? F.pos_v : F.pos_k) + (size_t)l * 2048; const float* W1 = (kv ? F.w1_v : F.w1_k) + (size_t)l * 2048 * 128;
        float a = 0.f;
        for (int k = 0; k < 2048; ++k) a += pos[k] * W1[(size_t)k * 128 + j];
        F.posb[lk * 128 + j] = a;
    }
    for (int m = gw; m < M; m += NGW) {
        const f32x4* xr = (const f32x4*)(F.x + (size_t)m * D) + F.lane; v2u* o8 = (v2u*)(F.xb + (size_t)m * D) + F.lane;
#pragma unroll
        for (int j = 0; j < 4; ++j) { const f32x4 v = xr[64 * j]; v2u w; w.x = pk2(v.x, v.y); w.y = pk2(v.z, v.w); o8[64 * j] = w; }
    }
}

__device__ __forceinline__ void p_layernorm(const Ctx& F, const float* gam, const float* bet) {
    const int gw = F.vcu * NWAVES + F.wave, NGW = F.G * NWAVES;
    f32x4 gv[4], bv[4];
#pragma unroll
    for (int j = 0; j < 4; ++j) { gv[j] = ((const f32x4*)gam)[F.lane + 64 * j]; bv[j] = ((const f32x4*)bet)[F.lane + 64 * j]; }
    for (int m = gw; m < M; m += NGW) {
        f32x4* xr = (f32x4*)(F.out + (size_t)m * D) + F.lane; v2u* o8 = (v2u*)(F.xb + (size_t)m * D) + F.lane;
        f32x4 v[4]; float s = 0.f;
#pragma unroll
        for (int j = 0; j < 4; ++j) { v[j] = xr[64 * j]; s += (v[j].x + v[j].y) + (v[j].z + v[j].w); }
        const float mean = wave_sum(s) * (1.f / D); float s2 = 0.f;
#pragma unroll
        for (int j = 0; j < 4; ++j) { v[j] = v[j] - mean; s2 += (v[j].x * v[j].x + v[j].y * v[j].y) + (v[j].z * v[j].z + v[j].w * v[j].w); }
        const float rstd = 1.f / sqrtf(wave_sum(s2) * (1.f / D) + LN_EPS);
#pragma unroll
        for (int j = 0; j < 4; ++j) { const f32x4 o = v[j] * rstd * gv[j] + bv[j]; xr[64 * j] = o; v2u w; w.x = pk2(o.x, o.y); w.y = pk2(o.z, o.w); o8[64 * j] = w; }
    }
}

__device__ __forceinline__ void hgrn_scan_unit(const Ctx& F, int l, int u) {
    constexpr int TT = 16;
    const int b = u >> 4, h = (u >> 2) & 3, dvs = u & 3;
    LAS float* qs = (LAS float*)(F.lds + RING_OFF);
    LAS float* fs = qs + TT * 128;
    LAS float* vs = fs + TT * 128;
    LAS float* part = vs + TT * 32;
    LAS float* lbs = part + TT * 16 * 32;
    const int tid = F.tid, dv = tid & 31, kg = tid >> 5;
    if (tid < 128) {
        const int c = h * 128 + tid; float p[DEPTH], mx = -1e30f;
#pragma unroll
        for (int i = 0; i < DEPTH; ++i) { p[i] = F.lb_param[i * 512 + c]; mx = fmaxf(mx, p[i]); }
        float sum = 0.f, acc = 0.f;
#pragma unroll
        for (int i = 0; i < DEPTH; ++i) { p[i] = expf(p[i] - mx); sum += p[i]; }
#pragma unroll
        for (int i = 1; i < DEPTH; ++i) { if (i <= l) acc += p[i]; }
        lbs[tid] = acc / sum;
    }
    __syncthreads();
    float S[8];
#pragma unroll
    for (int j = 0; j < 8; ++j) S[j] = 0.f;
    const bf16* P = F.proj + (size_t)b * SEQ * PS;
    const int lr = tid >> 5, lc = tid & 31;
    for (int t0 = 0; t0 < SEQ; t0 += TT) {
        {   const bf16* row = P + (size_t)(t0 + lr) * PS;
            const v2u qw = *(const v2u*)(row + C_HQ + h * 128 + lc * 4), fw = *(const v2u*)(row + C_HF + h * 128 + lc * 4);
            f32x4 qv = {bflo(qw.x), bfhi(qw.x), bflo(qw.y), bfhi(qw.y)}, zv = {bflo(fw.x), bfhi(fw.x), bflo(fw.y), bfhi(fw.y)};
            const f32x4 lbv = *(LAS f32x4*)(lbs + lc * 4); f32x4 fv;
            fv.x = lbv.x + (1.f - lbv.x) * sigmoidf_(zv.x); fv.y = lbv.y + (1.f - lbv.y) * sigmoidf_(zv.y); fv.z = lbv.z + (1.f - lbv.z) * sigmoidf_(zv.z); fv.w = lbv.w + (1.f - lbv.w) * sigmoidf_(zv.w);
            *(LAS f32x4*)(qs + lr * 128 + lc * 4) = qv; *(LAS f32x4*)(fs + lr * 128 + lc * 4) = fv;
            vs[lr * 32 + lc] = bf2f(row[C_HI + h * 128 + dvs * 32 + lc]);
        }
        __syncthreads();
#pragma unroll 4
        for (int tt = 0; tt < TT; ++tt) {
            const float v = vs[tt * 32 + dv];
            const f32x4 f0 = *(LAS f32x4*)(fs + tt * 128 + kg * 8), f1 = *(LAS f32x4*)(fs + tt * 128 + kg * 8 + 4);
            const f32x4 q0 = *(LAS f32x4*)(qs + tt * 128 + kg * 8), q1 = *(LAS f32x4*)(qs + tt * 128 + kg * 8 + 4);
            float o = 0.f;
            S[0] = f0.x * S[0] + (1.f - f0.x) * v; o += q0.x * S[0];
            S[1] = f0.y * S[1] + (1.f - f0.y) * v; o += q0.y * S[1];
            S[2] = f0.z * S[2] + (1.f - f0.z) * v; o += q0.z * S[2];
            S[3] = f0.w * S[3] + (1.f - f0.w) * v; o += q0.w * S[3];
            S[4] = f1.x * S[4] + (1.f - f1.x) * v; o += q1.x * S[4];
            S[5] = f1.y * S[5] + (1.f - f1.y) * v; o += q1.y * S[5];
            S[6] = f1.z * S[6] + (1.f - f1.z) * v; o += q1.z * S[6];
            S[7] = f1.w * S[7] + (1.f - f1.w) * v; o += q1.w * S[7];
            part[(tt * 16 + kg) * 32 + dv] = o;
        }
        __syncthreads();
        {   const int tt = tid >> 5; float o = 0.f;
#pragma unroll
            for (int k = 0; k < 16; ++k) o += part[(tt * 16 + k) * 32 + dv];
            F.opre[(size_t)(b * SEQ + t0 + tt) * 512 + h * 128 + dvs * 32 + dv] = o;
        }
    }
    __syncthreads();
}
__device__ __forceinline__ void hgrn_finalize(const Ctx& F, int l) {
    const int gw = F.vcu * NWAVES + F.wave, NGW = F.G * NWAVES;
    const float* nw = F.norm_w + l * 128 + (F.lane & 15) * 8;
    float w[8];
#pragma unroll
    for (int i = 0; i < 8; ++i) w[i] = nw[i];
    for (int m = gw; m < M; m += NGW) {
        const f32x4* op = (const f32x4*)(F.opre + (size_t)m * 512 + F.lane * 8);
        const f32x4 a = op[0], c = op[1];
        float o[8] = {a.x, a.y, a.z, a.w, c.x, c.y, c.z, c.w};
        float ss = 0.f;
#pragma unroll
        for (int i = 0; i < 8; ++i) ss += o[i] * o[i];
        ss += __shfl_xor(ss, 1); ss += __shfl_xor(ss, 2); ss += __shfl_xor(ss, 4); ss += __shfl_xor(ss, 8);
        const float r = 1.0f / sqrtf(ss * (1.f / 128.f) + 1e-6f);
        const v4u gw4 = *(const v4u*)(F.proj + (size_t)m * PS + C_HG + F.lane * 8);
        const float g[8] = {bflo(gw4.x), bfhi(gw4.x), bflo(gw4.y), bfhi(gw4.y), bflo(gw4.z), bfhi(gw4.z), bflo(gw4.w), bfhi(gw4.w)};
        float y[8];
#pragma unroll
        for (int i = 0; i < 8; ++i) y[i] = o[i] * r * w[i] * (g[i] * sigmoidf_(g[i]));
        v4u ov; ov.x = pk2(y[0], y[1]); ov.y = pk2(y[2], y[3]); ov.z = pk2(y[4], y[5]); ov.w = pk2(y[6], y[7]);
        *(v4u*)(F.mix + (size_t)m * D + F.lane * 8) = ov;
    }
}

__device__ __forceinline__ void cmp_unit(const Ctx& F, int l, int cu) {
    const int b = cu >> 6, g = (cu >> 5) & 1, kv = (cu >> 4) & 1, nb = cu & 15, n0 = nb * 16;
    LAS float* X = (LAS float*)(F.lds + RING_OFF);
    LAS float* posl = X + 272 * 64;
    LAS float* hid = posl + 32 * 64;
    const int tid = F.tid;
    const bf16* P = F.proj + (size_t)b * SEQ * PS + (kv ? C_VC : C_KC) + g * 64;
    const float* pos = (kv ? F.pos_v : F.pos_k) + (size_t)l * 32 * 64;
    const float* W1 = (kv ? F.w1_v : F.w1_k) + (size_t)l * 2048 * 128;
    const float* W2 = (kv ? F.w2_v : F.w2_k) + (size_t)l * 128 * 64;
    for (int i = tid; i < 272 * 16; i += 512) { const int r = i >> 4, c4 = (i & 15) * 4, t = n0 * 16 + r;
        f32x4 v = {0.f, 0.f, 0.f, 0.f};
        if (t < SEQ) { const v2u w = *(const v2u*)(P + (size_t)t * PS + c4); v = (f32x4){bflo(w.x), bfhi(w.x), bflo(w.y), bfhi(w.y)}; }
        *(LAS f32x4*)(X + r * 64 + c4) = v; }
    for (int i = tid; i < 32 * 64; i += 512) posl[i] = pos[i];
    __syncthreads();
    const int j = tid & 127, nq = tid >> 7;
    float acc[4] = {0.f, 0.f, 0.f, 0.f}, pacc = 0.f;
    for (int p = 0; p < 32; ++p) {
#pragma unroll 2
        for (int d = 0; d < 64; d += 4) {
            const float* wp = W1 + (size_t)(p * 64 + d) * 128 + j;
            const float w0 = wp[0], w1 = wp[128], w2 = wp[256], w3 = wp[384];
            const f32x4 pv = *(LAS f32x4*)(posl + p * 64 + d);
            pacc += pv.x * w0 + pv.y * w1 + pv.z * w2 + pv.w * w3;
#pragma unroll
            for (int i = 0; i < 4; ++i) { const f32x4 xv = *(LAS f32x4*)(X + ((nq * 4 + i) * 16 + p) * 64 + d); acc[i] += xv.x * w0 + xv.y * w1 + xv.z * w2 + xv.w * w3; }
        }
    }
#pragma unroll
    for (int i = 0; i < 4; ++i) hid[(nq * 4 + i) * 128 + j] = gelu_tanh(acc[i] + pacc);
    __syncthreads();
    bf16* O = (kv ? F.vcmp : F.kcmp) + (size_t)(b * 2 + g) * 256 * 64;
    const int c = tid & 63;
#pragma unroll
    for (int r = 0; r < 2; ++r) { const int nl = (tid >> 6) + 8 * r; float o = 0.f;
        for (int jj = 0; jj < 128; ++jj) o += hid[nl * 128 + jj] * W2[jj * 64 + c];
        const int n = n0 + nl; O[(size_t)n * 64 + c] = (bf16)((n < NCMP) ? f2bf(o) : 0u); }
    __syncthreads();
}

__device__ __forceinline__ int t5_bucket(int n) {
    if (n < 16) return n;
    int b = 16;
    b += (n >= 19); b += (n >= 21); b += (n >= 24); b += (n >= 27); b += (n >= 31); b += (n >= 35); b += (n >= 40); b += (n >= 46);
    b += (n >= 52); b += (n >= 59); b += (n >= 67); b += (n >= 77); b += (n >= 87); b += (n >= 99); b += (n >= 113);
    return b;
}
__device__ __forceinline__ void build_bias_table(const Ctx& F, LAS float* tab) {
    for (int i = F.tid; i < 8 * 129; i += NWAVES * 64) { const int h = i / 129, n = i % 129; tab[h * 132 + n] = F.rel_bias[t5_bucket(n) * 8 + h]; }
}
__device__ __forceinline__ void dot4(const bf16* krow, const LAS float* qf, float (&s)[4]) {
    s[0] = s[1] = s[2] = s[3] = 0.f;
#pragma unroll 2
    for (int i = 0; i < 8; ++i) {
        asm volatile("" ::: "memory");
        const v4u kv = *(const v4u*)(krow + 8 * i);
        const float k0 = bflo(kv.x), k1 = bfhi(kv.x), k2 = bflo(kv.y), k3 = bfhi(kv.y), k4 = bflo(kv.z), k5 = bfhi(kv.z), k6 = bflo(kv.w), k7 = bfhi(kv.w);
#pragma unroll
        for (int h = 0; h < 4; ++h) { const f32x4 qa = *(const LAS f32x4*)(qf + h * 64 + 8 * i), qb = *(const LAS f32x4*)(qf + h * 64 + 8 * i + 4);
            s[h] += k0 * qa.x + k1 * qa.y + k2 * qa.z + k3 * qa.w + k4 * qb.x + k5 * qb.y + k6 * qb.z + k7 * qb.w; }
    }
}
template <int MODE>
__device__ __forceinline__ void nsa_branch(const bf16* Kb, const bf16* Vb, int pitch, int nblk, unsigned long long sel, int t, int lim,
                                           const LAS float* qf, const LAS float* tab, LAS float* pe, int lane, float (&o)[4]) {
    float mx[4], lp[4];
#pragma unroll
    for (int h = 0; h < 4; ++h) { mx[h] = -INFINITY; lp[h] = 0.f; o[h] = 0.f; }
#pragma unroll 1
    for (int c = (MODE == 2 && t < 511) ? ((511 - t) >> 6) : 0; c < nblk; ++c) {
        int row0;
        if (MODE == 0) row0 = 64 * c; else if (MODE == 1) { row0 = 64 * (int)__builtin_ctzll(sel); sel &= sel - 1; } else row0 = t - 511 + 64 * c;
        const int key = row0 + lane; bool valid; int dist;
        if (MODE == 0) { valid = key < lim; dist = t - (16 * key + 31); } else { valid = (key >= 0) && (key <= t); dist = t - key; }
        const int krow = key < 0 ? 0 : key;
        float d4[4]; dot4(Kb + (size_t)krow * pitch, qf, d4);
        const int di = dist < 0 ? 0 : (dist > 128 ? 128 : dist);
        float e[4];
#pragma unroll
        for (int h = 0; h < 4; ++h) {
            const float sv = valid ? d4[h] + tab[h * 132 + di] : -INFINITY;
            if (MODE == 0) pe[h * 256 + key] = sv;
            const float mn = fmaxf(mx[h], wave_max(sv));
            const float scl = (mx[h] == mn) ? 1.f : __expf(mx[h] - mn);
            e[h] = valid ? __expf(sv - mn) : 0.f; lp[h] = lp[h] * scl + e[h]; o[h] *= scl; mx[h] = mn;
        }
#pragma unroll 2
        for (int kk = 0; kk < 64; ++kk) {
            int row = row0 + kk; row = row < 0 ? 0 : row;
            const float v = bf2f(Vb[(size_t)row * pitch + lane]);
#pragma unroll
            for (int h = 0; h < 4; ++h) o[h] += __int_as_float(__builtin_amdgcn_readlane(__float_as_int(e[h]), kk)) * v;
        }
    }
#pragma unroll
    for (int h = 0; h < 4; ++h) { lp[h] = 1.0f / wave_sum(lp[h]); o[h] *= lp[h]; }
    if (MODE == 0) {
        LDS_WAIT(); asm volatile("" ::: "memory");
#pragma unroll
        for (int c = 0; c < 4; ++c)
#pragma unroll
            for (int h = 0; h < 4; ++h) { const int n = 64 * c + lane; const float sv = (c < nblk) ? pe[h * 256 + n] : -INFINITY; pe[h * 256 + n] = __expf(sv - mx[h]) * lp[h]; }
    }
}
__device__ __forceinline__ void nsa_attn_phase(const Ctx& F, int l) {
    LAS float* tab = (LAS float*)(F.lds + RING_OFF);
    LAS float* qf = tab + 8 * 132 + F.wave * 64 * 4;
    LAS float* pe = tab + 8 * 132 + NWAVES * 256 + F.wave * 1024;
    build_bias_table(F, tab);
    __syncthreads();
    const int gw = F.vcu * NWAVES + F.wave, NGW = F.G * NWAVES, lane = F.lane;
    for (int idx = gw; idx < M * 2; idx += NGW) {
        const int g = idx & 1, m = idx >> 1, b = m >> 12, t = m & (SEQ - 1);
        const bf16* prow = F.proj + (size_t)m * PS;
        const LAS float* tg = tab + g * 4 * 132;
#pragma unroll
        for (int h = 0; h < 4; ++h) qf[h * 64 + lane] = 0.125f * bf2f(prow[C_NQ + (g * 4 + h) * 64 + lane]);
        LDS_WAIT(); asm volatile("" ::: "memory");
        const bf16* P0 = F.proj + (size_t)b * SEQ * PS;
        float oc[4] = {0.f, 0.f, 0.f, 0.f};
        const int nv = (t >= 31) ? ((t - 31) >> 4) + 1 : 0;
        if (nv > 0) {
            nsa_branch<0>(F.kcmp + (size_t)(b * 2 + g) * 256 * 64, F.vcmp + (size_t)(b * 2 + g) * 256 * 64, 64, (nv + 63) >> 6, 0ull, t, nv, qf, tg, pe, lane, oc);
            LDS_WAIT(); asm volatile("" ::: "memory");
        }
        const int cur = t >> 6;
        float imp = 0.f;
        if (nv > 0) {
#pragma unroll
            for (int k = -1; k <= 3; ++k) { const int n = 4 * lane + k; if (n >= 0 && n < NCMP) { const float p = pe[n] + pe[256 + n] + pe[512 + n] + pe[768 + n]; imp += (k >= 0 && k <= 2) ? 2.f * p : p; } }
        }
        const bool causal = lane <= cur, forced = (lane == 0) || (lane == cur) || (lane + 1 == cur);
        const float sc = forced ? 1e9f : (causal ? imp : -1e9f);
        int cnt = 0;
        for (int i = 0; i < 64; ++i) { const float o = __int_as_float(__builtin_amdgcn_readlane(__float_as_int(sc), i)); cnt += ((o > sc) || (o == sc && i < lane)) ? 1 : 0; }
        unsigned long long sel = __ballot((cnt < 16) && causal);
        float os[4];
        nsa_branch<1>(P0 + C_KS + g * 64, P0 + C_VS + g * 64, PS, __builtin_popcountll(sel), sel, t, 0, qf, tg, nullptr, lane, os);
        float ow[4];
        nsa_branch<2>(P0 + C_KW + g * 64, P0 + C_VW + g * 64, PS, 8, 0ull, t, 0, qf, tg, nullptr, lane, ow);
#pragma unroll
        for (int h = 0; h < 4; ++h) {
            const float gc = sigmoidf_(bf2f(prow[C_GT + 0 + g * 4 + h])), gs = sigmoidf_(bf2f(prow[C_GT + 8 + g * 4 + h])), gwn = sigmoidf_(bf2f(prow[C_GT + 16 + g * 4 + h]));
            F.mix[(size_t)m * D + 512 + (g * 4 + h) * 64 + lane] = (bf16)f2bf(gc * oc[h] + gs * os[h] + gwn * ow[h]);
        }
    }
    __syncthreads();
}

namespace nsa {
typedef short bf16x8 __attribute__((ext_vector_type(8)));
typedef float f32x16 __attribute__((ext_vector_type(16)));
typedef float f32x2_t __attribute__((ext_vector_type(2)));
typedef __bf16 bf16x2_t __attribute__((ext_vector_type(2)));
__device__ __forceinline__ unsigned cvtpk(float lo, float hi) { f32x2_t v = {lo, hi}; bf16x2_t b = __builtin_convertvector(v, bf16x2_t); return __builtin_bit_cast(unsigned, b); }
#define NSA_MFMA(a, b, c) __builtin_amdgcn_mfma_f32_32x32x16_bf16((a), (b), (c), 0, 0, 0)
constexpr int KP = 144, VP = 136;
constexpr int KT_BYTES = 64 * KP, VT_BYTES = 64 * VP;
constexpr int L_K = 0, L_V = 2 * KT_BYTES, L_TAB = L_V + 2 * VT_BYTES, L_IMPM = L_TAB + 8 * 132 * 4, L_IMPC = L_IMPM + 16384, L_STASH = L_IMPM  , L_SEL = L_STASH + 65536, L_END = L_SEL + 512;
static_assert(L_END <= RING_BYTES, "NSA LDS map");
constexpr float LOG2E = 1.4426950408889634f, C1 = 0.125f * LOG2E;
__device__ __forceinline__ int crow(int reg, int h) { return (reg & 3) + 8 * (reg >> 2) + 4 * h; }

struct Stage { v4u k, v; };
__device__ __forceinline__ void st_load(Stage& s, const bf16* kb, const bf16* vb, int pitch, int row0, int tid) {
    const size_t off = (size_t)(row0 + (tid >> 3)) * pitch + (tid & 7) * 8;
    s.k = *(const v4u*)(kb + off); s.v = *(const v4u*)(vb + off);
}
__device__ __forceinline__ void st_store(const Stage& s, LAS unsigned char* kl, LAS unsigned char* vl, int tid) {
    const int key = tid >> 3, ch = tid & 7;
    *(LAS v4u*)(kl + key * KP + ch * 16) = s.k;
    LAS unsigned short* vp = (LAS unsigned short*)(vl + (ch * 8) * VP + key * 2);
    vp[0 * (VP / 2)] = (unsigned short)(s.v.x & 0xffffu); vp[1 * (VP / 2)] = (unsigned short)(s.v.x >> 16);
    vp[2 * (VP / 2)] = (unsigned short)(s.v.y & 0xffffu); vp[3 * (VP / 2)] = (unsigned short)(s.v.y >> 16);
    vp[4 * (VP / 2)] = (unsigned short)(s.v.z & 0xffffu); vp[5 * (VP / 2)] = (unsigned short)(s.v.z >> 16);
    vp[6 * (VP / 2)] = (unsigned short)(s.v.w & 0xffffu); vp[7 * (VP / 2)] = (unsigned short)(s.v.w >> 16);
}
__device__ __forceinline__ void qk(f32x16& p0, f32x16& p1, const LAS unsigned char* kl, const bf16x8 (&qf)[4], int r, int h) {
    const LAS unsigned char* a = kl + r * KP + h * 16;
    f32x16 z;
#pragma unroll
    for (int i = 0; i < 16; ++i) z[i] = 0.f;
#pragma unroll
    for (int s = 0; s < 4; ++s) {
        const bf16x8 a0 = *(const LAS bf16x8*)(a + 32 * s), a1 = *(const LAS bf16x8*)(a + 32 * KP + 32 * s);
        p0 = NSA_MFMA(a0, qf[s], s ? p0 : z); p1 = NSA_MFMA(a1, qf[s], s ? p1 : z);
    }
}
__device__ __forceinline__ void pv(f32x16 (&o)[2], const LAS unsigned char* vl, const f32x16& p0, const f32x16& p1, int r, int h) {
#pragma unroll
    for (int kt = 0; kt < 2; ++kt)
#pragma unroll
        for (int s = 0; s < 2; ++s) {
            const f32x16& p = kt ? p1 : p0;
            v4u w; w.x = cvtpk(p[8 * s], p[8 * s + 1]); w.y = cvtpk(p[8 * s + 2], p[8 * s + 3]); w.z = cvtpk(p[8 * s + 4], p[8 * s + 5]); w.w = cvtpk(p[8 * s + 6], p[8 * s + 7]);
            const bf16x8 pb = __builtin_bit_cast(bf16x8, w);
#pragma unroll
            for (int dt = 0; dt < 2; ++dt) {
                const LAS unsigned char* va = vl + (32 * dt + r) * VP + (32 * kt + 16 * s + 4 * h) * 2;
                const v2u lo = *(const LAS v2u*)va, hi = *(const LAS v2u*)(va + 16);
                v4u vv; vv.x = lo.x; vv.y = lo.y; vv.z = hi.x; vv.w = hi.y;
                o[dt] = NSA_MFMA(__builtin_bit_cast(bf16x8, vv), pb, o[dt]);
            }
            __builtin_amdgcn_sched_barrier(0);
        }
}
template <int BR, bool NEAR>
__device__ __forceinline__ void to_scores_(f32x16& p0, f32x16& p1, int tile, int t, int lim, bool lsel, const LAS float* tabh, float bfar, int h) {
#pragma unroll
    for (int kt = 0; kt < 2; ++kt)
#pragma unroll
        for (int reg = 0; reg < 16; ++reg) {
            const int kk = 64 * tile + 32 * kt + crow(reg, h);
            int dist; bool valid;
            if (BR == 0) { valid = kk < lim; dist = t - 16 * kk - 31; }
            else { dist = t - kk; valid = (BR == 1) ? (lsel && dist >= 0) : (dist >= 0 && dist < 512); }
            float bb = bfar;
            if (NEAR) { const int di = dist < 0 ? 0 : (dist > 128 ? 128 : dist); bb = tabh[di]; }
            if (kt) p1[reg] = valid ? __builtin_fmaf(p1[reg], C1, bb) : -INFINITY; else p0[reg] = valid ? __builtin_fmaf(p0[reg], C1, bb) : -INFINITY;
        }
}
template <int BR>
__device__ __forceinline__ void to_scores(f32x16& p0, f32x16& p1, int tile, int t, int lim, bool lsel, bool near, const LAS float* tabh, float bfar, int h) {
    if (near) to_scores_<BR, true>(p0, p1, tile, t, lim, lsel, tabh, bfar, h);
    else if (BR == 0) to_scores_<BR, false>(p0, p1, tile, t, lim, lsel, tabh, bfar, h);
    else {
        const float c = lsel ? C1 : 0.f, bb = lsel ? bfar : -INFINITY;
#pragma unroll
        for (int i = 0; i < 16; ++i) { p0[i] = __builtin_fmaf(p0[i], c, bb); p1[i] = __builtin_fmaf(p1[i], c, bb); }
    }
}
__device__ __forceinline__ float max32(const f32x16& p0, const f32x16& p1) {
    float a = fmaxf(p0[0], p1[0]);
#pragma unroll
    for (int i = 1; i < 16; ++i) a = fmaxf(a, fmaxf(p0[i], p1[i]));
    return fmaxf(a, __shfl_xor(a, 32));
}
__device__ __forceinline__ void online(f32x16& p0, f32x16& p1, float& m, float& l, f32x16 (&o)[2], bool with_o) {
    const float tm = max32(p0, p1), mn = fmaxf(m, tm), mu = (mn == -INFINITY) ? 0.f : mn;
    const float alpha = __builtin_amdgcn_exp2f(m - mu); m = mn;
    float sum = 0.f;
#pragma unroll
    for (int i = 0; i < 16; ++i) { p0[i] = __builtin_amdgcn_exp2f(p0[i] - mu); p1[i] = __builtin_amdgcn_exp2f(p1[i] - mu); sum += p0[i] + p1[i]; }
    l = l * alpha + sum;
    if (with_o && __any(alpha != 1.0f)) {
#pragma unroll
        for (int i = 0; i < 16; ++i) { o[0][i] *= alpha; o[1][i] *= alpha; }
    }
}

__device__ __forceinline__ size_t row_of(int b, int qb, int w, int lane_opaque) { return (size_t)b * SEQ + 64 * qb + 8 * w + ((lane_opaque & 31) >> 2); }
#define NSA_OPAQUE_LANE(v) int v = lane; asm volatile("" : "+v"(v))
__device__ __forceinline__ void unit(const Ctx& F, int b, int g, int qb) {
    LAS unsigned char* L = F.lds + RING_OFF;
    const LAS float* tab2 = (const LAS float*)(L + L_TAB);
    LAS float* impM = (LAS float*)(L + L_IMPM); LAS float* impC = (LAS float*)(L + L_IMPC);
    LAS unsigned* selw = (LAS unsigned*)(L + L_SEL);
    const int tid = F.tid, lane = F.lane, w = F.wave, r = lane & 31, h = lane >> 5;
    const int t0 = 64 * qb, cur = qb, ql = 8 * w + (r >> 2), hp = r & 3, t = t0 + ql;
    const LAS float* tabh = tab2 + (g * 4 + hp) * 132; const float bfar = tabh[128];
    bf16x8 qf[4];
#pragma unroll
    for (int s = 0; s < 4; ++s) qf[s] = *(const bf16x8*)(F.proj + ((size_t)b * SEQ + t) * PS + C_NQ + (g * 4 + hp) * 64 + 16 * s + 8 * h);
    __syncthreads();
    for (int i = tid; i < 8192; i += NWAVES * 64) impM[i] = 0.f;
    f32x16 out[2], o[2];
#pragma unroll
    for (int i = 0; i < 16; ++i) { out[0][i] = 0.f; out[1][i] = 0.f; }
    Stage st;
    const bf16* P0 = F.proj + (size_t)b * SEQ * PS;
    {
        const bf16* kb = F.kcmp + (size_t)(b * 2 + g) * 256 * 64; const bf16* vb = F.vcmp + (size_t)(b * 2 + g) * 256 * 64;
        const int ntc = (4 * qb + 3 + 63) >> 6, nv = (t >= 31) ? ((t - 31) >> 4) + 1 : 0;
        float m = -INFINITY, l = 0.f;
#pragma unroll 1
        for (int pass = 0; pass < 2; ++pass) {
            float mu = 0.f, linv = 0.f;
            if (pass == 1) { l += __shfl_xor(l, 32); mu = (m == -INFINITY) ? 0.f : m; linv = (l > 0.f) ? 1.0f / l : 0.f;
#pragma unroll
                for (int i = 0; i < 16; ++i) { o[0][i] = 0.f; o[1][i] = 0.f; } }
            st_load(st, kb, vb, 64, 0, tid); st_store(st, L + L_K, L + L_V, tid); __syncthreads();
#pragma unroll 1
            for (int c = 0; c < ntc; ++c) {
                const int bi = c & 1;
                if (c + 1 < ntc) st_load(st, kb, vb, 64, 64 * (c + 1), tid);
                f32x16 p0, p1; qk(p0, p1, L + L_K + bi * KT_BYTES, qf, r, h);
                const bool near = (t0 - 16 * (64 * c + 63) - 31) < 128;
                __builtin_amdgcn_sched_barrier(0);
                to_scores<0>(p0, p1, c, t, nv, true, near, tabh, bfar, h);
                __builtin_amdgcn_sched_barrier(0);
                if (pass == 0) { online(p0, p1, m, l, o, false); }
                else {
#pragma unroll
                    for (int i = 0; i < 16; ++i) { p0[i] = __builtin_amdgcn_exp2f(p0[i] - mu) * linv; p1[i] = __builtin_amdgcn_exp2f(p1[i] - mu) * linv; }
#pragma unroll
                    for (int kt = 0; kt < 2; ++kt)
#pragma unroll
                        for (int q4 = 0; q4 < 4; ++q4) {
                            const f32x16& p = kt ? p1 : p0;
                            float carry = p[4 * q4 + 3], mainv = 2.f * (p[4 * q4] + p[4 * q4 + 1] + p[4 * q4 + 2]) + carry;
                            mainv += __shfl_xor(mainv, 1); mainv += __shfl_xor(mainv, 2); carry += __shfl_xor(carry, 1); carry += __shfl_xor(carry, 2);
                            const int j = 16 * c + 8 * kt + 2 * q4 + h;
                            if (hp == 0) { impM[ql * 64 + j] = mainv; if (j + 1 < 64) impC[ql * 64 + j + 1] = carry; }
                        }
                    __builtin_amdgcn_sched_barrier(0);
                    pv(o, L + L_V + bi * VT_BYTES, p0, p1, r, h);
                }
                if (c + 1 < ntc) st_store(st, L + L_K + (bi ^ 1) * KT_BYTES, L + L_V + (bi ^ 1) * VT_BYTES, tid);
                __syncthreads();
            }
        }
        NSA_OPAQUE_LANE(lo_); const float gc = sigmoidf_(bf2f(F.proj[row_of(b, qb, w, lo_) * PS + C_GT + 0 + g * 4 + (lo_ & 3)]));
#pragma unroll
        for (int i = 0; i < 16; ++i) { out[0][i] += gc * o[0][i]; out[1][i] += gc * o[1][i]; }
    }
    if (cur >= 16) {
        int tq_ = tid; asm volatile("" : "+v"(tq_));
        const int q = tq_ >> 3, part = tq_ & 7;
        const LAS float* im = impM + q * 64; const LAS float* ic = impC + q * 64;
        float sc[8]; int cnt[8];
#pragma unroll
        for (int i = 0; i < 8; ++i) { const int j = part * 8 + i; const float v = im[j] + ic[j]; sc[i] = (j == 0 || j == cur || j + 1 == cur) ? 1e9f : (j <= cur ? v : -1e9f); cnt[i] = 0; }
#pragma unroll 4
        for (int jj = 0; jj < 64; ++jj) {
            const float v = im[jj] + ic[jj]; const float sv = (jj == 0 || jj == cur || jj + 1 == cur) ? 1e9f : (jj <= cur ? v : -1e9f);
#pragma unroll
            for (int i = 0; i < 8; ++i) cnt[i] += ((sv > sc[i]) || (sv == sc[i] && jj < part * 8 + i)) ? 1 : 0;
        }
        unsigned bits = 0;
#pragma unroll
        for (int i = 0; i < 8; ++i) bits |= ((cnt[i] < 16) && (part * 8 + i <= cur)) ? (1u << i) : 0u;
        unsigned lo = (part < 4) ? (bits << (8 * part)) : 0u, hi = (part >= 4) ? (bits << (8 * (part - 4))) : 0u;
        lo |= __shfl_xor(lo, 1); lo |= __shfl_xor(lo, 2); lo |= __shfl_xor(lo, 4); hi |= __shfl_xor(hi, 1); hi |= __shfl_xor(hi, 2); hi |= __shfl_xor(hi, 4);
        if (part == 0) { selw[2 * q] = lo; selw[2 * q + 1] = hi; }
    } else {
        if (tid < 64) { selw[2 * tid] = (1u << (cur + 1)) - 1u; selw[2 * tid + 1] = 0u; }
    }
    __syncthreads();
    const unsigned selLo = selw[2 * ql], selHi = selw[2 * ql + 1];
    LAS float* stash = (LAS float*)(L + L_STASH) + tid;
#pragma unroll
    for (int i = 0; i < 16; ++i) { stash[i * 512] = out[0][i]; stash[(16 + i) * 512] = out[1][i]; }
    unsigned long long U;
    { unsigned ulo = selw[2 * lane], uhi = selw[2 * lane + 1];
#pragma unroll
      for (int s = 1; s < 64; s <<= 1) { ulo |= __shfl_xor(ulo, s); uhi |= __shfl_xor(uhi, s); }
      U = ((unsigned long long)(unsigned)__builtin_amdgcn_readfirstlane(uhi) << 32) | (unsigned)__builtin_amdgcn_readfirstlane(ulo); }
    {
        const bf16* kb = P0 + C_KS + g * 64; const bf16* vb = P0 + C_VS + g * 64;
        float m = -INFINITY, l = 0.f;
#pragma unroll
        for (int i = 0; i < 16; ++i) { o[0][i] = 0.f; o[1][i] = 0.f; }
        unsigned long long rem = U; int j = (int)__builtin_ctzll(rem); rem &= rem - 1;
        st_load(st, kb, vb, PS, 64 * j, tid); st_store(st, L + L_K, L + L_V, tid); __syncthreads();
        int bi = 0;
#pragma unroll 1
        for (;;) {
            const bool more = rem != 0ull; int jn = 0;
            if (more) { jn = (int)__builtin_ctzll(rem); rem &= rem - 1; st_load(st, kb, vb, PS, 64 * jn, tid); }
            f32x16 p0, p1; qk(p0, p1, L + L_K + bi * KT_BYTES, qf, r, h);
            const bool lsel = ((j < 32 ? (selLo >> j) : (selHi >> (j - 32))) & 1u) != 0u;
            __builtin_amdgcn_sched_barrier(0);
            to_scores<1>(p0, p1, j, t, 0, lsel, (cur - j) <= 2, tabh, bfar, h);
            __builtin_amdgcn_sched_barrier(0);
            online(p0, p1, m, l, o, true);
            __builtin_amdgcn_sched_barrier(0);
            pv(o, L + L_V + bi * VT_BYTES, p0, p1, r, h);
            if (more) st_store(st, L + L_K + (bi ^ 1) * KT_BYTES, L + L_V + (bi ^ 1) * VT_BYTES, tid);
            __syncthreads();
            if (!more) break;
            j = jn; bi ^= 1;
        }
        l += __shfl_xor(l, 32);
        NSA_OPAQUE_LANE(lo_); const float gs = sigmoidf_(bf2f(F.proj[row_of(b, qb, w, lo_) * PS + C_GT + 8 + g * 4 + (lo_ & 3)])) / l;
#pragma unroll
        for (int i = 0; i < 16; ++i) { stash[i * 512] += gs * o[0][i]; stash[(16 + i) * 512] += gs * o[1][i]; }
    }
    {
        const bf16* kb = P0 + C_KW + g * 64; const bf16* vb = P0 + C_VW + g * 64;
        float m = -INFINITY, l = 0.f;
#pragma unroll
        for (int i = 0; i < 16; ++i) { o[0][i] = 0.f; o[1][i] = 0.f; }
        const int j0 = cur >= 8 ? cur - 8 : 0;
        st_load(st, kb, vb, PS, 64 * j0, tid); st_store(st, L + L_K, L + L_V, tid); __syncthreads();
#pragma unroll 1
        for (int j = j0; j <= cur; ++j) {
            const int bi = (j - j0) & 1;
            if (j < cur) st_load(st, kb, vb, PS, 64 * (j + 1), tid);
            f32x16 p0, p1; qk(p0, p1, L + L_K + bi * KT_BYTES, qf, r, h);
            __builtin_amdgcn_sched_barrier(0);
            to_scores<2>(p0, p1, j, t, 0, true, (cur - j) <= 2 || (cur - j) >= 8, tabh, bfar, h);
            __builtin_amdgcn_sched_barrier(0);
            online(p0, p1, m, l, o, true);
            __builtin_amdgcn_sched_barrier(0);
            pv(o, L + L_V + bi * VT_BYTES, p0, p1, r, h);
            if (j < cur) st_store(st, L + L_K + (bi ^ 1) * KT_BYTES, L + L_V + (bi ^ 1) * VT_BYTES, tid);
            __syncthreads();
        }
        l += __shfl_xor(l, 32);
        NSA_OPAQUE_LANE(lo_); const float gw = sigmoidf_(bf2f(F.proj[row_of(b, qb, w, lo_) * PS + C_GT + 16 + g * 4 + (lo_ & 3)])) / l;
#pragma unroll
        for (int i = 0; i < 16; ++i) { out[0][i] = stash[i * 512] + gw * o[0][i]; out[1][i] = stash[(16 + i) * 512] + gw * o[1][i]; }
    }
    NSA_OPAQUE_LANE(lo2_);
    bf16* orow = F.mix + row_of(b, qb, w, lo2_) * D + 512 + (g * 4 + (lo2_ & 3)) * 64 + 4 * (lo2_ >> 5);
#pragma unroll
    for (int dt = 0; dt < 2; ++dt)
#pragma unroll
        for (int q4 = 0; q4 < 4; ++q4) { v2u wv; wv.x = cvtpk(out[dt][4 * q4], out[dt][4 * q4 + 1]); wv.y = cvtpk(out[dt][4 * q4 + 2], out[dt][4 * q4 + 3]); *(v2u*)(orow + 32 * dt + 8 * q4) = wv; }
}
__device__ __forceinline__ void phase(const Ctx& F) {
    LAS float* tab2 = (LAS float*)(F.lds + RING_OFF + L_TAB);
    for (int i = F.tid; i < 8 * 129; i += NWAVES * 64) { const int hh = i / 129, n = i % 129; tab2[hh * 132 + n] = F.rel_bias[t5_bucket(n) * 8 + hh] * LOG2E; }
    __syncthreads();
    const int nper = (2048 + F.G - 1) / F.G;
#pragma unroll 1
    for (int k = 0; k < nper; ++k) {
        int b, g, qb;
        if (F.G == 256) { const int a = F.vcu & 7, bg = F.vcu >> 3; qb = 63 - 8 * k - ((k & 1) ? (7 - a) : a); b = bg >> 1; g = bg & 1; }
        else { const int u = F.vcu + k * F.G; if (u >= 2048) break; b = (u & 31) >> 1; g = u & 1; qb = 63 - (u >> 5); }
        unit(F, b, g, qb);
    }
    __syncthreads();
}
#undef NSA_MFMA
#undef NSA_OPAQUE_LANE
}

namespace cmpx {
typedef short bf16x8 __attribute__((ext_vector_type(8)));
typedef float f32x16 __attribute__((ext_vector_type(16)));
#define CMP_MFMA(a, b, c) __builtin_amdgcn_mfma_f32_32x32x16_bf16((a), (b), (c), 0, 0, 0)
__device__ __forceinline__ void wave_unit(const Ctx& F, int l, int wu, int lane) {
    const int nt = wu & 7, kv = (wu >> 3) & 1, g = (wu >> 4) & 1, b = wu >> 5;
    const int r = lane & 31, h = lane >> 5, n = 32 * nt + r;
    const bf16* W1T = F.w1t + (size_t)(l * 2 + kv) * 128 * 2048 + (size_t)r * 2048 + 8 * h;
    const bf16* X = F.proj + (size_t)b * SEQ * PS + (kv ? C_VC : C_KC) + g * 64 + 8 * h;
    f32x16 acc[4];
#pragma unroll
    for (int jt = 0; jt < 4; ++jt)
#pragma unroll
        for (int i = 0; i < 16; ++i) acc[jt][i] = 0.f;
#pragma unroll 2
    for (int p = 0; p < 32; ++p) {
        int row = 16 * n + p; row = row > SEQ - 1 ? SEQ - 1 : row;
        const bf16* xr = X + (size_t)row * PS;
#pragma unroll
        for (int s4 = 0; s4 < 4; ++s4) {
            const bf16x8 xb = *(const bf16x8*)(xr + 16 * s4);
#pragma unroll
            for (int jt = 0; jt < 4; ++jt) { const bf16x8 wa = *(const bf16x8*)(W1T + (size_t)(32 * jt) * 2048 + 64 * p + 16 * s4); acc[jt] = CMP_MFMA(wa, xb, acc[jt]); }
        }
    }
    const float* pb = F.posb + (l * 2 + kv) * 128 + 4 * h;
    const bf16* W2T = F.w2t + (size_t)(l * 2 + kv) * 64 * 128 + (size_t)r * 128 + 4 * h;
    f32x16 o2[2];
#pragma unroll
    for (int i = 0; i < 16; ++i) { o2[0][i] = 0.f; o2[1][i] = 0.f; }
#pragma unroll
    for (int jt = 0; jt < 4; ++jt) {
#pragma unroll
        for (int i = 0; i < 16; ++i) acc[jt][i] = gelu_tanh(acc[jt][i] + pb[32 * jt + (i & 3) + 8 * (i >> 2)]);
#pragma unroll
        for (int s = 0; s < 2; ++s) {
            v4u w; w.x = nsa::cvtpk(acc[jt][8 * s], acc[jt][8 * s + 1]); w.y = nsa::cvtpk(acc[jt][8 * s + 2], acc[jt][8 * s + 3]); w.z = nsa::cvtpk(acc[jt][8 * s + 4], acc[jt][8 * s + 5]); w.w = nsa::cvtpk(acc[jt][8 * s + 6], acc[jt][8 * s + 7]);
            const bf16x8 hb = __builtin_bit_cast(bf16x8, w);
#pragma unroll
            for (int ct = 0; ct < 2; ++ct) {
                const bf16* wp = W2T + (size_t)(32 * ct) * 128 + 32 * jt + 16 * s;
                const v2u lo = *(const v2u*)wp, hi = *(const v2u*)(wp + 8);
                v4u vv; vv.x = lo.x; vv.y = lo.y; vv.z = hi.x; vv.w = hi.y;
                o2[ct] = CMP_MFMA(__builtin_bit_cast(bf16x8, vv), hb, o2[ct]);
            }
        }
    }
    bf16* O = (kv ? F.vcmp : F.kcmp) + ((size_t)(b * 2 + g) * 256 + n) * 64 + 4 * h;
    const bool live = n < NCMP;
#pragma unroll
    for (int ct = 0; ct < 2; ++ct)
#pragma unroll
        for (int q4 = 0; q4 < 4; ++q4) { v2u wv; wv.x = live ? nsa::cvtpk(o2[ct][4 * q4], o2[ct][4 * q4 + 1]) : 0u; wv.y = live ? nsa::cvtpk(o2[ct][4 * q4 + 2], o2[ct][4 * q4 + 3]) : 0u; *(v2u*)(O + 32 * ct + 8 * q4) = wv; }
}
__device__ __forceinline__ void phase(const Ctx& F, int l) {
    if ((F.wave & 3) == 0) {
        const int gq = F.vcu * 2 + (F.wave >> 2), nq = F.G * 2;
        for (int wu = gq; wu < 512; wu += nq) wave_unit(F, l, wu, F.lane);
    }
}
#undef CMP_MFMA
}

namespace hg {
typedef short bf16x8 __attribute__((ext_vector_type(8)));
typedef float f32x16 __attribute__((ext_vector_type(16)));
#define HG_MFMA(a, b, c) __builtin_amdgcn_mfma_f32_32x32x16_bf16((a), (b), (c), 0, 0, 0)
constexpr int TP = 272, VP = 136;
constexpr int L_QT = 0, L_KT = 17408, L_QD = 34816, L_VT = 52224, L_KD = 0, L_TOT = 69632, L_SSQ = 71680, L_END = 72704;
static_assert(L_END <= RING_BYTES, "HGRN LDS map");
struct Prep { float b[16], k[16]; float bref, blast; };
__device__ __forceinline__ void prep(const Ctx& F, int l, int b, int h, int n, int tid, LAS float* tot, Prep& P) {
    const int d = tid & 127, tq = tid >> 7;
    float lb;
    {   float p[DEPTH], mx = -1e30f, sum = 0.f, acc = 0.f;
#pragma unroll
        for (int i = 0; i < DEPTH; ++i) { p[i] = F.lb_param[i * 512 + h * 128 + d]; mx = fmaxf(mx, p[i]); }
#pragma unroll
        for (int i = 0; i < DEPTH; ++i) { p[i] = __expf(p[i] - mx); sum += p[i]; }
#pragma unroll
        for (int i = 1; i < DEPTH; ++i) { if (i <= l) acc += p[i]; }
        lb = acc * __builtin_amdgcn_rcpf(sum); }
    const bf16* zp = F.proj + ((size_t)b * SEQ + 64 * n + 16 * tq) * PS + C_HF + h * 128 + d;
    float run = 0.f;
#pragma unroll
    for (int i = 0; i < 16; ++i) { const float z = bf2f(zp[(size_t)i * PS]); const float f = lb + (1.f - lb) * sigmoidf_(z); run += __logf(f); P.b[i] = run; P.k[i] = 1.f - f; }
    tot[tq * 128 + d] = run;
    __syncthreads();
    const float t0 = tot[d], t1 = tot[128 + d], t2 = tot[256 + d], t3 = tot[384 + d];
    const float off = (tq == 0) ? 0.f : (tq == 1) ? t0 : (tq == 2) ? (t0 + t1) : (t0 + t1 + t2);
#pragma unroll
    for (int i = 0; i < 16; ++i) P.b[i] += off;
    P.bref = t0 + t1; P.blast = (t0 + t1) + (t2 + t3);
}
__device__ __forceinline__ void load_vt(const bf16* vsrc, LAS unsigned char* vt, int tid) {
#pragma unroll
    for (int e = 0; e < 2; ++e) {
        const int id = tid + 512 * e, s = id >> 4, ch = id & 15;
        const v4u x = *(const v4u*)(vsrc + (size_t)s * PS + ch * 8);
        LAS unsigned short* vp = (LAS unsigned short*)(vt + (ch * 8) * VP + s * 2);
        vp[0 * (VP / 2)] = (unsigned short)(x.x & 0xffffu); vp[1 * (VP / 2)] = (unsigned short)(x.x >> 16);
        vp[2 * (VP / 2)] = (unsigned short)(x.y & 0xffffu); vp[3 * (VP / 2)] = (unsigned short)(x.y >> 16);
        vp[4 * (VP / 2)] = (unsigned short)(x.z & 0xffffu); vp[5 * (VP / 2)] = (unsigned short)(x.z >> 16);
        vp[6 * (VP / 2)] = (unsigned short)(x.w & 0xffffu); vp[7 * (VP / 2)] = (unsigned short)(x.w >> 16);
    }
}
__device__ __forceinline__ bf16x8 ld8x2(const LAS unsigned char* p) {
    const v2u lo = *(const LAS v2u*)p, hi = *(const LAS v2u*)(p + 8); v4u v; v.x = lo.x; v.y = lo.y; v.z = hi.x; v.w = hi.y; return __builtin_bit_cast(bf16x8, v);
}
__device__ __forceinline__ void h1_unit(const Ctx& F, int l, int u) {
    LAS unsigned char* L = F.lds + RING_OFF;
    const int tid = F.tid, lane = F.lane, w = F.wave, r = lane & 31, hl = lane >> 5;
    const int b = u >> 8, h = (u >> 6) & 3, n = u & 63;
    Prep P; prep(F, l, b, h, n, tid, (LAS float*)(L + L_TOT), P);
    const int d = tid & 127, tq = tid >> 7;
    {   unsigned wv[8];
#pragma unroll
        for (int i = 0; i < 8; ++i) wv[i] = nsa::cvtpk(P.k[2 * i] * __expf(P.blast - P.b[2 * i]), P.k[2 * i + 1] * __expf(P.blast - P.b[2 * i + 1]));
        LAS v2u* kp = (LAS v2u*)(L + L_KD + d * VP + 32 * tq);
#pragma unroll
        for (int i = 0; i < 4; ++i) { v2u x; x.x = wv[2 * i]; x.y = wv[2 * i + 1]; kp[i] = x; } }
    load_vt(F.proj + ((size_t)b * SEQ + 64 * n) * PS + C_HI + h * 128, L + L_VT, tid);
    if (tq == 0) F.dlast[(size_t)u * 128 + d] = __expf(P.blast);
    __syncthreads();
    const int dkt = w & 3, dvt0 = 2 * (w >> 2);
    f32x16 a0, a1;
#pragma unroll
    for (int i = 0; i < 16; ++i) { a0[i] = 0.f; a1[i] = 0.f; }
#pragma unroll
    for (int ks = 0; ks < 4; ++ks) {
        const bf16x8 A = ld8x2(L + L_KD + (32 * dkt + r) * VP + 32 * ks + 16 * hl);
        const bf16x8 B0 = ld8x2(L + L_VT + (32 * dvt0 + r) * VP + 32 * ks + 16 * hl), B1 = ld8x2(L + L_VT + (32 * dvt0 + 32 + r) * VP + 32 * ks + 16 * hl);
        a0 = HG_MFMA(A, B0, a0); a1 = HG_MFMA(A, B1, a1);
    }
    bf16* O = F.kvt + (size_t)u * 16384 + (size_t)(32 * dvt0 + r) * 128 + 32 * dkt + 4 * hl;
#pragma unroll
    for (int q4 = 0; q4 < 4; ++q4) {
        v2u x; x.x = nsa::cvtpk(a0[4 * q4], a0[4 * q4 + 1]); x.y = nsa::cvtpk(a0[4 * q4 + 2], a0[4 * q4 + 3]); *(v2u*)(O + 8 * q4) = x;
        v2u y; y.x = nsa::cvtpk(a1[4 * q4], a1[4 * q4 + 1]); y.y = nsa::cvtpk(a1[4 * q4 + 2], a1[4 * q4 + 3]); *(v2u*)(O + 32 * 128 + 8 * q4) = y;
    }
    __syncthreads();
}
__device__ __forceinline__ void scan(const Ctx& F) {
    const int gw = F.vcu * NWAVES + F.wave, NGW = F.G * NWAVES, lane = F.lane;
    for (int task = gw; task < 2048; task += NGW) {
        const int bh = task >> 5, part = task & 31, dv = 4 * part + (lane >> 4), dk0 = (lane & 15) * 8;
        bf16* kv = F.kvt + (size_t)bh * 64 * 16384 + (size_t)dv * 128 + dk0;
        const float* dl = F.dlast + (size_t)bh * 64 * 128 + dk0;
        float S[8];
#pragma unroll
        for (int i = 0; i < 8; ++i) S[i] = 0.f;
#pragma unroll 4
        for (int n = 0; n < 63; ++n) {
            const v4u x = *(const v4u*)(kv + (size_t)n * 16384);
            const f32x4 d0 = *(const f32x4*)(dl + n * 128), d1 = *(const f32x4*)(dl + n * 128 + 4);
            S[0] = d0.x * S[0] + bflo(x.x); S[1] = d0.y * S[1] + bfhi(x.x); S[2] = d0.z * S[2] + bflo(x.y); S[3] = d0.w * S[3] + bfhi(x.y);
            S[4] = d1.x * S[4] + bflo(x.z); S[5] = d1.y * S[5] + bfhi(x.z); S[6] = d1.z * S[6] + bflo(x.w); S[7] = d1.w * S[7] + bfhi(x.w);
            v4u y; y.x = nsa::cvtpk(S[0], S[1]); y.y = nsa::cvtpk(S[2], S[3]); y.z = nsa::cvtpk(S[4], S[5]); y.w = nsa::cvtpk(S[6], S[7]);
            *(v4u*)(kv + (size_t)n * 16384) = y;
        }
    }
}
__device__ __forceinline__ void h3_unit(const Ctx& F, int l, int u) {
    LAS unsigned char* L = F.lds + RING_OFF;
    const int tid = F.tid, lane = F.lane, w = F.wave, r = lane & 31, hl = lane >> 5;
    const int b = u >> 8, h = (u >> 6) & 3, n = u & 63;
    const size_t row0 = (size_t)b * SEQ + 64 * n;
    Prep P; prep(F, l, b, h, n, tid, (LAS float*)(L + L_TOT), P);
    {   const int d = tid & 127, tq = tid >> 7;
        const bf16* qp = F.proj + (row0 + 16 * tq) * PS + C_HQ + h * 128 + d;
#pragma unroll
        for (int i = 0; i < 16; ++i) {
            const float q = bf2f(qp[(size_t)i * PS]); const int off = (16 * tq + i) * TP + d * 2;
            *(LAS unsigned short*)(L + L_QT + off) = (unsigned short)f2bf(q * __expf(P.b[i] - P.bref));
            *(LAS unsigned short*)(L + L_KT + off) = (unsigned short)f2bf(P.k[i] * __expf(P.bref - P.b[i]));
            *(LAS unsigned short*)(L + L_QD + off) = (unsigned short)f2bf(q * __expf(P.b[i]));
        } }
    load_vt(F.proj + row0 * PS + C_HI + h * 128, L + L_VT, tid);
    __syncthreads();
    const int dvt = w & 3, tt = w >> 2;
    f32x16 o;
#pragma unroll
    for (int i = 0; i < 16; ++i) o[i] = 0.f;
#pragma unroll 1
    for (int st = 0; st <= tt; ++st) {
        f32x16 a;
#pragma unroll
        for (int i = 0; i < 16; ++i) a[i] = 0.f;
#pragma unroll
        for (int ks = 0; ks < 8; ++ks) {
            const bf16x8 A = *(const LAS bf16x8*)(L + L_KT + (32 * st + r) * TP + 32 * ks + 16 * hl);
            const bf16x8 B = *(const LAS bf16x8*)(L + L_QT + (32 * tt + r) * TP + 32 * ks + 16 * hl);
            a = HG_MFMA(A, B, a);
        }
        if (st == tt) {
#pragma unroll
            for (int i = 0; i < 16; ++i) { const int sl = (i & 3) + 8 * (i >> 2) + 4 * hl; a[i] = (sl <= r) ? a[i] : 0.f; }
        }
#pragma unroll
        for (int s2 = 0; s2 < 2; ++s2) {
            v4u pw; pw.x = nsa::cvtpk(a[8 * s2], a[8 * s2 + 1]); pw.y = nsa::cvtpk(a[8 * s2 + 2], a[8 * s2 + 3]); pw.z = nsa::cvtpk(a[8 * s2 + 4], a[8 * s2 + 5]); pw.w = nsa::cvtpk(a[8 * s2 + 6], a[8 * s2 + 7]);
            const LAS unsigned char* va = L + L_VT + (32 * dvt + r) * VP + (32 * st + 16 * s2 + 4 * hl) * 2;
            const v2u lo = *(const LAS v2u*)va, hi = *(const LAS v2u*)(va + 16);
            v4u vv; vv.x = lo.x; vv.y = lo.y; vv.z = hi.x; vv.w = hi.y;
            o = HG_MFMA(__builtin_bit_cast(bf16x8, vv), __builtin_bit_cast(bf16x8, pw), o);
        }
    }
    if (n > 0) {
        const bf16* Sp = F.kvt + (size_t)(u - 1) * 16384 + (size_t)(32 * dvt + r) * 128 + 8 * hl;
#pragma unroll
        for (int ks = 0; ks < 8; ++ks) {
            const bf16x8 A = *(const bf16x8*)(Sp + 16 * ks);
            const bf16x8 B = *(const LAS bf16x8*)(L + L_QD + (32 * tt + r) * TP + 32 * ks + 16 * hl);
            o = HG_MFMA(A, B, o);
        }
    }
    LAS float* ssq = (LAS float*)(L + L_SSQ);
    float ss = 0.f;
#pragma unroll
    for (int i = 0; i < 16; ++i) ss += o[i] * o[i];
    ss += __shfl_xor(ss, 32);
    if (hl == 0) ssq[dvt * 64 + 32 * tt + r] = ss;
    __syncthreads();
    const int tl = 32 * tt + r;
    const float rinv = 1.0f / sqrtf(((ssq[tl] + ssq[64 + tl]) + (ssq[128 + tl] + ssq[192 + tl])) * (1.f / 128.f) + 1e-6f);
    const bf16* gp = F.proj + (row0 + tl) * PS + C_HG + h * 128 + 32 * dvt + 4 * hl;
    bf16* op = F.mix + (row0 + tl) * D + h * 128 + 32 * dvt + 4 * hl;
    const float* nw = F.norm_w + l * 128 + 32 * dvt + 4 * hl;
#pragma unroll
    for (int q4 = 0; q4 < 4; ++q4) {
        const v2u gw2 = *(const v2u*)(gp + 8 * q4); const f32x4 nv = *(const f32x4*)(nw + 8 * q4);
        const float g0 = bflo(gw2.x), g1 = bfhi(gw2.x), g2 = bflo(gw2.y), g3 = bfhi(gw2.y);
        v2u y; y.x = nsa::cvtpk(o[4 * q4] * rinv * nv.x * (g0 * sigmoidf_(g0)), o[4 * q4 + 1] * rinv * nv.y * (g1 * sigmoidf_(g1)));
        y.y = nsa::cvtpk(o[4 * q4 + 2] * rinv * nv.z * (g2 * sigmoidf_(g2)), o[4 * q4 + 3] * rinv * nv.w * (g3 * sigmoidf_(g3)));
        *(v2u*)(op + 8 * q4) = y;
    }
    __syncthreads();
}
#undef HG_MFMA
}

struct Args { const float* in[19]; float* out; unsigned char* ws; int ph_lo, ph_hi; };
__global__ void __launch_bounds__(NWAVES * 64, 2) fwd(Args args) {
    extern __shared__ __attribute__((aligned(16))) unsigned char lds[];
    Ctx F;
    F.lds = (LAS unsigned char*)lds;
    volatile LAS unsigned* MISC = (volatile LAS unsigned*)(F.lds + MISC_OFF);
    F.tid = threadIdx.x; F.lane = F.tid & 63; F.wave = __builtin_amdgcn_readfirstlane(F.tid >> 6);
    F.G = gridDim.x; { const int bx = blockIdx.x; F.vcu = (F.G % 8 == 0) ? (bx % 8) * (F.G / 8) + bx / 8 : bx; }
    unsigned char* ws = args.ws;
    gu32* ctl = (gu32*)(ws + WS_CTL);
    F.x = args.in[0]; F.w_in = args.in[1]; F.lb_param = args.in[2]; F.norm_w = args.in[3]; F.pos_k = args.in[4]; F.w1_k = args.in[5]; F.w2_k = args.in[6];
    F.pos_v = args.in[7]; F.w1_v = args.in[8]; F.w2_v = args.in[9]; F.rel_bias = args.in[10]; F.w_out = args.in[11]; F.ln1_g = args.in[12]; F.ln1_b = args.in[13];
    F.w_gate = args.in[14]; F.w_up = args.in[15]; F.w_down = args.in[16]; F.ln2_g = args.in[17]; F.ln2_b = args.in[18]; F.out = args.out;
    F.win_t = (bf16*)(ws + WS_WIN); F.wout_t = (bf16*)(ws + WS_WOUT); F.wgu_t = (bf16*)(ws + WS_WGU); F.wdn_t = (bf16*)(ws + WS_WDN);
    F.kcmp = (bf16*)(ws + WS_KCMP); F.vcmp = (bf16*)(ws + WS_VCMP); F.xb = (bf16*)(ws + WS_XB); F.mix = (bf16*)(ws + WS_MIX); F.proj = (bf16*)(ws + WS_PROJ);
    F.opre = (float*)(ws + WS_OPRE); F.w1t = (bf16*)(ws + WS_W1T); F.w2t = (bf16*)(ws + WS_W2T); F.posb = (float*)(ws + WS_POSB);
    F.kvt = (bf16*)(ws + WS_XB);
    F.dlast = (float*)(ws + WS_OPRE);
    for (int u = F.tid; u < (LDS_BYTES - LDSCTL_OFF) / 4; u += NWAVES * 64) ((LAS unsigned*)(F.lds + LDSCTL_OFF))[u] = 0u;
    __syncthreads();
    XcdBarrier bar; bar.bar = (unsigned*)(ctl + CW_BAR); bar.x = 0; bar.st = nullptr;
    if (ONE_LAUNCH) bar = xcd_barrier_post((unsigned*)(ctl + CW_BAR), MISC + 8);
    const int lo = args.ph_lo, hi = args.ph_hi;
#define IN(k) (lo <= (k) && (k) < hi)
#define FRESH() do { int t_ = threadIdx.x; asm volatile("" : "+v"(t_)); F.tid = t_; F.lane = t_ & 63; } while (0)
#define SEAM(k) do { if (IN(k) && IN((k) + 1)) { if (ONE_LAUNCH) xcd_barrier(bar); } } while (0)

    if (IN(0)) { p_prologue(F); } SEAM(0);
    for (int l = 0; l < DEPTH; ++l) {
        const int p0 = 1 + 9 * l;
        const float* xin = (l == 0) ? F.x : F.out;
        if (IN(p0 + 0)) {
            pg8::Gemm g{F.xb, F.win_t + (size_t)l * PS * D, M, PS, D}; pg8::StaticOrder S; S.init(M, PS, F.G, (int)blockIdx.x);
            pg8::EpiBf16<0> E{F.proj, PS, nullptr, 0, 0, 1.f};
            pg8::gemm_phase<pg8::EpiBf16<0>, pg8::StaticOrder, true, true>(F.lds + RING_OFF, g, S, E);
        } SEAM(p0 + 0);
        if (IN(p0 + 1)) { FRESH();
            cmpx::phase(F, l);
#pragma unroll 1
            for (int u = F.vcu; u < 4096; u += F.G) hg::h1_unit(F, l, u);
        } SEAM(p0 + 1);
        if (IN(p0 + 2)) { FRESH();
            hg::scan(F);
            FRESH(); nsa::phase(F);
        } SEAM(p0 + 2);
        if (IN(p0 + 3)) { FRESH();
#pragma unroll 1
            for (int u = F.vcu; u < 4096; u += F.G) hg::h3_unit(F, l, u);
        } SEAM(p0 + 3);
        if (IN(p0 + 4)) {
            pg8::Gemm g{F.mix, F.wout_t + (size_t)l * D * D, M, D, D}; pg8::StaticOrder S; S.init(M, D, F.G, (int)blockIdx.x);
            pg8::EpiResid E{xin, F.out, D, ALPHA};
            pg8::gemm_phase<pg8::EpiResid, pg8::StaticOrder, true, true>(F.lds + RING_OFF, g, S, E);
        } SEAM(p0 + 4);
        if (IN(p0 + 5)) { FRESH(); p_layernorm(F, F.ln1_g + l * D, F.ln1_b + l * D); } SEAM(p0 + 5);
        if (IN(p0 + 6)) {
            pg8::Gemm g{F.xb, F.wgu_t + (size_t)l * NGU * D, M, NGU, D}; pg8::StaticOrder S; S.init(M, NGU, F.G, (int)blockIdx.x);
            pg8::EpiSwiGLU E{F.proj, DFF};
            pg8::gemm_phase<pg8::EpiSwiGLU, pg8::StaticOrder, true, true>(F.lds + RING_OFF, g, S, E);
        } SEAM(p0 + 6);
        if (IN(p0 + 7)) {
            pg8::Gemm g{F.proj, F.wdn_t + (size_t)l * D * DFF, M, D, DFF}; pg8::StaticOrder S; S.init(M, D, F.G, (int)blockIdx.x);
            pg8::EpiResid E{F.out, F.out, D, ALPHA};
            pg8::gemm_phase<pg8::EpiResid, pg8::StaticOrder, true, true>(F.lds + RING_OFF, g, S, E);
        } SEAM(p0 + 7);
        if (IN(p0 + 8)) { FRESH(); p_layernorm(F, F.ln2_g + l * D, F.ln2_b + l * D); } SEAM(p0 + 8);
    }
#undef IN
#undef SEAM
}

extern "C" void kernel_launch(void* const* d_in, const int* in_sizes, int n_in, void* d_out, int out_size, void* d_ws, size_t ws_size, hipStream_t stream) {
    static int grid = 0;
    if (grid == 0) {
        if (n_in != 19 || in_sizes[0] != M * D || out_size != M * D || ws_size < WS_END) { fprintf(stderr, "kernel_launch: unexpected shapes (n_in %d, in0 %d, out %d, ws %zu); nothing launched\n", n_in, n_in > 0 ? in_sizes[0] : -1, out_size, ws_size); grid = -1; return; }
        int dev = 0, cus = 0, per_cu = 0;
        if (hipGetDevice(&dev) != hipSuccess || hipDeviceGetAttribute(&cus, hipDeviceAttributeMultiprocessorCount, dev) != hipSuccess) { grid = -1; return; }
        if (hipFuncSetAttribute((const void*)fwd, hipFuncAttributeMaxDynamicSharedMemorySize, LDS_BYTES) != hipSuccess) { fprintf(stderr, "kernel_launch: hipFuncSetAttribute failed\n"); grid = -1; return; }
        if (hipOccupancyMaxActiveBlocksPerMultiprocessor(&per_cu, (const void*)fwd, NWAVES * 64, LDS_BYTES) != hipSuccess || per_cu < 1) fprintf(stderr, "kernel_launch: note: occupancy query reports %d\n", per_cu);
        (void)hipGetLastError();
        grid = cus;
    }
    if (grid < 0) return;
    if (hipMemsetAsync((char*)d_ws + WS_CTL, 0, CTL_ZERO_BYTES, stream) != hipSuccess) return;
    Args a{};
    for (int i = 0; i < 19; ++i) a.in[i] = (const float*)d_in[i];
    a.out = (float*)d_out; a.ws = (unsigned char*)d_ws;
    if (ONE_LAUNCH) { a.ph_lo = 0; a.ph_hi = N_PHASES; hipLaunchKernelGGL(fwd, dim3(grid), dim3(NWAVES * 64), LDS_BYTES, stream, a); }
    else { for (int p = 0; p < N_PHASES; ++p) { a.ph_lo = p; a.ph_hi = p + 1; hipLaunchKernelGGL(fwd, dim3(grid), dim3(NWAVES * 64), LDS_BYTES, stream, a); } }
}
```
